# Optimizing an MI355X kernel written in HIP

```python
import jax
import jax.numpy as jnp
from jax import lax
import numpy as np

D_MODEL = 2048
BATCH = 4
SEQ = 2048
DEPTH = 2
DEC_BATCH = 16
DEC_SEQ = 16
PAST_LEN = 4096

CHUNK = 64
EPS = 1e-6
SSD_INNER = D_MODEL
SSD_HEADDIM = 64
SSD_HEADS = SSD_INNER // SSD_HEADDIM
SSD_GROUPS = 4
SSD_STATE = 128
SSD_CONV = 4
SSD_CONV_DIM = SSD_INNER + 2 * SSD_GROUPS * SSD_STATE
SSD_CHUNK = CHUNK
GLA_HEADS = 4
GLA_KEY = D_MODEL // 2
GLA_VAL = D_MODEL
GLA_HEAD_K = GLA_KEY // GLA_HEADS
GLA_HEAD_V = GLA_VAL // GLA_HEADS
GLA_RANK = 16
GLA_GATE_NORM = 16.0
GLA_CHUNK = 16
N_BRANCH = 2
IN_SPLITS = (SSD_INNER, SSD_CONV_DIM, SSD_HEADS, GLA_KEY, GLA_KEY, GLA_VAL, GLA_VAL, GLA_RANK, N_BRANCH * D_MODEL)
IN_DIM = SSD_INNER + SSD_CONV_DIM + SSD_HEADS + 2 * GLA_KEY + 2 * GLA_VAL + GLA_RANK + N_BRANCH * D_MODEL
MEM_TOKENS = 256
MEM_HEADS = 4
MEM_HEAD_DIM = D_MODEL // MEM_HEADS
D_FF = 5632
FFN_CONV = 3

kernel_name = "hybrid_ssd_gla_streaming_encoder_step"


def _split(x, sizes):
    offsets = [int(o) for o in np.cumsum(sizes)[:-1]]
    return jnp.split(x, offsets, axis=-1)


def group_rmsnorm(x, g, groups):
    shp = x.shape
    xf = x.astype(jnp.float32).reshape(shp[:-1] + (groups, shp[-1] // groups))
    xf = xf * lax.rsqrt(jnp.mean(xf * xf, axis=-1, keepdims=True) + EPS)
    return xf.reshape(shp).astype(x.dtype) * g


def causal_dwconv(x, buf, w, b):
    width = w.shape[0]
    L = x.shape[1]
    xp = jnp.concatenate([buf.astype(x.dtype), x], axis=1)
    y = xp[:, 0:L] * w[0]
    for i in range(1, width):
        y = y + xp[:, i:i + L] * w[i]
    return y + b, xp[:, L:]


def _pad_time(t, pad):
    return jnp.pad(t, [(0, 0), (0, pad)] + [(0, 0)] * (t.ndim - 2))


def ssd_scan(x, dt, a, b_in, c_in, h0):
    out_dtype = x.dtype
    bt, L, H, P = x.shape
    G, N = b_in.shape[2], b_in.shape[3]
    R = H // G
    Q = min(SSD_CHUNK, L)
    pad = (-L) % Q
    f32 = jnp.float32
    x, dt, b_in, c_in = x.astype(f32), dt.astype(f32), b_in.astype(f32), c_in.astype(f32)
    if pad:
        x, dt, b_in, c_in = _pad_time(x, pad), _pad_time(dt, pad), _pad_time(b_in, pad), _pad_time(c_in, pad)
    nc = (L + pad) // Q
    xr = x.reshape(bt, nc, Q, G, R, P)
    dtr = dt.reshape(bt, nc, Q, G, R)
    br = b_in.reshape(bt, nc, Q, G, N)
    cr = c_in.reshape(bt, nc, Q, G, N)
    acum = jnp.cumsum(dtr * a.astype(f32).reshape(G, R), axis=2)
    causal = jnp.tril(jnp.ones((Q, Q), dtype=bool))
    seg = acum[:, :, :, None] - acum[:, :, None, :]
    decay = jnp.exp(jnp.where(causal[:, :, None, None], seg, -jnp.inf))
    cb = jnp.einsum('bcign,bcjgn->bcijg', cr, br)
    w_ij = cb[..., None] * decay * dtr[:, :, None]
    y_diag = jnp.einsum('bcijgr,bcjgrp->bcigrp', w_ij, xr)
    to_end = jnp.exp(acum[:, :, -1:] - acum) * dtr
    chunk_dec = jnp.exp(acum[:, :, -1])
    exp_acum = jnp.exp(acum)

    def step(h, inp):
        b_c, te_c, x_c, c_c, ea_c, dec_c = inp
        y_off = jnp.einsum('bign,bgrpn->bigrp', c_c, h) * ea_c[..., None]
        h_new = h * dec_c[..., None, None] + jnp.einsum('bjgn,bjgr,bjgrp->bgrpn', b_c, te_c, x_c)
        return h_new, y_off

    xs = tuple(jnp.moveaxis(t, 1, 0) for t in (br, to_end, xr, cr, exp_acum, chunk_dec))
    h_last, y_off = lax.scan(step, h0.astype(f32).reshape(bt, G, R, P, N), xs)
    y = y_diag + jnp.moveaxis(y_off, 0, 1)
    y = y.reshape(bt, nc * Q, H, P)[:, :L]
    return y.astype(out_dtype), h_last.reshape(bt, H, P, N).astype(h0.dtype)


def gla_scan(q, k, v, log_a, s0):
    out_dtype = v.dtype
    bt, L, H, K = q.shape
    V = v.shape[-1]
    Q = min(GLA_CHUNK, L)
    pad = (-L) % Q
    f32 = jnp.float32
    q, k, v, log_a = q.astype(f32), k.astype(f32), v.astype(f32), log_a.astype(f32)
    if pad:
        q, k, v, log_a = _pad_time(q, pad), _pad_time(k, pad), _pad_time(v, pad), _pad_time(log_a, pad)
    nc = (L + pad) // Q
    qr = q.reshape(bt, nc, Q, H, K)
    kr = k.reshape(bt, nc, Q, H, K)
    vr = v.reshape(bt, nc, Q, H, V)
    bcum = jnp.cumsum(log_a.reshape(bt, nc, Q, H, K), axis=2)
    q_dec = qr * jnp.exp(bcum)
    k_inv = kr * jnp.exp(-bcum)
    k_end = kr * jnp.exp(bcum[:, :, -1:] - bcum)
    chunk_dec = jnp.exp(bcum[:, :, -1])
    causal = jnp.tril(jnp.ones((Q, Q), dtype=bool))
    att = jnp.where(causal, jnp.einsum('bcihk,bcjhk->bchij', q_dec, k_inv), 0.0)
    o_intra = jnp.einsum('bchij,bcjhv->bcihv', att, vr)

    def step(s, inp):
        q_c, k_c, v_c, dec_c = inp
        o = jnp.einsum('bihk,bhkv->bihv', q_c, s)
        s_new = s * dec_c[..., None] + jnp.einsum('bjhk,bjhv->bhkv', k_c, v_c)
        return s_new, o

    xs = tuple(jnp.moveaxis(t, 1, 0) for t in (q_dec, k_end, vr, chunk_dec))
    s_last, o_inter = lax.scan(step, s0.astype(f32), xs)
    o = o_intra + jnp.moveaxis(o_inter, 0, 1)
    o = o.reshape(bt, nc * Q, H, V)[:, :L]
    return o.astype(out_dtype), s_last.astype(s0.dtype)


def token_mixer(h, w_in, ssd_conv_w, ssd_conv_b, ssd_dt_bias, ssd_a_log, ssd_d, ssd_norm,
                gla_wa2, gla_ba, gla_norm, w_branch, w_out, ssd_h0, ssd_conv0, gla_s0):
    bt, L, _ = h.shape
    z, xbc, dt, q, k, v, g, a_lr, gates = _split(h @ w_in, IN_SPLITS)
    xbc, ssd_conv_new = causal_dwconv(xbc, ssd_conv0, ssd_conv_w, ssd_conv_b)
    xbc = jax.nn.silu(xbc)
    xs, bs, cs = _split(xbc, (SSD_INNER, SSD_GROUPS * SSD_STATE, SSD_GROUPS * SSD_STATE))
    xs = xs.reshape(bt, L, SSD_HEADS, SSD_HEADDIM)
    bs = bs.reshape(bt, L, SSD_GROUPS, SSD_STATE)
    cs = cs.reshape(bt, L, SSD_GROUPS, SSD_STATE)
    dt = jax.nn.softplus(dt + ssd_dt_bias)
    y_ssd, ssd_h = ssd_scan(xs, dt, -jnp.exp(ssd_a_log), bs, cs, ssd_h0)
    y_ssd = (y_ssd + ssd_d[:, None] * xs).reshape(bt, L, SSD_INNER)
    y_ssd = group_rmsnorm(y_ssd * jax.nn.silu(z), ssd_norm, SSD_GROUPS)
    q = q.reshape(bt, L, GLA_HEADS, GLA_HEAD_K) * (GLA_HEAD_K ** -0.5)
    k = k.reshape(bt, L, GLA_HEADS, GLA_HEAD_K)
    v = v.reshape(bt, L, GLA_HEADS, GLA_HEAD_V)
    log_a = jax.nn.log_sigmoid((a_lr @ gla_wa2 + gla_ba).astype(jnp.float32)) / GLA_GATE_NORM
    log_a = log_a.reshape(bt, L, GLA_HEADS, GLA_HEAD_K)
    y_gla, gla_s = gla_scan(q, k, v, log_a, gla_s0)
    y_gla = group_rmsnorm(y_gla, gla_norm, 1).reshape(bt, L, GLA_VAL) * jax.nn.silu(g)
    branches = jnp.stack([y_ssd, y_gla], axis=2)
    branch_out = jnp.einsum('blnc,ncd->blnd', branches, w_branch)
    gate = jax.nn.sigmoid(gates.reshape(bt, L, N_BRANCH, D_MODEL))
    merged = jnp.sum(gate * branch_out, axis=2)
    return merged @ w_out, ssd_h, ssd_conv_new, gla_s


def memory_cross_attn(h, mem_k, mem_v, w_mq, w_mo):
    bt, L, _ = h.shape
    q = (h @ w_mq).reshape(bt, L, MEM_HEADS, MEM_HEAD_DIM)
    s = jnp.einsum('blhd,bmhd->bhlm', q, mem_k).astype(jnp.float32) * (MEM_HEAD_DIM ** -0.5)
    p = jax.nn.softmax(s, axis=-1).astype(mem_v.dtype)
    o = jnp.einsum('bhlm,bmhd->blhd', p, mem_v).reshape(bt, L, D_MODEL)
    return o @ w_mo


def conv_ffn(h, w_ffn_in, ffn_conv_w, ffn_conv_b, w_ffn_out, conv0):
    up, conv_new = causal_dwconv(h @ w_ffn_in, conv0, ffn_conv_w, ffn_conv_b)
    u, gt = _split(up, (D_FF, D_FF))
    return (jax.nn.silu(gt) * u) @ w_ffn_out, conv_new


def run_trunk(x, mem_k, mem_v, st_ssd, st_ssd_conv, st_gla, st_ffn_conv, layer_w, norm_final):
    (norm_mix, w_in, ssd_conv_w, ssd_conv_b, ssd_dt_bias, ssd_a_log, ssd_d, ssd_norm,
     gla_wa2, gla_ba, gla_norm, w_branch, w_out, norm_mem, w_mq, w_mo,
     norm_ffn, w_ffn_in, ffn_conv_w, ffn_conv_b, w_ffn_out) = layer_w
    new_ssd, new_ssd_conv, new_gla, new_ffn = [], [], [], []
    for i in range(DEPTH):
        mix, s_h, s_c, g_s = token_mixer(
            group_rmsnorm(x, norm_mix[i], 1), w_in[i], ssd_conv_w[i], ssd_conv_b[i], ssd_dt_bias[i],
            ssd_a_log[i], ssd_d[i], ssd_norm[i], gla_wa2[i], gla_ba[i], gla_norm[i], w_branch[i], w_out[i],
            st_ssd[i], st_ssd_conv[i], st_gla[i])
        x = x + mix
        x = x + memory_cross_attn(group_rmsnorm(x, norm_mem[i], 1), mem_k[i], mem_v[i], w_mq[i], w_mo[i])
        f, f_c = conv_ffn(group_rmsnorm(x, norm_ffn[i], 1), w_ffn_in[i], ffn_conv_w[i], ffn_conv_b[i],
                          w_ffn_out[i], st_ffn_conv[i])
        x = x + f
        new_ssd.append(s_h)
        new_ssd_conv.append(s_c)
        new_gla.append(g_s)
        new_ffn.append(f_c)
    y = group_rmsnorm(x, norm_final, 1)
    return y, jnp.stack(new_ssd), jnp.stack(new_ssd_conv), jnp.stack(new_gla), jnp.stack(new_ffn)


def setup_inputs(seed: int = 0) -> dict:
    key = jax.random.key(seed)
    ks = jax.random.split(key, 40)
    f32 = jnp.float32

    def nrm(k, shape, scale=1.0):
        return jax.random.normal(k, shape, f32) * scale

    def gain(k, shape):
        return 1.0 + 0.02 * jax.random.normal(k, shape, f32)

    dt0 = jnp.exp(jax.random.uniform(ks[12], (DEPTH, SSD_HEADS), f32, np.log(1e-3), np.log(1e-1)))
    return {
        "x_prompt": nrm(ks[0], (BATCH, SEQ, D_MODEL)),
        "x_sample": nrm(ks[1], (DEC_BATCH, DEC_SEQ, D_MODEL)),
        "mem_prompt": nrm(ks[2], (BATCH, MEM_TOKENS, D_MODEL)),
        "state_ssd": nrm(ks[3], (DEPTH, DEC_BATCH, SSD_HEADS, SSD_HEADDIM, SSD_STATE), 0.5),
        "state_ssd_conv": nrm(ks[4], (DEPTH, DEC_BATCH, SSD_CONV - 1, SSD_CONV_DIM)),
        "state_gla": nrm(ks[5], (DEPTH, DEC_BATCH, GLA_HEADS, GLA_HEAD_K, GLA_HEAD_V), 0.5),
        "state_ffn_conv": nrm(ks[6], (DEPTH, DEC_BATCH, FFN_CONV - 1, 2 * D_FF)),
        "cache_mem_k": nrm(ks[7], (DEPTH, DEC_BATCH, MEM_TOKENS, MEM_HEADS, MEM_HEAD_DIM)),
        "cache_mem_v": nrm(ks[8], (DEPTH, DEC_BATCH, MEM_TOKENS, MEM_HEADS, MEM_HEAD_DIM)),
        "norm_mix": gain(ks[9], (DEPTH, D_MODEL)),
        "w_in": nrm(ks[10], (DEPTH, D_MODEL, IN_DIM), D_MODEL ** -0.5),
        "ssd_conv_w": nrm(ks[11], (DEPTH, SSD_CONV, SSD_CONV_DIM), SSD_CONV ** -0.5),
        "ssd_conv_b": nrm(ks[13], (DEPTH, SSD_CONV_DIM), 0.02),
        "ssd_dt_bias": dt0 + jnp.log(-jnp.expm1(-dt0)),
        "ssd_a_log": jnp.log(jax.random.uniform(ks[14], (DEPTH, SSD_HEADS), f32, 1.0, 16.0)),
        "ssd_d": 1.0 + nrm(ks[15], (DEPTH, SSD_HEADS), 0.1),
        "ssd_norm": gain(ks[16], (DEPTH, SSD_INNER)),
        "gla_wa2": nrm(ks[17], (DEPTH, GLA_RANK, GLA_KEY), GLA_RANK ** -0.5),
        "gla_ba": nrm(ks[18], (DEPTH, GLA_KEY), 0.01),
        "gla_norm": gain(ks[19], (DEPTH, GLA_HEAD_V)),
        "w_branch": nrm(ks[20], (DEPTH, N_BRANCH, D_MODEL, D_MODEL), D_MODEL ** -0.5),
        "w_out": nrm(ks[21], (DEPTH, D_MODEL, D_MODEL), D_MODEL ** -0.5),
        "norm_mem": gain(ks[22], (DEPTH, D_MODEL)),
        "w_mq": nrm(ks[23], (DEPTH, D_MODEL, D_MODEL), D_MODEL ** -0.5),
        "w_mk": nrm(ks[24], (DEPTH, D_MODEL, D_MODEL), D_MODEL ** -0.5),
        "w_mv": nrm(ks[25], (DEPTH, D_MODEL, D_MODEL), D_MODEL ** -0.5),
        "w_mo": nrm(ks[26], (DEPTH, D_MODEL, D_MODEL), D_MODEL ** -0.5),
        "norm_ffn": gain(ks[27], (DEPTH, D_MODEL)),
        "w_ffn_in": nrm(ks[28], (DEPTH, D_MODEL, 2 * D_FF), D_MODEL ** -0.5),
        "ffn_conv_w": nrm(ks[29], (DEPTH, FFN_CONV, 2 * D_FF), FFN_CONV ** -0.5),
        "ffn_conv_b": nrm(ks[30], (DEPTH, 2 * D_FF), 0.02),
        "w_ffn_out": nrm(ks[31], (DEPTH, D_FF, D_MODEL), D_FF ** -0.5),
        "norm_final": gain(ks[32], (D_MODEL,)),
    }


def reference(x_prompt, x_sample, mem_prompt, state_ssd, state_ssd_conv, state_gla, state_ffn_conv,
              cache_mem_k, cache_mem_v, norm_mix, w_in, ssd_conv_w, ssd_conv_b, ssd_dt_bias, ssd_a_log,
              ssd_d, ssd_norm, gla_wa2, gla_ba, gla_norm, w_branch, w_out, norm_mem, w_mq, w_mk, w_mv,
              w_mo, norm_ffn, w_ffn_in, ffn_conv_w, ffn_conv_b, w_ffn_out, norm_final):
    layer_w = (norm_mix, w_in, ssd_conv_w, ssd_conv_b, ssd_dt_bias, ssd_a_log, ssd_d, ssd_norm,
               gla_wa2, gla_ba, gla_norm, w_branch, w_out, norm_mem, w_mq, w_mo,
               norm_ffn, w_ffn_in, ffn_conv_w, ffn_conv_b, w_ffn_out)
    dt = x_prompt.dtype
    p_mem_k = jnp.einsum('bmd,ldc->lbmc', mem_prompt, w_mk).reshape(DEPTH, BATCH, MEM_TOKENS, MEM_HEADS, MEM_HEAD_DIM)
    p_mem_v = jnp.einsum('bmd,ldc->lbmc', mem_prompt, w_mv).reshape(DEPTH, BATCH, MEM_TOKENS, MEM_HEADS, MEM_HEAD_DIM)
    y_prompt, p_ssd, p_ssd_conv, p_gla, p_ffn_conv = run_trunk(
        x_prompt, p_mem_k, p_mem_v,
        jnp.zeros((DEPTH, BATCH, SSD_HEADS, SSD_HEADDIM, SSD_STATE), dt),
        jnp.zeros((DEPTH, BATCH, SSD_CONV - 1, SSD_CONV_DIM), dt),
        jnp.zeros((DEPTH, BATCH, GLA_HEADS, GLA_HEAD_K, GLA_HEAD_V), dt),
        jnp.zeros((DEPTH, BATCH, FFN_CONV - 1, 2 * D_FF), dt),
        layer_w, norm_final)
    y_sample, s_ssd, s_ssd_conv, s_gla, s_ffn_conv = run_trunk(
        x_sample, cache_mem_k, cache_mem_v, state_ssd, state_ssd_conv, state_gla, state_ffn_conv,
        layer_w, norm_final)
    return (y_prompt, y_sample, p_ssd, p_ssd_conv, p_gla, p_ffn_conv, p_mem_k, p_mem_v,
            s_ssd, s_ssd_conv, s_gla, s_ffn_conv)
```

```cpp
#ifndef HOST_EMU
#include <hip/hip_runtime.h>
#endif
#include <cstdio>
#include <cstdint>

#ifndef CFG_BATCH
#define CFG_BATCH 4
#endif
#ifndef CFG_SEQ
#define CFG_SEQ 2048
#endif
#ifndef MK_ONE_LAUNCH
#define MK_ONE_LAUNCH 1
#endif

#ifdef HOST_EMU
#define LAS
#define VMCNT(n) ((void)0)
#define LGKMCNT(n) ((void)0)
#define MEMCLOB() ((void)0)
#define WAVE_LDS_SYNC() ((void)emu_wave_op([](unsigned char*) {}, [](unsigned char (*)[64]) {}))
#define DYN_LDS(name) unsigned char* name = emu_lds()
#define LAUNDER_V(x) ((void)0)
#else
#define LAS __attribute__((address_space(3)))
#define VMCNT(n) asm volatile("s_waitcnt vmcnt(" #n ")" ::: "memory")
#define LGKMCNT(n) asm volatile("s_waitcnt lgkmcnt(" #n ")" ::: "memory")
#define MEMCLOB() asm volatile("" ::: "memory")
#define WAVE_LDS_SYNC() asm volatile("s_waitcnt lgkmcnt(0)" ::: "memory")
#define DYN_LDS(name) extern __shared__ __attribute__((aligned(16))) unsigned char name[]
#define LAUNDER_V(x) asm volatile("" : "+v"(x))
#endif

typedef unsigned short bf16;
typedef short bf16x8 __attribute__((ext_vector_type(8)));
typedef float f32x4 __attribute__((ext_vector_type(4)));
typedef float f32x2 __attribute__((ext_vector_type(2)));
typedef unsigned u32x4 __attribute__((ext_vector_type(4)));
typedef unsigned u32x2 __attribute__((ext_vector_type(2)));

__device__ __forceinline__ unsigned f2bf(float f) { unsigned u = __builtin_bit_cast(unsigned, f); return (u + 0x7fffu + ((u >> 16) & 1u)) >> 16; }
__device__ __forceinline__ float bf2f(unsigned b) { return __builtin_bit_cast(float, b << 16); }
__device__ __forceinline__ float bf_lo(unsigned w) { return __builtin_bit_cast(float, w << 16); }
__device__ __forceinline__ float bf_hi(unsigned w) { return __builtin_bit_cast(float, w & 0xffff0000u); }
#ifdef HOST_EMU
__device__ __forceinline__ unsigned cvt_pk_bf16(float lo, float hi) { return f2bf(lo) | (f2bf(hi) << 16); }
#else
typedef __bf16 bf16x2_native __attribute__((ext_vector_type(2)));
__device__ __forceinline__ unsigned cvt_pk_bf16(float lo, float hi) { const f32x2 v = {lo, hi}; return __builtin_bit_cast(unsigned, __builtin_convertvector(v, bf16x2_native)); }
#endif
__device__ __forceinline__ void unpack8(const u32x4 w, float (&v)[8]) { v[0] = bf_lo(w.x); v[1] = bf_hi(w.x); v[2] = bf_lo(w.y); v[3] = bf_hi(w.y); v[4] = bf_lo(w.z); v[5] = bf_hi(w.z); v[6] = bf_lo(w.w); v[7] = bf_hi(w.w); }
__device__ __forceinline__ u32x4 pack8(const float (&v)[8]) { u32x4 w; w.x = cvt_pk_bf16(v[0], v[1]); w.y = cvt_pk_bf16(v[2], v[3]); w.z = cvt_pk_bf16(v[4], v[5]); w.w = cvt_pk_bf16(v[6], v[7]); return w; }
__device__ __forceinline__ u32x4 zero16() { unsigned z = 0u; LAUNDER_V(z); return (u32x4){z, z, z, z}; }
__device__ __forceinline__ bf16x8 zero8h() { return __builtin_bit_cast(bf16x8, zero16()); }
__device__ __forceinline__ float sigmoidf_(float x) { return 1.0f / (1.0f + __expf(-x)); }
__device__ __forceinline__ float siluf_(float x) { return x / (1.0f + __expf(-x)); }
__device__ __forceinline__ float softplusf_(float x) { return x > 20.f ? x : __logf(1.0f + __expf(x)); }
__device__ __forceinline__ float logsigmoidf_(float x) { return fminf(x, 0.f) - __logf(1.0f + __expf(-fabsf(x))); }
__device__ __forceinline__ float wave_sum(float v) {
#pragma unroll
    for (int o = 1; o < 64; o <<= 1) v += __shfl_xor(v, o);
    return v;
}

constexpr int DM = 2048, NB = CFG_BATCH, SEQ = CFG_SEQ, TP = NB * SEQ, SBT = 16, SSQ = 16, TS = SBT * SSQ, T = TP + TS, NSEQ = NB + SBT;
constexpr int MTOK = 256, DFF = 5632, DFF2 = 11264, IN_DIM = 15408, NPROJ = 15360, NPROJ_PAD = 15616, XBCW = 3072;
constexpr int PZ = 0, PXBC = 2048, PQ = 5120, PK = 6144, PV = 7168, PG = 9216, PGATE = 11264;
constexpr float EPSF = 1e-6f;
static_assert(TP % 256 == 0 && SEQ % 16 == 0, "token tiling");
constexpr size_t O_Y = 0, O_PSSD = (size_t)T * DM, O_PSSDC = O_PSSD + (size_t)2 * NB * 32 * 64 * 128, O_PGLA = O_PSSDC + (size_t)2 * NB * 3 * XBCW, O_PFFC = O_PGLA + (size_t)2 * NB * 4 * 256 * 512,
                 O_PMK = O_PFFC + (size_t)2 * NB * 2 * DFF2, O_PMV = O_PMK + (size_t)2 * NB * MTOK * DM, O_SSSD = O_PMV + (size_t)2 * NB * MTOK * DM, O_SSSDC = O_SSSD + (size_t)2 * SBT * 32 * 64 * 128,
                 O_SGLA = O_SSSDC + (size_t)2 * SBT * 3 * XBCW, O_SFFC = O_SGLA + (size_t)2 * SBT * 4 * 256 * 512, O_END = O_SFFC + (size_t)2 * SBT * 2 * DFF2;
constexpr size_t A256(size_t x) { return (x + 255) & ~(size_t)255; }
constexpr size_t WS_CTL = 0, CTL_BYTES = 1u << 20;
constexpr size_t WS_WIN = WS_CTL + CTL_BYTES;
constexpr size_t WS_WB0 = WS_WIN + (size_t)NPROJ_PAD * DM * 2;
constexpr size_t WS_WB1 = WS_WB0 + (size_t)DM * DM * 2, WS_WOUT = WS_WB1 + (size_t)DM * DM * 2, WS_WMQ = WS_WOUT + (size_t)DM * DM * 2, WS_WMO = WS_WMQ + (size_t)DM * DM * 2;
constexpr size_t WS_WFI = WS_WMO + (size_t)DM * DM * 2;
constexpr size_t WS_WFO = WS_WFI + (size_t)DFF2 * DM * 2;
constexpr size_t WS_WKV = WS_WFO + (size_t)DM * DFF * 2;
constexpr size_t WS_X = WS_WKV + (size_t)8192 * DM * 2;
constexpr size_t WS_H = WS_X + (size_t)T * DM * 4;
constexpr size_t WS_PROJ = WS_H + (size_t)T * DM * 2;
constexpr size_t WS_SMALL = WS_PROJ + (size_t)T * NPROJ * 2;
constexpr size_t WS_XBC = WS_SMALL + (size_t)T * 256 * 4;
constexpr size_t WS_DT = WS_XBC + (size_t)T * XBCW * 2;
constexpr size_t WS_LOGA = WS_DT + (size_t)T * 32 * 4;
constexpr size_t WS_YSR = WS_LOGA + (size_t)T * 1024 * 4;
constexpr size_t WS_YGR = WS_YSR + (size_t)T * DM * 4;
constexpr size_t WS_YS = WS_YGR + (size_t)T * DM * 4;
constexpr size_t WS_YG = WS_YS + (size_t)T * DM * 2;
constexpr size_t WS_MRG = WS_YG + (size_t)T * DM * 2;
constexpr size_t WS_KP = WS_MRG + (size_t)T * DM * 2;
constexpr size_t WS_VTP = WS_KP + (size_t)2 * NB * MTOK * DM * 2;
constexpr size_t WS_KS = WS_VTP + (size_t)2 * NB * MTOK * DM * 2;
constexpr size_t WS_VTS = WS_KS + (size_t)2 * SBT * MTOK * DM * 2;
constexpr size_t WS_MEMP = WS_VTS + (size_t)2 * SBT * MTOK * DM * 2;
constexpr int NCK = T / 16, NCP = TP / 64, NCS = NCP + SBT;
static_assert(SEQ % 64 == 0, "SSD chunks must not straddle sequences");
constexpr size_t WS_WCH = WS_MEMP + (size_t)NB * MTOK * DM * 2;
constexpr size_t WS_XT = WS_WCH + (size_t)NCS * 32 * 64 * 64 * 2;
constexpr size_t WS_END0 = WS_XT + (size_t)NCS * DM * 64 * 2;
constexpr size_t WS_VT16 = WS_H;
constexpr size_t WS_QD = WS_MRG, WS_KET = WS_MRG + (size_t)T * 1024 * 2;
constexpr size_t WS_DEC = WS_WKV, WS_ATT = WS_DEC + (size_t)NCK * 1024 * 4, WS_EA = WS_ATT + (size_t)NCK * 4 * 256 * 2, WS_DECS = WS_EA + (size_t)NCS * 32 * 64 * 4;
constexpr size_t SZ_XTE = (size_t)NCS * DM * 64 * 2, SZ_BT = (size_t)NCS * 512 * 64 * 2, SZ_CC = (size_t)NCS * 64 * 512 * 2;
constexpr bool OVL_Y = SZ_XTE + SZ_BT + SZ_CC <= (size_t)2 * T * DM * 2;
constexpr size_t WS_XTE = OVL_Y ? WS_YS : WS_END0, WS_BT = WS_XTE + SZ_XTE, WS_CC = WS_BT + SZ_BT;
constexpr size_t WS_END = OVL_Y ? WS_END0 : WS_CC + SZ_CC;
static_assert(WS_DECS + (size_t)NCS * 32 * 4 <= WS_WKV + (size_t)8192 * DM * 2, "scan operand overlays");
static_assert((size_t)T * DFF * 2 <= (size_t)2 * T * DM * 4, "ACT overlay");
static_assert(WS_END <= (size_t)1081389824, "workspace budget");
constexpr size_t WS_SS = WS_CTL + 65536;
static_assert(65536 + (size_t)7 * T * 4 <= CTL_BYTES, "SS slots inside the zeroed control region");
constexpr int LDS_BYTES = 147456;
constexpr int LDS_CTL_OFF = 131072;

namespace pg8 {
constexpr int BM = 256, BK = 64, HALF = 128, HTB = HALF * BK * 2, STAGE_BYTES = 8 * HTB, NXCD = 8, WGM = 8;
__host__ __device__ __forceinline__ int lds_byte(int r, int c) { const int st = (r >> 4) * 2 + (c >> 5), rr = r & 15, cc = c & 31, ob = rr * 64 + cc * 2; return st * 1024 + (ob ^ (((ob >> 9) & 1) << 5)); }
__host__ __device__ __forceinline__ void stage_rc(int b, int& R, int& C) { const int st = b / 1024, sb = b % 1024, swz = sb ^ (((sb >> 9) & 1) << 5); R = (st >> 1) * 16 + swz / 64; C = (st & 1) * 32 + (swz % 64) / 2; }
__host__ __device__ __forceinline__ int perm32(int rho) { const int n = rho >> 4, i = rho & 15; return 8 * (i >> 2) + 4 * n + (i & 3); }
struct Unit { int pm, pn; };
struct Gemm { const bf16* A; const bf16* Bt; int M, N, K; };
struct StaticOrder {
    int nM, nN, nwg, G, c;
    __host__ __device__ void init(int M, int N, int G_, int c_) { nM = M / BM; nN = N / BM; nwg = nM * nN; G = G_; c = c_; }
    __host__ __device__ bool next(int i, Unit& u) const {
        const long L = (long)i * G + c; if (L >= nwg) return false;
        int wgid = (int)L; { const int q = nwg / NXCD, r = nwg % NXCD, xcd = wgid % NXCD, off = wgid / NXCD; wgid = (xcd < r ? xcd * (q + 1) : r * (q + 1) + (xcd - r) * q) + off; }
        const int nig = WGM * nN, gid = wgid / nig, fm = gid * WGM, gsz = (nM - fm) < WGM ? (nM - fm) : WGM;
        u.pm = fm + ((wgid % nig) % gsz); u.pn = (wgid % nig) / gsz; return true;
    }
};
template <class Epi, bool ALIGN_EPI>
__device__ __forceinline__ void gemm_phase(LAS unsigned char* lds, const int tid, const Gemm g, const StaticOrder& S, const Epi& E) {
    const int wid = __builtin_amdgcn_readfirstlane(tid >> 6), lane = tid & 63, wr = wid >> 2, wc = wid & 3, fr = lane & 15, fq = lane >> 4;
    const int K = g.K, nt = K / BK;
    unsigned voffA[2], voffB[2];
#pragma unroll
    for (int i = 0; i < 2; ++i) { int R, C; stage_rc(tid * 16 + i * 8192, R, C); const int Rb = Epi::PERM ? ((R & ~31) + perm32(R & 31)) : R;
        voffA[i] = (unsigned)(R * K + C) * 2u; voffB[i] = (unsigned)(Rb * K + C) * 2u; }
    const size_t kstep = (size_t)(BK * 2), hstep = (size_t)HALF * K * 2, tstep = 2 * hstep;
    const unsigned ldsw = (unsigned)wid * 1024u;
    const int aoff = lds_byte(wr * 64 + fr, fq * 8), boff = lds_byte(wc * 32 + fr, fq * 8);
#define PG8_SA(b, h) (((b) * 2 + (h)) * HTB)
#define PG8_SB(b, h) ((4 + (b) * 2 + (h)) * HTB)
#define PG8_STAGE(bufoff, gbase, voff) do { _Pragma("unroll") for (int _i = 0; _i < 2; ++_i) \
        __builtin_amdgcn_global_load_lds((const unsigned*)((const char*)(gbase) + (voff)[_i]), (LAS unsigned*)(lds + (bufoff) + ldsw + _i * 8192), 16, 0, 0); } while (0)
#define PG8_LDA(dst, b, h) do { _Pragma("unroll") for (int m = 0; m < 4; ++m) _Pragma("unroll") for (int k = 0; k < 2; ++k) dst[m][k] = *(const LAS bf16x8*)(lds + PG8_SA(b, h) + aoff + m * 2048 + k * 1024); } while (0)
#define PG8_LDB(dst, b, h) do { _Pragma("unroll") for (int n = 0; n < 2; ++n) _Pragma("unroll") for (int k = 0; k < 2; ++k) dst[n][k] = *(const LAS bf16x8*)(lds + PG8_SB(b, h) + boff + n * 2048 + k * 1024); } while (0)
#define PG8_MMA(ai, bj, At, Bt) do { __builtin_amdgcn_s_setprio(1); _Pragma("unroll") for (int m = 0; m < 4; ++m) _Pragma("unroll") for (int n = 0; n < 2; ++n) _Pragma("unroll") for (int k = 0; k < 2; ++k) \
        acc[ai][bj][m][n] = __builtin_amdgcn_mfma_f32_16x16x32_bf16(Bt[n][k], At[m][k], acc[ai][bj][m][n], 0, 0, 0); __builtin_amdgcn_s_setprio(0); } while (0)
#define PG8_BAR __builtin_amdgcn_s_barrier()
#define PG8_SCHED __builtin_amdgcn_sched_barrier(0)
    Unit cur, nxt; int ui = 0;
    if (!S.next(0, cur)) return;
    float zf = 0.f; LAUNDER_V(zf);
    f32x4 acc[2][2][4][2];
#pragma unroll
    for (int a = 0; a < 2; ++a)
#pragma unroll
        for (int b = 0; b < 2; ++b)
#pragma unroll
            for (int m = 0; m < 4; ++m)
#pragma unroll
                for (int n = 0; n < 2; ++n) acc[a][b][m][n] = (f32x4){zf, zf, zf, zf};
    bf16x8 At[4][2], B0[2][2], B1[2][2];
    const char* cA = (const char*)g.A + (size_t)cur.pm * tstep; const char* cB = (const char*)g.Bt + (size_t)cur.pn * tstep;
    PG8_STAGE(PG8_SB(0, 0), cB, voffB); PG8_STAGE(PG8_SB(0, 1), cB + hstep, voffB); PG8_STAGE(PG8_SA(0, 0), cA, voffA); PG8_STAGE(PG8_SA(0, 1), cA + hstep, voffA);
    if (wr == 1) PG8_BAR;
    VMCNT(2); PG8_BAR;
    PG8_STAGE(PG8_SB(1, 0), cB + kstep, voffB); PG8_STAGE(PG8_SA(1, 0), cA + kstep, voffA); PG8_STAGE(PG8_SB(1, 1), cB + hstep + kstep, voffB);
    VMCNT(6); PG8_BAR;
    for (;;) {
        const bool has_next = S.next(ui + 1, nxt);
        const char* nA = has_next ? (const char*)g.A + (size_t)nxt.pm * tstep : cA; const char* nB = has_next ? (const char*)g.Bt + (size_t)nxt.pn * tstep : cB;
        for (int t = 0; t < nt; t += 2) {
            const bool last = (t == nt - 2);
            const char* a1 = cA + (size_t)(t + 1) * kstep;
            const char* a2 = last ? nA : cA + (size_t)(t + 2) * kstep; const char* b2 = last ? nB : cB + (size_t)(t + 2) * kstep;
            const char* a3 = a2 + kstep; const char* b3 = b2 + kstep;
            PG8_LDB(B0, 0, 0); PG8_LDB(B1, 0, 1); PG8_SCHED; PG8_LDA(At, 0, 0); PG8_STAGE(PG8_SA(1, 1), a1 + hstep, voffA);
            VMCNT(8); LGKMCNT(0); PG8_BAR; PG8_MMA(0, 0, At, B0); PG8_MMA(0, 1, At, B1); PG8_BAR; PG8_SCHED;
            PG8_LDA(At, 0, 1); PG8_STAGE(PG8_SB(0, 0), b2, voffB); PG8_STAGE(PG8_SB(0, 1), b2 + hstep, voffB); PG8_STAGE(PG8_SA(0, 0), a2, voffA);
            VMCNT(8); LGKMCNT(0); PG8_BAR; PG8_MMA(1, 0, At, B0); PG8_MMA(1, 1, At, B1); PG8_BAR; PG8_SCHED;
            PG8_LDB(B0, 1, 0); PG8_LDB(B1, 1, 1); PG8_SCHED; PG8_LDA(At, 1, 0); PG8_STAGE(PG8_SA(0, 1), a2 + hstep, voffA);
            VMCNT(8); LGKMCNT(0); PG8_BAR; PG8_MMA(0, 0, At, B0); PG8_MMA(0, 1, At, B1); PG8_BAR; PG8_SCHED;
            PG8_LDA(At, 1, 1); PG8_STAGE(PG8_SB(1, 0), b3, voffB); PG8_STAGE(PG8_SB(1, 1), b3 + hstep, voffB); PG8_STAGE(PG8_SA(1, 0), a3, voffA);
            VMCNT(8); LGKMCNT(0); PG8_BAR; PG8_MMA(1, 0, At, B0); PG8_MMA(1, 1, At, B1); PG8_BAR; PG8_SCHED;
        }
        if constexpr (ALIGN_EPI) { if (wr == 0) PG8_BAR; }
        E(acc, cur, wr, wc, fr, fq);
        if (!has_next) break;
#pragma unroll
        for (int a = 0; a < 2; ++a)
#pragma unroll
            for (int b = 0; b < 2; ++b)
#pragma unroll
                for (int m = 0; m < 4; ++m)
#pragma unroll
                    for (int n = 0; n < 2; ++n) acc[a][b][m][n] = (f32x4){zf, zf, zf, zf};
        cur = nxt; cA = nA; cB = nB; ++ui;
        if constexpr (ALIGN_EPI) { if (wr == 1) PG8_BAR; }
    }
    VMCNT(0);
    if constexpr (!ALIGN_EPI) { if (wr == 0) PG8_BAR; }
    PG8_BAR;
#undef PG8_SA
#undef PG8_SB
#undef PG8_STAGE
#undef PG8_LDA
#undef PG8_LDB
#undef PG8_MMA
#undef PG8_BAR
#undef PG8_SCHED
}
}
using pg8::Unit;

#define EPI_LOOP_ROWS for (int ai = 0; ai < 2; ++ai) _Pragma("unroll") for (int m = 0; m < 4; ++m)
__device__ __forceinline__ float row_rstd(const float* SS, int row) { return 1.0f / sqrtf(SS[row] * (1.0f / DM) + EPSF); }
struct EpiBf16 {
    static constexpr bool PERM = true;
    bf16* O; int ldc; const float* SS;
    __device__ __forceinline__ void operator()(const f32x4 (&acc)[2][2][4][2], const Unit& u, int wr, int wc, int fr, int fq) const {
        const int row0 = u.pm * 256 + wr * 64 + fr, col0 = u.pn * 256 + wc * 32 + 8 * fq;
#pragma unroll
        EPI_LOOP_ROWS { const int row = row0 + ai * 128 + m * 16; const float rs = row_rstd(SS, row); bf16* rowp = O + (size_t)row * ldc + col0;
#pragma unroll
            for (int bj = 0; bj < 2; ++bj) { const f32x4 v0 = acc[ai][bj][m][0] * rs, v1 = acc[ai][bj][m][1] * rs;
                u32x4 w; w.x = cvt_pk_bf16(v0[0], v0[1]); w.y = cvt_pk_bf16(v0[2], v0[3]); w.z = cvt_pk_bf16(v1[0], v1[1]); w.w = cvt_pk_bf16(v1[2], v1[3]);
                *(u32x4*)(rowp + bj * 128) = w; } }
    }
};
struct EpiProj {
    static constexpr bool PERM = true;
    bf16* P; float* Sm; const float* SS;
    __device__ __forceinline__ void operator()(const f32x4 (&acc)[2][2][4][2], const Unit& u, int wr, int wc, int fr, int fq) const {
        const int row0 = u.pm * 256 + wr * 64 + fr;
        if (u.pn < NPROJ / 256) {
            const int col0 = u.pn * 256 + wc * 32 + 8 * fq;
#pragma unroll
            EPI_LOOP_ROWS { const int row = row0 + ai * 128 + m * 16; const float rs = row_rstd(SS, row); bf16* rowp = P + (size_t)row * NPROJ + col0;
#pragma unroll
                for (int bj = 0; bj < 2; ++bj) { const f32x4 v0 = acc[ai][bj][m][0] * rs, v1 = acc[ai][bj][m][1] * rs;
                    u32x4 w; w.x = cvt_pk_bf16(v0[0], v0[1]); w.y = cvt_pk_bf16(v0[2], v0[3]); w.z = cvt_pk_bf16(v1[0], v1[1]); w.w = cvt_pk_bf16(v1[2], v1[3]);
                    *(u32x4*)(rowp + bj * 128) = w; } }
        } else {
            const int col0 = wc * 32 + 8 * fq;
#pragma unroll
            EPI_LOOP_ROWS { const int row = row0 + ai * 128 + m * 16; const float rs = row_rstd(SS, row); float* rowp = Sm + (size_t)row * 256 + col0;
#pragma unroll
                for (int bj = 0; bj < 2; ++bj) { *(f32x4*)(rowp + bj * 128) = acc[ai][bj][m][0] * rs; *(f32x4*)(rowp + bj * 128 + 4) = acc[ai][bj][m][1] * rs; } }
        }
    }
};
struct EpiGate0 {
    static constexpr bool PERM = false;
    const bf16* P; float* M0;
    __device__ __forceinline__ void operator()(const f32x4 (&acc)[2][2][4][2], const Unit& u, int wr, int wc, int fr, int fq) const {
        const int row0 = u.pm * 256 + wr * 64 + fr, col0 = u.pn * 256 + wc * 32 + 4 * fq;
#pragma unroll
        EPI_LOOP_ROWS { const size_t r = (size_t)(row0 + ai * 128 + m * 16);
#pragma unroll
            for (int bj = 0; bj < 2; ++bj)
#pragma unroll
                for (int n = 0; n < 2; ++n) { const int c = col0 + bj * 128 + n * 16; const u32x2 gw = *(const u32x2*)(P + r * NPROJ + PGATE + c); const f32x4 a = acc[ai][bj][m][n];
                    f32x4 o; o[0] = a[0] * sigmoidf_(bf_lo(gw.x)); o[1] = a[1] * sigmoidf_(bf_hi(gw.x)); o[2] = a[2] * sigmoidf_(bf_lo(gw.y)); o[3] = a[3] * sigmoidf_(bf_hi(gw.y));
                    *(f32x4*)(M0 + r * DM + c) = o; } }
    }
};
struct EpiGate1 {
    static constexpr bool PERM = true;
    const bf16* P; const float* M0; bf16* O;
    __device__ __forceinline__ void operator()(const f32x4 (&acc)[2][2][4][2], const Unit& u, int wr, int wc, int fr, int fq) const {
        const int row0 = u.pm * 256 + wr * 64 + fr, col0 = u.pn * 256 + wc * 32 + 8 * fq;
#pragma unroll
        EPI_LOOP_ROWS { const size_t r = (size_t)(row0 + ai * 128 + m * 16);
#pragma unroll
            for (int bj = 0; bj < 2; ++bj) { const int c = col0 + bj * 128; const u32x4 gw = *(const u32x4*)(P + r * NPROJ + PGATE + DM + c); float gv[8]; unpack8(gw, gv);
                const f32x4 m0 = *(const f32x4*)(M0 + r * DM + c), m1 = *(const f32x4*)(M0 + r * DM + c + 4); const f32x4 a0 = acc[ai][bj][m][0], a1 = acc[ai][bj][m][1];
                float o[8];
#pragma unroll
                for (int j = 0; j < 4; ++j) { o[j] = m0[j] + a0[j] * sigmoidf_(gv[j]); o[4 + j] = m1[j] + a1[j] * sigmoidf_(gv[4 + j]); }
                *(u32x4*)(O + r * DM + c) = pack8(o); } }
    }
};
struct EpiResid {
    static constexpr bool PERM = false;
    float* X; bf16* H; float* SS;
    __device__ __forceinline__ void operator()(const f32x4 (&acc)[2][2][4][2], const Unit& u, int wr, int wc, int fr, int fq) const {
        const int row0 = u.pm * 256 + wr * 64 + fr, col0 = u.pn * 256 + wc * 32 + 4 * fq;
#pragma unroll
        EPI_LOOP_ROWS { const int row = row0 + ai * 128 + m * 16; float* rowp = X + (size_t)row * DM + col0; bf16* hp = H + (size_t)row * DM + col0; float ss = 0.f;
#pragma unroll
            for (int bj = 0; bj < 2; ++bj)
#pragma unroll
                for (int n = 0; n < 2; ++n) { f32x4* p = (f32x4*)(rowp + bj * 128 + n * 16); const f32x4 x = *p + acc[ai][bj][m][n]; *p = x;
                    ss += (x[0] * x[0] + x[1] * x[1]) + (x[2] * x[2] + x[3] * x[3]);
                    u32x2 w; w.x = cvt_pk_bf16(x[0], x[1]); w.y = cvt_pk_bf16(x[2], x[3]); *(u32x2*)(hp + bj * 128 + n * 16) = w; }
            ss += __shfl_xor(ss, 16); ss += __shfl_xor(ss, 32);
            if (fq == 0) atomicAdd(SS + row, ss); }
    }
};
struct EpiMemKV {
    static constexpr bool PERM = false;
    float* out; bf16* KP; bf16* VTP;
    __device__ __forceinline__ void operator()(const f32x4 (&acc)[2][2][4][2], const Unit& u, int wr, int wc, int fr, int fq) const {
        const int row0 = u.pm * 256 + wr * 64 + fr, colt = u.pn * 256, l = colt / 4096, kv = (colt / 2048) & 1, cbase = (colt & 2047) + wc * 32 + 4 * fq;
        float* dst = out + (kv ? O_PMV : O_PMK) + (size_t)l * NB * MTOK * DM;
#pragma unroll
        EPI_LOOP_ROWS { const int r = row0 + ai * 128 + m * 16, b = r >> 8, mt = r & 255;
#pragma unroll
            for (int bj = 0; bj < 2; ++bj)
#pragma unroll
                for (int n = 0; n < 2; ++n) { const int c = cbase + bj * 128 + n * 16; const f32x4 a = acc[ai][bj][m][n];
                    *(f32x4*)(dst + (size_t)r * DM + c) = a;
                    if (!kv) { u32x2 w; w.x = cvt_pk_bf16(a[0], a[1]); w.y = cvt_pk_bf16(a[2], a[3]); *(u32x2*)(KP + ((size_t)l * NB * MTOK + r) * DM + c) = w; }
                    else { bf16* vt = VTP + (((size_t)l * NB + b) * DM + c) * MTOK + mt;
#pragma unroll
                        for (int j = 0; j < 4; ++j) vt[(size_t)j * MTOK] = (bf16)f2bf(a[j]); } } }
    }
};

struct Args { const float* in[33]; float* out; unsigned char* ws; int ph_lo, ph_hi; };
#ifdef HOST_EMU
struct Ctx {
    LAS unsigned char* lds; int tid, lane, wave, G, bid;
    const Args* ap; float* out; unsigned char* ws;
    __device__ __forceinline__ const float* in(int i) const { return ap->in[i]; }
};
#else
#define CAS __attribute__((address_space(4)))
struct Ctx {
    LAS unsigned char* lds; int tid, lane, wave, G, bid;
    const CAS unsigned char* kp; float* out; unsigned char* ws;
    __device__ __forceinline__ const float* in(int i) const { return ((const float* const CAS*)kp)[i]; }
};
#endif
#define WSP(type, off) ((type*)(C.ws + (off)))

template <class RowMap>
__device__ __forceinline__ void transpose_item(const float* W, int K, int N, bf16* WT, const float* gain, LAS float* scr, int item, int lane, RowMap rowmap) {
    const int nblk = (N + 31) / 32, kb = item / nblk, nb = item % nblk, k0 = 64 * kb, n0 = 32 * nb;
    float vv[32]; const int nn = n0 + (lane & 31); const bool nok = nn < N; const float* wp = W + (size_t)(k0 + (lane >> 5)) * N + (nok ? nn : 0);
#pragma unroll
    for (int i = 0; i < 32; ++i) vv[i] = nok ? wp[(size_t)(2 * i) * N] : 0.f;
    if (gain) {
#pragma unroll
        for (int i = 0; i < 32; ++i) vv[i] *= gain[k0 + 2 * i + (lane >> 5)]; }
#pragma unroll
    for (int i = 0; i < 32; ++i) scr[(2 * i + (lane >> 5)) * 33 + (lane & 31)] = vv[i];
    WAVE_LDS_SYNC();
    const int c = lane & 7;
#pragma unroll
    for (int j = 0; j < 4; ++j) { const int n = (lane >> 3) + 8 * j; const LAS float* s = scr + (8 * c) * 33 + n;
        if (n0 + n < N) { u32x4 o; o.x = cvt_pk_bf16(s[0 * 33], s[1 * 33]); o.y = cvt_pk_bf16(s[2 * 33], s[3 * 33]); o.z = cvt_pk_bf16(s[4 * 33], s[5 * 33]); o.w = cvt_pk_bf16(s[6 * 33], s[7 * 33]);
            *(u32x4*)(WT + (size_t)rowmap(n0 + n) * K + k0 + 8 * c) = o; } }
    WAVE_LDS_SYNC();
}
struct RowId { int off; __device__ __forceinline__ int operator()(int n) const { return off + n; } };
struct RowWin { __device__ __forceinline__ int operator()(int n) const {
    return n < 5120 ? n : n < 5152 ? NPROJ + (n - 5120) : n < 11296 ? n - 32 : n < 11312 ? NPROJ + 32 + (n - 11296) : n - 48; } };

__device__ __forceinline__ void phase_wconv(const Ctx& C, int l) {
    LAS float* scr = (LAS float*)(C.lds + C.wave * 16384);
    const int gw = C.bid * 8 + C.wave, NGW = C.G * 8;
    const int I_IN = (DM / 64) * ((IN_DIM + 31) / 32), I_SQ = (DM / 64) * (DM / 32), I_FI = (DM / 64) * (DFF2 / 32), I_FO = (DFF / 64) * (DM / 32);
    const int NIT = I_IN + 5 * I_SQ + I_FI + I_FO;
    for (int it = gw; it < NIT; it += NGW) {
        int r = it;
        if (r < I_IN) { transpose_item(C.in(10) + (size_t)l * DM * IN_DIM, DM, IN_DIM, WSP(bf16, WS_WIN), C.in(9) + l * DM, scr, r, C.lane, RowWin{}); continue; } r -= I_IN;
        if (r < I_SQ) { transpose_item(C.in(20) + (size_t)(l * 2 + 0) * DM * DM, DM, DM, WSP(bf16, WS_WB0), (const float*)nullptr, scr, r, C.lane, RowId{0}); continue; } r -= I_SQ;
        if (r < I_SQ) { transpose_item(C.in(20) + (size_t)(l * 2 + 1) * DM * DM, DM, DM, WSP(bf16, WS_WB1), (const float*)nullptr, scr, r, C.lane, RowId{0}); continue; } r -= I_SQ;
        if (r < I_SQ) { transpose_item(C.in(21) + (size_t)l * DM * DM, DM, DM, WSP(bf16, WS_WOUT), (const float*)nullptr, scr, r, C.lane, RowId{0}); continue; } r -= I_SQ;
        if (r < I_SQ) { transpose_item(C.in(23) + (size_t)l * DM * DM, DM, DM, WSP(bf16, WS_WMQ), C.in(22) + l * DM, scr, r, C.lane, RowId{0}); continue; } r -= I_SQ;
        if (r < I_SQ) { transpose_item(C.in(26) + (size_t)l * DM * DM, DM, DM, WSP(bf16, WS_WMO), (const float*)nullptr, scr, r, C.lane, RowId{0}); continue; } r -= I_SQ;
        if (r < I_FI) { transpose_item(C.in(28) + (size_t)l * DM * DFF2, DM, DFF2, WSP(bf16, WS_WFI), C.in(27) + l * DM, scr, r, C.lane, RowId{0}); continue; } r -= I_FI;
        transpose_item(C.in(31) + (size_t)l * DFF * DM, DFF, DM, WSP(bf16, WS_WFO), (const float*)nullptr, scr, r, C.lane, RowId{0});
    }
    { u32x4* z = (u32x4*)(WSP(bf16, WS_WIN) + (size_t)(NPROJ + 48) * DM); const size_t n16 = (size_t)(NPROJ_PAD - NPROJ - 48) * DM * 2 / 16;
      for (size_t i = (size_t)C.bid * 512 + C.tid; i < n16; i += (size_t)C.G * 512) z[i] = zero16(); }
}
__device__ __forceinline__ void phase_prologue(const Ctx& C) {
    const size_t gt = (size_t)C.bid * 512 + C.tid, NT = (size_t)C.G * 512;
    { const f32x4* s = (const f32x4*)C.in(2); u32x2* d = WSP(u32x2, WS_MEMP); const size_t n = (size_t)NB * MTOK * DM / 4;
      for (size_t i = gt; i < n; i += NT) { const f32x4 v = s[i]; u32x2 w; w.x = cvt_pk_bf16(v[0], v[1]); w.y = cvt_pk_bf16(v[2], v[3]); d[i] = w; } }
    { const f32x4* s = (const f32x4*)C.in(7); u32x2* d = WSP(u32x2, WS_KS); const size_t n = (size_t)2 * SBT * MTOK * DM / 4;
      for (size_t i = gt; i < n; i += NT) { const f32x4 v = s[i]; u32x2 w; w.x = cvt_pk_bf16(v[0], v[1]); w.y = cvt_pk_bf16(v[2], v[3]); d[i] = w; } }
    LAS float* scr = (LAS float*)(C.lds + C.wave * 16384);
    const int gw = C.bid * 8 + C.wave, NGW = C.G * 8;
    const int I_V = (MTOK / 64) * (DM / 32), I_SQ = (DM / 64) * (DM / 32);
    const int NIT = 2 * SBT * I_V + 4 * I_SQ;
    for (int it = gw; it < NIT; it += NGW) {
        if (it < 2 * SBT * I_V) { const int lb = it / I_V, r = it % I_V;
            transpose_item(C.in(8) + (size_t)lb * MTOK * DM, MTOK, DM, WSP(bf16, WS_VTS) + (size_t)lb * DM * MTOK, (const float*)nullptr, scr, r, C.lane, RowId{0}); }
        else { const int q = (it - 2 * SBT * I_V) / I_SQ, r = (it - 2 * SBT * I_V) % I_SQ, l = q >> 1, kv = q & 1;
            transpose_item(C.in(kv ? 25 : 24) + (size_t)l * DM * DM, DM, DM, WSP(bf16, WS_WKV), (const float*)nullptr, scr, r, C.lane, RowId{q * DM}); }
    }
}
__device__ __forceinline__ void phase_xprep(const Ctx& C) {
    const int gw = C.bid * 8 + C.wave, NGW = C.G * 8;
    for (int row = gw; row < T; row += NGW) {
        const f32x4* xr = (row < TP ? (const f32x4*)C.in(0) + (size_t)row * (DM / 4) : (const f32x4*)C.in(1) + (size_t)(row - TP) * (DM / 4)) + C.lane; f32x4 v[8]; float s = 0.f;
#pragma unroll
        for (int j = 0; j < 8; ++j) { v[j] = xr[64 * j]; s += (v[j][0] * v[j][0] + v[j][1] * v[j][1]) + (v[j][2] * v[j][2] + v[j][3] * v[j][3]); }
        s = wave_sum(s); if (C.lane == 0) WSP(float, WS_SS)[row] = s;
        u32x2* o = WSP(u32x2, WS_H) + (size_t)row * (DM / 4) + C.lane; f32x4* xo = WSP(f32x4, WS_X) + (size_t)row * (DM / 4) + C.lane;
#pragma unroll
        for (int j = 0; j < 8; ++j) { u32x2 w; w.x = cvt_pk_bf16(v[j][0], v[j][1]); w.y = cvt_pk_bf16(v[j][2], v[j][3]); o[64 * j] = w; xo[64 * j] = v[j]; }
    }
}
__device__ __forceinline__ void phase_final(const Ctx& C) {
    const int gw = C.bid * 8 + C.wave, NGW = C.G * 8; const f32x4* gn = (const f32x4*)C.in(32) + C.lane;
    for (int row = gw; row < T; row += NGW) {
        const f32x4* xr = WSP(const f32x4, WS_X) + (size_t)row * (DM / 4) + C.lane; f32x4 v[8];
#pragma unroll
        for (int j = 0; j < 8; ++j) v[j] = xr[64 * j];
        const float rstd = row_rstd(WSP(const float, WS_SS) + (size_t)6 * T, row);
        f32x4* o = (f32x4*)(C.out + O_Y) + (size_t)row * (DM / 4) + C.lane;
#pragma unroll
        for (int j = 0; j < 8; ++j) o[64 * j] = v[j] * rstd * gn[64 * j];
    }
}
struct SeqInfo { int sample, b, t, L, row0; };
__device__ __forceinline__ SeqInfo seq_of_row(int row) { SeqInfo s; if (row < TP) { s.sample = 0; s.b = row / SEQ; s.t = row % SEQ; s.L = SEQ; s.row0 = s.b * SEQ; } else { const int r = row - TP; s.sample = 1; s.b = r / SSQ; s.t = r % SSQ; s.L = SSQ; s.row0 = TP + s.b * SSQ; } return s; }
__device__ __forceinline__ SeqInfo seq_of_idx(int sq) { SeqInfo s; if (sq < NB) { s.sample = 0; s.b = sq; s.L = SEQ; s.row0 = sq * SEQ; } else { s.sample = 1; s.b = sq - NB; s.L = SSQ; s.row0 = TP + s.b * SSQ; } s.t = 0; return s; }

__device__ __forceinline__ void phase_prep_conv(const Ctx& C, int l) {
    const size_t gt = (size_t)C.bid * 512 + C.tid, NT = (size_t)C.G * 512;
    const bf16* P = WSP(const bf16, WS_PROJ); const float* Sm = WSP(const float, WS_SMALL);
    const float* cw = C.in(11) + (size_t)l * 4 * XBCW; const float* cb = C.in(12) + (size_t)l * XBCW; const float* st = C.in(4) + (size_t)l * SBT * 3 * XBCW;
    for (size_t it = gt; it < (size_t)(T / 16) * (XBCW / 8); it += NT) {
        const int seg = (int)(it / (XBCW / 8)), c = (int)(it % (XBCW / 8)) * 8, row0 = seg * 16; const SeqInfo s = seq_of_row(row0);
        u32x4 raw[19];
#pragma unroll
        for (int i = 0; i < 16; ++i) raw[3 + i] = *(const u32x4*)(P + (size_t)(row0 + i) * NPROJ + PXBC + c);
        float w[4][8], bias[8];
#pragma unroll
        for (int i = 0; i < 4; ++i) { const f32x4 a = *(const f32x4*)(cw + i * XBCW + c), b = *(const f32x4*)(cw + i * XBCW + c + 4);
#pragma unroll
            for (int j = 0; j < 4; ++j) { w[i][j] = a[j]; w[i][4 + j] = b[j]; } }
        { const f32x4 a = *(const f32x4*)(cb + c), b = *(const f32x4*)(cb + c + 4);
#pragma unroll
          for (int j = 0; j < 4; ++j) { bias[j] = a[j]; bias[4 + j] = b[j]; } }
        float hist[3][8];
        if (s.t >= 3) {
#pragma unroll
            for (int i = 0; i < 3; ++i) { raw[i] = *(const u32x4*)(P + (size_t)(row0 - 3 + i) * NPROJ + PXBC + c); unpack8(raw[i], hist[i]); } }
        else if (s.sample) {
#pragma unroll
            for (int i = 0; i < 3; ++i) { const float* sp = st + ((size_t)s.b * 3 + i) * XBCW + c;
#pragma unroll
                for (int j = 0; j < 8; ++j) hist[i][j] = sp[j]; } }
        else {
#pragma unroll
            for (int i = 0; i < 3; ++i)
#pragma unroll
                for (int j = 0; j < 8; ++j) hist[i][j] = 0.f; }
#pragma unroll
        for (int i = 0; i < 16; ++i) { float cur[8], o[8]; unpack8(raw[3 + i], cur);
#pragma unroll
            for (int j = 0; j < 8; ++j) { o[j] = siluf_(bias[j] + hist[0][j] * w[0][j] + hist[1][j] * w[1][j] + hist[2][j] * w[2][j] + cur[j] * w[3][j]); hist[0][j] = hist[1][j]; hist[1][j] = hist[2][j]; hist[2][j] = cur[j]; }
            *(u32x4*)(WSP(bf16, WS_XBC) + (size_t)(row0 + i) * XBCW + c) = pack8(o); }
    }
    for (size_t it = gt; it < (size_t)NSEQ * 3 * XBCW; it += NT) {
        const int c = (int)(it % XBCW), j = (int)(it / XBCW) % 3, sq = (int)(it / (3 * XBCW)); const SeqInfo s = seq_of_idx(sq);
        const float v = bf2f(P[(size_t)(s.row0 + s.L - 3 + j) * NPROJ + PXBC + c]);
        float* dst = C.out + (s.sample ? O_SSSDC + ((size_t)l * SBT + s.b) * 3 * XBCW : O_PSSDC + ((size_t)l * NB + s.b) * 3 * XBCW);
        dst[j * XBCW + c] = v;
    }
    for (size_t it = gt; it < (size_t)T * 32; it += NT) { const int row = (int)(it >> 5), h = (int)(it & 31);
        WSP(float, WS_DT)[it] = softplusf_(Sm[(size_t)row * 256 + h] + C.in(13)[l * 32 + h]); }
}

typedef short bf16x4 __attribute__((ext_vector_type(4)));
#define MFMA32(a, b, c) __builtin_amdgcn_mfma_f32_16x16x32_bf16(a, b, c, 0, 0, 0)
#define MFMA16(a, b, c) __builtin_amdgcn_mfma_f32_16x16x16bf16_1k(a, b, c, 0, 0, 0)
__device__ __forceinline__ bf16x8 mk8(u32x2 lo, u32x2 hi) { u32x4 w; w.x = lo.x; w.y = lo.y; w.z = hi.x; w.w = hi.y; return __builtin_bit_cast(bf16x8, w); }
__device__ __forceinline__ bf16x8 pack_tiles(const f32x4 t0, const f32x4 t1) { u32x4 w; w.x = cvt_pk_bf16(t0[0], t0[1]); w.y = cvt_pk_bf16(t0[2], t0[3]); w.z = cvt_pk_bf16(t1[0], t1[1]); w.w = cvt_pk_bf16(t1[2], t1[3]); return __builtin_bit_cast(bf16x8, w); }
struct ChunkInfo { int row0, nvalid; };
__device__ __forceinline__ ChunkInfo ssd_chunk(int cs) { ChunkInfo c; if (cs < NCP) { c.row0 = 64 * cs; c.nvalid = 64; } else { c.row0 = TP + SSQ * (cs - NCP); c.nvalid = SSQ; } return c; }

__device__ __forceinline__ void gla_prep_task(const Ctx& C, int l, int ck, int h) {
    const int lane = C.lane, fr = lane & 15, fq = lane >> 4, k4 = 4 * lane;
    LAS bf16* Lq = (LAS bf16*)(C.lds + C.wave * 16384); LAS bf16* Lk = Lq + 16 * 256;
    const bf16* P = WSP(const bf16, WS_PROJ); const float* Sm = WSP(const float, WS_SMALL);
    f32x4 bc[16]; f32x4 run = (f32x4){0.f, 0.f, 0.f, 0.f};
    { const float* wa2 = C.in(17) + (size_t)l * 16 * 1024 + h * 256 + k4; f32x4 wv[16];
#pragma unroll
      for (int r = 0; r < 16; ++r) wv[r] = *(const f32x4*)(wa2 + r * 1024);
      const f32x4 bav = *(const f32x4*)(C.in(18) + (size_t)l * 1024 + h * 256 + k4);
#pragma unroll
      for (int i = 0; i < 16; ++i) { const float* ar = Sm + (size_t)(16 * ck + i) * 256 + 32; f32x4 a = bav;
#pragma unroll
          for (int r4 = 0; r4 < 4; ++r4) { const f32x4 av = *(const f32x4*)(ar + 4 * r4);
#pragma unroll
              for (int q = 0; q < 4; ++q) a = a + wv[4 * r4 + q] * av[q]; }
#pragma unroll
          for (int j = 0; j < 4; ++j) run[j] += logsigmoidf_(a[j]) * (1.0f / 16.0f);
          bc[i] = run; } }
    const f32x4 b15 = bc[15];
    unsigned ke[4][8];
#pragma unroll
    for (int i = 0; i < 16; ++i) { const size_t row = (size_t)(16 * ck + i);
        const u32x2 qw = *(const u32x2*)(P + row * NPROJ + PQ + h * 256 + k4), kw = *(const u32x2*)(P + row * NPROJ + PK + h * 256 + k4);
        const float qv[4] = {bf_lo(qw.x), bf_hi(qw.x), bf_lo(qw.y), bf_hi(qw.y)}, kv[4] = {bf_lo(kw.x), bf_hi(kw.x), bf_lo(kw.y), bf_hi(kw.y)};
        float qd[4], ki[4], kend[4];
#pragma unroll
        for (int j = 0; j < 4; ++j) { qd[j] = qv[j] * 0.0625f * __expf(bc[i][j]); ki[j] = kv[j] * __expf(-bc[i][j]); kend[j] = kv[j] * __expf(b15[j] - bc[i][j]); }
        u32x2 w; w.x = cvt_pk_bf16(qd[0], qd[1]); w.y = cvt_pk_bf16(qd[2], qd[3]);
        *(u32x2*)(WSP(bf16, WS_QD) + row * 1024 + h * 256 + k4) = w; *(LAS u32x2*)(Lq + i * 256 + k4) = w;
        u32x2 w2; w2.x = cvt_pk_bf16(ki[0], ki[1]); w2.y = cvt_pk_bf16(ki[2], ki[3]); *(LAS u32x2*)(Lk + i * 256 + k4) = w2;
#pragma unroll
        for (int j = 0; j < 4; ++j) { if (i & 1) ke[j][i >> 1] |= f2bf(kend[j]) << 16; else ke[j][i >> 1] = f2bf(kend[j]); } }
#pragma unroll
    for (int j = 0; j < 4; ++j) { u32x4* d = (u32x4*)(WSP(bf16, WS_KET) + ((size_t)ck * 1024 + h * 256 + k4 + j) * 16);
        d[0] = (u32x4){ke[j][0], ke[j][1], ke[j][2], ke[j][3]}; d[1] = (u32x4){ke[j][4], ke[j][5], ke[j][6], ke[j][7]}; }
    { f32x4 dv; dv[0] = __expf(b15[0]); dv[1] = __expf(b15[1]); dv[2] = __expf(b15[2]); dv[3] = __expf(b15[3]); *(f32x4*)(WSP(float, WS_DEC) + (size_t)ck * 1024 + h * 256 + k4) = dv; }
    WAVE_LDS_SYNC();
    f32x4 att = (f32x4){0.f, 0.f, 0.f, 0.f};
#pragma unroll
    for (int ks = 0; ks < 8; ++ks) { const bf16x8 a = *(const LAS bf16x8*)(Lq + fr * 256 + 32 * ks + 8 * fq), b = *(const LAS bf16x8*)(Lk + fr * 256 + 32 * ks + 8 * fq); att = MFMA32(a, b, att); }
#pragma unroll
    for (int r = 0; r < 4; ++r) { const int i = 4 * fq + r; WSP(bf16, WS_ATT)[(((size_t)ck * 4 + h) * 16 + i) * 16 + fr] = (bf16)(fr <= i ? f2bf(att[r]) : 0u); }
    WAVE_LDS_SYNC();
    unsigned vt[8][8];
#pragma unroll
    for (int i = 0; i < 16; ++i) { float vv[8]; unpack8(*(const u32x4*)(P + (size_t)(16 * ck + i) * NPROJ + PV + h * 512 + 8 * lane), vv);
#pragma unroll
        for (int j = 0; j < 8; ++j) { if (i & 1) vt[j][i >> 1] |= f2bf(vv[j]) << 16; else vt[j][i >> 1] = f2bf(vv[j]); } }
#pragma unroll
    for (int j = 0; j < 8; ++j) { u32x4* d = (u32x4*)(WSP(bf16, WS_VT16) + ((size_t)ck * DM + h * 512 + 8 * lane + j) * 16);
        d[0] = (u32x4){vt[j][0], vt[j][1], vt[j][2], vt[j][3]}; d[1] = (u32x4){vt[j][4], vt[j][5], vt[j][6], vt[j][7]}; }
}
__device__ __forceinline__ void ssd_prep_head(const Ctx& C, int l, int cs, int h) {
    const int lane = C.lane, fr = lane & 15, fq = lane >> 4, g = h >> 3; const ChunkInfo ci = ssd_chunk(cs);
    LAS float* La = (LAS float*)(C.lds + C.wave * 16384); LAS float* Ld = La + 64;
    const bf16* XB = WSP(const bf16, WS_XBC); const float* DT = WSP(const float, WS_DT);
    const bf16x8 z8 = zero8h();
    f32x4 cb[4][4];
#pragma unroll
    for (int mt = 0; mt < 4; ++mt)
#pragma unroll
        for (int nt = 0; nt < 4; ++nt) cb[mt][nt] = (f32x4){0.f, 0.f, 0.f, 0.f};
#pragma unroll
    for (int ks = 0; ks < 4; ++ks) { bf16x8 af[4], bfr[4];
#pragma unroll
        for (int t = 0; t < 4; ++t) { const int i = 16 * t + fr; const bool ok = i < ci.nvalid; const bf16* rp = XB + (size_t)(ci.row0 + (ok ? i : 0)) * XBCW + g * 128 + 32 * ks + 8 * fq;
            af[t] = ok ? *(const bf16x8*)(rp + 2560) : z8; bfr[t] = ok ? *(const bf16x8*)(rp + 2048) : z8; }
#pragma unroll
        for (int mt = 0; mt < 4; ++mt)
#pragma unroll
            for (int nt = 0; nt <= mt; ++nt) cb[mt][nt] = MFMA32(af[mt], bfr[nt], cb[mt][nt]); }
    const bool jok = lane < ci.nvalid; const size_t jrow = (size_t)(ci.row0 + (jok ? lane : 0));
    const float a = -__expf(C.in(14)[l * 32 + h]); const float dtj = jok ? DT[jrow * 32 + h] : 0.f;
    float ac = dtj * a;
#pragma unroll
    for (int d = 1; d < 64; d <<= 1) { const float t = __shfl(ac, (lane - d) & 63); if (lane >= d) ac += t; }
    const float a63 = __shfl(ac, 63), te = __expf(a63 - ac) * dtj;
    La[lane] = ac; Ld[lane] = dtj;
    WSP(float, WS_EA)[((size_t)cs * 32 + h) * 64 + lane] = __expf(ac);
    if (lane == 0) WSP(float, WS_DECS)[(size_t)cs * 32 + h] = __expf(a63);
    u32x4 xr[8];
#pragma unroll
    for (int p8 = 0; p8 < 8; ++p8) xr[p8] = jok ? *(const u32x4*)(XB + jrow * XBCW + h * 64 + 8 * p8) : zero16();
#pragma unroll
    for (int p8 = 0; p8 < 8; ++p8) { float xv[8]; unpack8(xr[p8], xv);
#pragma unroll
        for (int q = 0; q < 8; ++q) { const size_t o = ((size_t)cs * DM + h * 64 + 8 * p8 + q) * 64 + lane; WSP(bf16, WS_XT)[o] = (bf16)f2bf(xv[q]); WSP(bf16, WS_XTE)[o] = (bf16)f2bf(xv[q] * te); } }
    WAVE_LDS_SYNC();
#pragma unroll
    for (int mt = 0; mt < 4; ++mt)
#pragma unroll
        for (int nt = 0; nt < 4; ++nt) { const int j = 16 * nt + fr; const float aj = La[j], dj = Ld[j];
#pragma unroll
            for (int r = 0; r < 4; ++r) { const int i = 16 * mt + 4 * fq + r; const float w = (nt <= mt && j <= i) ? cb[mt][nt][r] * __expf(La[i] - aj) * dj : 0.f;
                WSP(bf16, WS_WCH)[(((size_t)cs * 32 + h) * 64 + i) * 64 + j] = (bf16)f2bf(w); } }
    WAVE_LDS_SYNC();
}
__device__ __forceinline__ void ssd_prep_group(const Ctx& C, int cs, int g) {
    const int lane = C.lane; const ChunkInfo ci = ssd_chunk(cs); const bf16* XB = WSP(const bf16, WS_XBC);
    const bool jok = lane < ci.nvalid; const size_t jrow = (size_t)(ci.row0 + (jok ? lane : 0));
#pragma unroll 4
    for (int n8 = 0; n8 < 16; ++n8) { float bv[8];
        if (jok) unpack8(*(const u32x4*)(XB + jrow * XBCW + 2048 + g * 128 + 8 * n8), bv); else {
#pragma unroll
            for (int q = 0; q < 8; ++q) bv[q] = 0.f; }
#pragma unroll
        for (int q = 0; q < 8; ++q) WSP(bf16, WS_BT)[((size_t)cs * 512 + g * 128 + 8 * n8 + q) * 64 + lane] = (bf16)f2bf(bv[q]); }
#pragma unroll 4
    for (int it = 0; it < 16; ++it) { const int idx = it * 64 + lane, i = idx >> 4, n8 = idx & 15; const bool ok = i < ci.nvalid;
        const u32x4 v = ok ? *(const u32x4*)(XB + (size_t)(ci.row0 + i) * XBCW + 2560 + g * 128 + 8 * n8) : zero16();
        *(u32x4*)(WSP(bf16, WS_CC) + ((size_t)cs * 64 + i) * 512 + g * 128 + 8 * n8) = v; }
}
__device__ __forceinline__ void phase_prep(const Ctx& C, int l) {
    const int gw = C.wave * C.G + C.bid, NGW = C.G * 8;
    for (int t = gw; t < NCK * 4; t += NGW) gla_prep_task(C, l, t >> 2, t & 3);
    phase_prep_conv(C, l);
}
__device__ __forceinline__ void phase_chunkprep(const Ctx& C, int l) {
    const int gw = C.wave * C.G + C.bid, NGW = C.G * 8;
    constexpr int NHT = NCS * 32, NGT = NCS * 4;
    for (int t = gw; t < NHT + NGT; t += NGW) { if (t < NHT) ssd_prep_head(C, l, t >> 5, t & 31); else ssd_prep_group(C, (t - NHT) >> 2, (t - NHT) & 3); }
}
__device__ __forceinline__ void gla_scan_task(const Ctx& C, int l, int sq, int h, int vs) {
    const SeqInfo s = seq_of_idx(sq); const int lane = C.lane, fr = lane & 15, fq = lane >> 4, vc0 = h * 512 + vs * 16;
    f32x4 S[16];
    const size_t st_off = ((((size_t)l * (s.sample ? SBT : NB) + s.b) * 4 + h) * 256) * 512 + vs * 16;
    if (s.sample) { const float* st = C.in(5) + st_off;
#pragma unroll
        for (int kt = 0; kt < 16; ++kt)
#pragma unroll
            for (int r = 0; r < 4; ++r) S[kt][r] = st[(size_t)(16 * kt + 4 * fq + r) * 512 + fr]; }
    else {
#pragma unroll
        for (int kt = 0; kt < 16; ++kt) S[kt] = (f32x4){0.f, 0.f, 0.f, 0.f}; }
    const int nch = s.L / 16, ck0 = s.row0 / 16;
    const unsigned char* wsb = C.ws;
#define LDW(type, off) (*(const type*)(wsb + (off)))
    unsigned qo = (unsigned)(WS_QD + ((size_t)(16 * ck0 + fr) * 1024 + h * 256 + 4 * fq) * 2);
    const int fh = fq & 1; const bool alo = fq < 2; short zz = 0; LAUNDER_V(zz); const bf16x8 z8 = (bf16x8){zz, zz, zz, zz, zz, zz, zz, zz};
    unsigned ao = (unsigned)(WS_ATT + ((((size_t)ck0 * 4 + h) * 16 + fr) * 16 + 8 * fh) * 2);
    unsigned vo = (unsigned)(WS_VT16 + (((size_t)ck0 * DM + vc0 + fr) * 16 + 8 * fh) * 2);
    unsigned ko = (unsigned)(WS_KET + (((size_t)ck0 * 1024 + h * 256 + fr) * 16 + 8 * fh) * 2);
    unsigned dof = (unsigned)(WS_DEC + ((size_t)ck0 * 1024 + h * 256 + 4 * lane) * 4);
    unsigned yo = (unsigned)(WS_YGR + ((size_t)(16 * ck0 + 4 * fq) * DM + vc0 + fr) * 4);
    LAS float* Ld = (LAS float*)(C.lds + C.wave * 16384);
    u32x2 qa[8], qb[8]; bf16x8 ka[16]; bf16x8 at = z8, v0, v1;
#define LDA8(dst, off) do { if (alo) dst = LDW(bf16x8, off); } while (0)
#pragma unroll
    for (int kt = 0; kt < 16; ++kt) ka[kt] = z8;
#pragma unroll
    for (int ks = 0; ks < 8; ++ks) { qa[ks] = LDW(u32x2, qo + 64 * ks); qb[ks] = LDW(u32x2, qo + 64 * ks + 32); }
    LDA8(at, ao); v0 = LDW(bf16x8, vo);
    if (alo) {
#pragma unroll
        for (int kt = 0; kt < 16; ++kt) ka[kt] = LDW(bf16x8, ko + kt * 512); }
    { const f32x4 d0 = LDW(f32x4, dof); *(LAS f32x4*)(Ld + 4 * lane) = d0; }
    WAVE_LDS_SYNC();
#define GLA_OUT(vv) do { f32x4 o0 = (f32x4){0.f, 0.f, 0.f, 0.f}; \
        _Pragma("unroll") for (int ks = 0; ks < 8; ++ks) o0 = MFMA32(mk8(qa[ks], qb[ks]), pack_tiles(S[2 * ks], S[2 * ks + 1]), o0); \
        o0 = MFMA32(at, vv, o0); \
        _Pragma("unroll") for (int r = 0; r < 4; ++r) *(float*)(C.ws + yo + (unsigned)(r * DM * 4)) = o0[r]; \
        yo += 16 * DM * 4; } while (0)
    GLA_OUT(v0);
    for (int c = 0; c < nch; ++c) {
        const unsigned adv = (c + 1 < nch) ? 1u : 0u;
        qo += adv * (16 * 1024 * 2); ao += adv * (1024 * 2); vo += adv * (DM * 16 * 2); dof += adv * (1024 * 4);
        const unsigned kon = ko + adv * (1024 * 16 * 2);
#pragma unroll
        for (int ks = 0; ks < 8; ++ks) { qa[ks] = LDW(u32x2, qo + 64 * ks); qb[ks] = LDW(u32x2, qo + 64 * ks + 32); }
        LDA8(at, ao); v1 = LDW(bf16x8, vo);
        const f32x4 dnext = LDW(f32x4, dof);
        __builtin_amdgcn_sched_barrier(0);
        const LAS float* dcur = Ld + (c & 1) * 256 + 4 * fq;
#pragma unroll
        for (int kt = 0; kt < 16; ++kt) { const f32x4 d = *(const LAS f32x4*)(dcur + 16 * kt); S[kt] = MFMA32(ka[kt], v0, S[kt] * d);
            LDA8(ka[kt], kon + kt * 512);
            __builtin_amdgcn_sched_barrier(0); }
        *(LAS f32x4*)(Ld + ((c + 1) & 1) * 256 + 4 * lane) = dnext;
        WAVE_LDS_SYNC();
        ko = kon; v0 = v1;
        if (adv) GLA_OUT(v0);
        __builtin_amdgcn_sched_barrier(0);
    }
#undef GLA_OUT
#undef LDA8
    float* dst = C.out + (s.sample ? O_SGLA : O_PGLA) + st_off;
#pragma unroll
    for (int kt = 0; kt < 16; ++kt)
#pragma unroll
        for (int r = 0; r < 4; ++r) dst[(size_t)(16 * kt + 4 * fq + r) * 512 + fr] = S[kt][r];
}
__device__ __forceinline__ void ssd_scan_task(const Ctx& C, int l, int sq, int h, int ph) {
    const SeqInfo s = seq_of_idx(sq); const int lane = C.lane, fr = lane & 15, fq = lane >> 4, g = h >> 3, ch0 = h * 64 + ph * 32;
    f32x4 H[8][2];
    const size_t st_off = (((size_t)l * (s.sample ? SBT : NB) + s.b) * 32 + h) * 64 * 128;
    if (s.sample) { const float* st = C.in(3) + st_off;
#pragma unroll
        for (int nt = 0; nt < 8; ++nt)
#pragma unroll
            for (int pt = 0; pt < 2; ++pt) H[nt][pt] = *(const f32x4*)(st + (size_t)(ph * 32 + 16 * pt + fr) * 128 + 16 * nt + 4 * fq); }
    else {
#pragma unroll
        for (int nt = 0; nt < 8; ++nt) { H[nt][0] = (f32x4){0.f, 0.f, 0.f, 0.f}; H[nt][1] = (f32x4){0.f, 0.f, 0.f, 0.f}; } }
    const float Dh = C.in(15)[l * 32 + h];
    const int nch = s.sample ? 1 : SEQ / 64, cs0 = s.sample ? NCP + s.b : s.row0 / 64, nvalid = s.sample ? SSQ : 64;
    const unsigned char* wsb = C.ws;
    unsigned co = (unsigned)(WS_CC + (((size_t)cs0 * 64 + fr) * 512 + g * 128 + 4 * fq) * 2);
    unsigned eo = (unsigned)(WS_EA + (((size_t)cs0 * 32 + h) * 64 + 4 * fq) * 4);
    unsigned wo = (unsigned)(WS_WCH + ((((size_t)cs0 * 32 + h) * 64 + fr) * 64 + 8 * fq) * 2);
    unsigned xo = (unsigned)(WS_XT + (((size_t)cs0 * DM + ch0 + fr) * 64) * 2);
    unsigned xeo = (unsigned)(WS_XTE + (((size_t)cs0 * DM + ch0 + fr) * 64 + 8 * fq) * 2);
    unsigned bo = (unsigned)(WS_BT + (((size_t)cs0 * 512 + g * 128 + fr) * 64 + 8 * fq) * 2);
    unsigned deo = (unsigned)(WS_DECS + ((size_t)cs0 * 32 + h) * 4);
    unsigned yo = (unsigned)(WS_YSR + ((size_t)(s.row0 + 4 * fq) * DM + ch0 + fr) * 4);
#define SCHED_FENCE() __builtin_amdgcn_sched_barrier(0)
    for (int c = 0; c < nch; ++c) {
        u32x2 ca[4][4], cb2[4][4]; f32x4 ea[4];
#pragma unroll
        for (int mt = 0; mt < 4; ++mt) { ea[mt] = LDW(f32x4, eo + 64 * mt);
#pragma unroll
            for (int ks = 0; ks < 4; ++ks) { ca[mt][ks] = LDW(u32x2, co + mt * 16384 + 64 * ks); cb2[mt][ks] = LDW(u32x2, co + mt * 16384 + 64 * ks + 32); } }
        f32x4 y[4][2];
#pragma unroll
        for (int mt = 0; mt < 4; ++mt) { y[mt][0] = (f32x4){0.f, 0.f, 0.f, 0.f}; y[mt][1] = (f32x4){0.f, 0.f, 0.f, 0.f}; }
        SCHED_FENCE();
#pragma unroll
        for (int ks = 0; ks < 2; ++ks) { const bf16x8 b0 = pack_tiles(H[2 * ks][0], H[2 * ks + 1][0]), b1 = pack_tiles(H[2 * ks][1], H[2 * ks + 1][1]);
#pragma unroll
            for (int mt = 0; mt < 4; ++mt) { const bf16x8 a = mk8(ca[mt][ks], cb2[mt][ks]); y[mt][0] = MFMA32(a, b0, y[mt][0]); y[mt][1] = MFMA32(a, b1, y[mt][1]); } }
        SCHED_FENCE();
        bf16x8 wf[6], xf[2][2]; u32x2 xd[4][2];
#pragma unroll
        for (int mt = 0; mt < 4; ++mt) wf[mt] = LDW(bf16x8, wo + mt * 2048);
        wf[4] = LDW(bf16x8, wo + 2 * 2048 + 64); wf[5] = LDW(bf16x8, wo + 3 * 2048 + 64);
#pragma unroll
        for (int pt = 0; pt < 2; ++pt) { xf[0][pt] = LDW(bf16x8, xo + pt * 2048 + 16 * fq); xf[1][pt] = LDW(bf16x8, xo + pt * 2048 + 64 + 16 * fq);
#pragma unroll
            for (int mt = 0; mt < 4; ++mt) xd[mt][pt] = LDW(u32x2, xo + pt * 2048 + 32 * mt + 8 * fq); }
        SCHED_FENCE();
#pragma unroll
        for (int ks = 2; ks < 4; ++ks) { const bf16x8 b0 = pack_tiles(H[2 * ks][0], H[2 * ks + 1][0]), b1 = pack_tiles(H[2 * ks][1], H[2 * ks + 1][1]);
#pragma unroll
            for (int mt = 0; mt < 4; ++mt) { const bf16x8 a = mk8(ca[mt][ks], cb2[mt][ks]); y[mt][0] = MFMA32(a, b0, y[mt][0]); y[mt][1] = MFMA32(a, b1, y[mt][1]); } }
#pragma unroll
        for (int mt = 0; mt < 4; ++mt) { y[mt][0] = y[mt][0] * ea[mt]; y[mt][1] = y[mt][1] * ea[mt]; }
        SCHED_FENCE();
        bf16x8 bt0[8], bt1[8], xe[2][2]; const float dec = LDW(float, deo);
#pragma unroll
        for (int nt = 0; nt < 8; ++nt) bt0[nt] = LDW(bf16x8, bo + nt * 2048);
        xe[0][0] = LDW(bf16x8, xeo); xe[0][1] = LDW(bf16x8, xeo + 2048);
        SCHED_FENCE();
#pragma unroll
        for (int mt = 0; mt < 4; ++mt) { y[mt][0] = MFMA32(wf[mt], xf[0][0], y[mt][0]); y[mt][1] = MFMA32(wf[mt], xf[0][1], y[mt][1]); }
        y[2][0] = MFMA32(wf[4], xf[1][0], y[2][0]); y[2][1] = MFMA32(wf[4], xf[1][1], y[2][1]); y[3][0] = MFMA32(wf[5], xf[1][0], y[3][0]); y[3][1] = MFMA32(wf[5], xf[1][1], y[3][1]);
#pragma unroll
        for (int mt = 0; mt < 4; ++mt)
#pragma unroll
            for (int pt = 0; pt < 2; ++pt) { const float xv[4] = {bf_lo(xd[mt][pt].x), bf_hi(xd[mt][pt].x), bf_lo(xd[mt][pt].y), bf_hi(xd[mt][pt].y)};
#pragma unroll
                for (int r = 0; r < 4; ++r) if (16 * mt + 4 * fq + r < nvalid) *(float*)(C.ws + yo + (unsigned)(((16 * mt + r) * DM + 16 * pt) * 4)) = y[mt][pt][r] + Dh * xv[r]; }
        SCHED_FENCE();
#pragma unroll
        for (int nt = 0; nt < 8; ++nt) bt1[nt] = LDW(bf16x8, bo + nt * 2048 + 64);
        xe[1][0] = LDW(bf16x8, xeo + 64); xe[1][1] = LDW(bf16x8, xeo + 2048 + 64);
        SCHED_FENCE();
#pragma unroll
        for (int nt = 0; nt < 8; ++nt) { H[nt][0] = MFMA32(bt0[nt], xe[0][0], H[nt][0] * dec); H[nt][1] = MFMA32(bt0[nt], xe[0][1], H[nt][1] * dec); }
#pragma unroll
        for (int nt = 0; nt < 8; ++nt) { H[nt][0] = MFMA32(bt1[nt], xe[1][0], H[nt][0]); H[nt][1] = MFMA32(bt1[nt], xe[1][1], H[nt][1]); }
        co += 64 * 512 * 2; eo += 32 * 64 * 4; wo += 32 * 64 * 64 * 2; xo += DM * 64 * 2; xeo += DM * 64 * 2; bo += 512 * 64 * 2; deo += 32 * 4; yo += 64 * DM * 4;
    }
    float* dst = C.out + (s.sample ? O_SSSD : O_PSSD) + st_off;
#pragma unroll
    for (int nt = 0; nt < 8; ++nt)
#pragma unroll
        for (int pt = 0; pt < 2; ++pt) *(f32x4*)(dst + (size_t)(ph * 32 + 16 * pt + fr) * 128 + 16 * nt + 4 * fq) = H[nt][pt];
}
__device__ __forceinline__ void phase_scan(const Ctx& C, int l) {
    constexpr int NGP = NB * 4 * 32, NSP = NB * 32 * 2, NH = NGP + NSP, NGS = SBT * 4 * 32, NSS = SBT * 32 * 2, NL = NGS + NSS;
    const int slot = C.wave * C.G + C.bid, NSLOT = C.G * 8;
    const int ls0 = NH < NSLOT ? NH : 0, nls = NSLOT - ls0;
#ifndef PROBE_SCAN_DUP
#define PROBE_SCAN_DUP 0
#endif
    int t = slot < NH ? slot : (slot >= ls0 ? NH + (slot - ls0) : NH + NL); int dup = 0;
    while (t < NH + NL) {
        int kind, sq, a, b2;
        if (t < NH) { if (t < NGP) { kind = 0; sq = t / 128; a = (t % 128) / 32; b2 = t % 32; } else { const int r = t - NGP; kind = 1; sq = r / 64; a = (r % 64) / 2; b2 = r % 2; } }
        else { const int u = t - NH; if (u < NGS) { kind = 0; sq = NB + u / 128; a = (u % 128) / 32; b2 = u % 32; } else { const int r = u - NGS; kind = 1; sq = NB + r / 64; a = (r % 64) / 2; b2 = r % 2; } }
        if (kind == 0) gla_scan_task(C, l, sq, a, b2); else ssd_scan_task(C, l, sq, a, b2);
        if (PROBE_SCAN_DUP && PROBE_SCAN_DUP < 3 && t < NH && !dup && ((PROBE_SCAN_DUP == 1) == (kind == 0))) { dup = 1; continue; }
        if (PROBE_SCAN_DUP >= 3 && t >= NH && !dup && ((PROBE_SCAN_DUP == 3) == (kind == 0))) { dup = 1; continue; } else if (PROBE_SCAN_DUP >= 3) dup = 0;
        if (t < NH) { t += NSLOT; if (t >= NH) t = (slot >= ls0) ? NH + (slot - ls0) : NH + NL; }
        else t += nls;
    }
}
__device__ __forceinline__ void phase_ynorm(const Ctx& C, int l) {
    const int gw = C.bid * 8 + C.wave, NGW = C.G * 8; const bf16* P = WSP(const bf16, WS_PROJ);
    const float* sn = C.in(16) + (size_t)l * DM; const float* gn = C.in(19) + (size_t)l * 512;
    for (int row = gw; row < T; row += NGW) {
        f32x4 ya[8][2]; u32x4 zg[8];
#pragma unroll
        for (int gi = 0; gi < 4; ++gi) { const int c = gi * 512 + C.lane * 8;
            ya[gi][0] = *(const f32x4*)(WSP(const float, WS_YSR) + (size_t)row * DM + c); ya[gi][1] = *(const f32x4*)(WSP(const float, WS_YSR) + (size_t)row * DM + c + 4);
            zg[gi] = *(const u32x4*)(P + (size_t)row * NPROJ + PZ + c);
            ya[4 + gi][0] = *(const f32x4*)(WSP(const float, WS_YGR) + (size_t)row * DM + c); ya[4 + gi][1] = *(const f32x4*)(WSP(const float, WS_YGR) + (size_t)row * DM + c + 4);
            zg[4 + gi] = *(const u32x4*)(P + (size_t)row * NPROJ + PG + c); }
        float ssq[8]; float v[8][8];
#pragma unroll
        for (int q = 0; q < 8; ++q) { float zv[8]; unpack8(zg[q], zv); float ss = 0.f;
#pragma unroll
            for (int j = 0; j < 8; ++j) { const float y = j < 4 ? ya[q][0][j] : ya[q][1][j - 4]; v[q][j] = q < 4 ? y * siluf_(zv[j]) : y; if (q >= 4) zv[j] = siluf_(zv[j]); ss += v[q][j] * v[q][j]; }
            if (q >= 4) {
#pragma unroll
                for (int j = 0; j < 8; ++j) ya[q][j >> 2][j & 3] = zv[j]; }
            ssq[q] = ss; }
#pragma unroll
        for (int o = 1; o < 64; o <<= 1) {
#pragma unroll
            for (int q = 0; q < 8; ++q) ssq[q] += __shfl_xor(ssq[q], o); }
#pragma unroll
        for (int q = 0; q < 8; ++q) { const float rstd = 1.0f / sqrtf(ssq[q] * (1.0f / 512.0f) + EPSF); const int c = (q & 3) * 512 + C.lane * 8; float o8[8];
#pragma unroll
            for (int j = 0; j < 8; ++j) o8[j] = q < 4 ? v[q][j] * rstd * sn[c + j] : v[q][j] * rstd * gn[C.lane * 8 + j] * ya[q][j >> 2][j & 3];
            *(u32x4*)(WSP(bf16, q < 4 ? WS_YS : WS_YG) + (size_t)row * DM + c) = pack8(o8); }
    }
}
__device__ __forceinline__ void phase_attn(const Ctx& C, int l) {
    constexpr int QT = SEQ / 128, NU_P = NB * 4 * QT, NU = NU_P + SBT * 4;
    constexpr int KROW = 1040, VROW = 528, BUFB = 16896;
    const int tid = C.tid, lane = C.lane, w = C.wave, fr = lane & 15, fq = lane >> 4;
    LAS unsigned char* KV = C.lds;
    LAS bf16* Pl = (LAS bf16*)(C.lds + 2 * BUFB + w * 8448);
    const int krow = tid >> 6, kc = tid & 63, vrow = tid >> 5, vc = tid & 31;
    const unsigned char* wsb = C.ws;
#define LDG(type, off) (*(const type*)(wsb + (off)))
    for (int u = C.bid; u < NU; u += C.G) {
        int row0, h, nvw; unsigned kbo, vbo;
        if (u < NU_P) { const int b = u / (4 * QT), r = u % (4 * QT); h = r / QT; row0 = b * SEQ + (r % QT) * 128; nvw = 8;
            kbo = (unsigned)(WS_KP + (((size_t)l * NB + b) * MTOK * DM + h * 512) * 2); vbo = (unsigned)(WS_VTP + ((((size_t)l * NB + b) * DM + h * 512) * MTOK) * 2); }
        else { const int r = u - NU_P, b = r / 4; h = r % 4; row0 = TP + b * SSQ; nvw = 1;
            kbo = (unsigned)(WS_KS + (((size_t)l * SBT + b) * MTOK * DM + h * 512) * 2); vbo = (unsigned)(WS_VTS + ((((size_t)l * SBT + b) * DM + h * 512) * MTOK) * 2); }
        const bool act = w < nvw; const int qrow = row0 + 16 * w;
        const unsigned kld = kbo + (unsigned)((krow * DM + kc * 8) * 2), vld = vbo + (unsigned)((vrow * MTOK + vc * 8) * 2);
        const unsigned qo = (unsigned)(WS_YS + ((size_t)(qrow + fr) * DM + h * 512 + 8 * fq) * 2), oo = (unsigned)(WS_YG + ((size_t)(qrow + 4 * fq) * DM + h * 512 + fr) * 2);
        __syncthreads();
        u32x4 st0 = LDG(u32x4, kld), st1 = LDG(u32x4, kld + 8 * DM * 2);
        bf16x8 qf[16];
        if (act) {
#pragma unroll
            for (int ks = 0; ks < 16; ++ks) qf[ks] = LDG(bf16x8, qo + 64 * ks); }
        else {
#pragma unroll
            for (int ks = 0; ks < 16; ++ks) qf[ks] = zero8h(); }
        *(LAS u32x4*)(KV + krow * KROW + kc * 16) = st0; *(LAS u32x4*)(KV + (krow + 8) * KROW + kc * 16) = st1;
        __syncthreads();
        f32x4 sacc[16];
#pragma unroll
        for (int kt = 0; kt < 16; ++kt) {
            if (kt < 15) { st0 = LDG(u32x4, kld + (kt + 1) * (16 * DM * 2)); st1 = LDG(u32x4, kld + (kt + 1) * (16 * DM * 2) + 8 * DM * 2); }
            else { st0 = LDG(u32x4, vld); st1 = LDG(u32x4, vld + 16 * MTOK * 2); }
            f32x4 a = (f32x4){0.f, 0.f, 0.f, 0.f};
            if (act) {
#pragma unroll
                for (int ks = 0; ks < 16; ++ks) { const bf16x8 kf = *(const LAS bf16x8*)(KV + (kt & 1) * BUFB + fr * KROW + (32 * ks + 8 * fq) * 2); a = MFMA32(qf[ks], kf, a); } }
            sacc[kt] = a;
            if (kt < 15) { *(LAS u32x4*)(KV + ((kt + 1) & 1) * BUFB + krow * KROW + kc * 16) = st0; *(LAS u32x4*)(KV + ((kt + 1) & 1) * BUFB + (krow + 8) * KROW + kc * 16) = st1; }
            else { *(LAS u32x4*)(KV + vrow * VROW + vc * 16) = st0; *(LAS u32x4*)(KV + (vrow + 16) * VROW + vc * 16) = st1; }
            __syncthreads();
            __builtin_amdgcn_sched_barrier(0);
        }
        bf16x8 pf[8];
        if (act) {
            const float sc = 0.04419417382415922f;
#pragma unroll
            for (int r = 0; r < 4; ++r) { float mx = -3.0e38f;
#pragma unroll
                for (int nt = 0; nt < 16; ++nt) mx = fmaxf(mx, sacc[nt][r]);
                mx = fmaxf(mx, __shfl_xor(mx, 1)); mx = fmaxf(mx, __shfl_xor(mx, 2)); mx = fmaxf(mx, __shfl_xor(mx, 4)); mx = fmaxf(mx, __shfl_xor(mx, 8));
                float sum = 0.f;
#pragma unroll
                for (int nt = 0; nt < 16; ++nt) { const float e = __expf((sacc[nt][r] - mx) * sc); sacc[nt][r] = e; sum += e; }
                sum += __shfl_xor(sum, 1); sum += __shfl_xor(sum, 2); sum += __shfl_xor(sum, 4); sum += __shfl_xor(sum, 8);
                const float inv = 1.0f / sum;
#pragma unroll
                for (int nt = 0; nt < 16; ++nt) Pl[(4 * fq + r) * 264 + 16 * nt + fr] = (bf16)f2bf(sacc[nt][r] * inv); }
            WAVE_LDS_SYNC();
#pragma unroll
            for (int ks = 0; ks < 8; ++ks) pf[ks] = *(const LAS bf16x8*)(Pl + fr * 264 + 32 * ks + 8 * fq);
            WAVE_LDS_SYNC();
        } else {
#pragma unroll
            for (int ks = 0; ks < 8; ++ks) pf[ks] = zero8h(); }
#pragma unroll
        for (int vt = 0; vt < 16; ++vt) {
            if (vt < 15) { st0 = LDG(u32x4, vld + (vt + 1) * (32 * MTOK * 2)); st1 = LDG(u32x4, vld + (vt + 1) * (32 * MTOK * 2) + 16 * MTOK * 2); }
            if (act) {
#pragma unroll
                for (int d2 = 0; d2 < 2; ++d2) { f32x4 a = (f32x4){0.f, 0.f, 0.f, 0.f};
#pragma unroll
                    for (int ks = 0; ks < 8; ++ks) { const bf16x8 vf = *(const LAS bf16x8*)(KV + (vt & 1) * BUFB + (16 * d2 + fr) * VROW + (32 * ks + 8 * fq) * 2); a = MFMA32(pf[ks], vf, a); }
#pragma unroll
                    for (int r = 0; r < 4; ++r) *(bf16*)(C.ws + oo + (unsigned)((r * DM + 32 * vt + 16 * d2) * 2)) = (bf16)f2bf(a[r]); } }
            if (vt < 15) { *(LAS u32x4*)(KV + ((vt + 1) & 1) * BUFB + vrow * VROW + vc * 16) = st0; *(LAS u32x4*)(KV + ((vt + 1) & 1) * BUFB + (vrow + 16) * VROW + vc * 16) = st1;
                __syncthreads(); }
            __builtin_amdgcn_sched_barrier(0);
        }
    }
#undef LDG
}
__device__ __forceinline__ void phase_ffnact(const Ctx& C, int l) {
    const size_t gt = (size_t)C.bid * 512 + C.tid, NT = (size_t)C.G * 512;
    const bf16* U = WSP(const bf16, WS_PROJ);
    const float* cw = C.in(29) + (size_t)l * 3 * DFF2; const float* cb = C.in(30) + (size_t)l * DFF2; const float* st = C.in(6) + (size_t)l * SBT * 2 * DFF2;
    for (size_t it = gt; it < (size_t)(T / 8) * (DFF / 8); it += NT) {
        const int seg = (int)(it / (DFF / 8)), c = (int)(it % (DFF / 8)) * 8, row0 = seg * 8; const SeqInfo s = seq_of_row(row0);
        u32x4 ru[10], rg[10];
#pragma unroll
        for (int i = 0; i < 8; ++i) { ru[2 + i] = *(const u32x4*)(U + (size_t)(row0 + i) * DFF2 + c); rg[2 + i] = *(const u32x4*)(U + (size_t)(row0 + i) * DFF2 + DFF + c); }
        float wu[3][8], wg[3][8], bu[8], bg[8];
#pragma unroll
        for (int i = 0; i < 3; ++i)
#pragma unroll
            for (int hlf = 0; hlf < 2; ++hlf) { const f32x4 a = *(const f32x4*)(cw + i * DFF2 + c + 4 * hlf), b = *(const f32x4*)(cw + i * DFF2 + DFF + c + 4 * hlf);
#pragma unroll
                for (int j = 0; j < 4; ++j) { wu[i][4 * hlf + j] = a[j]; wg[i][4 * hlf + j] = b[j]; } }
#pragma unroll
        for (int hlf = 0; hlf < 2; ++hlf) { const f32x4 a = *(const f32x4*)(cb + c + 4 * hlf), b = *(const f32x4*)(cb + DFF + c + 4 * hlf);
#pragma unroll
            for (int j = 0; j < 4; ++j) { bu[4 * hlf + j] = a[j]; bg[4 * hlf + j] = b[j]; } }
        float hu[2][8], hg[2][8];
        if (s.t >= 2) {
#pragma unroll
            for (int i = 0; i < 2; ++i) { ru[i] = *(const u32x4*)(U + (size_t)(row0 - 2 + i) * DFF2 + c); rg[i] = *(const u32x4*)(U + (size_t)(row0 - 2 + i) * DFF2 + DFF + c); unpack8(ru[i], hu[i]); unpack8(rg[i], hg[i]); } }
        else if (s.sample) {
#pragma unroll
            for (int i = 0; i < 2; ++i) { const float* sp = st + ((size_t)s.b * 2 + i) * DFF2 + c;
#pragma unroll
                for (int j = 0; j < 8; ++j) { hu[i][j] = sp[j]; hg[i][j] = sp[DFF + j]; } } }
        else {
#pragma unroll
            for (int i = 0; i < 2; ++i)
#pragma unroll
                for (int j = 0; j < 8; ++j) { hu[i][j] = 0.f; hg[i][j] = 0.f; } }
#pragma unroll
        for (int i = 0; i < 8; ++i) { float cu[8], cg[8], o[8]; unpack8(ru[2 + i], cu); unpack8(rg[2 + i], cg);
#pragma unroll
            for (int j = 0; j < 8; ++j) { const float au = bu[j] + hu[0][j] * wu[0][j] + hu[1][j] * wu[1][j] + cu[j] * wu[2][j], ag = bg[j] + hg[0][j] * wg[0][j] + hg[1][j] * wg[1][j] + cg[j] * wg[2][j];
                o[j] = siluf_(ag) * au; hu[0][j] = hu[1][j]; hu[1][j] = cu[j]; hg[0][j] = hg[1][j]; hg[1][j] = cg[j]; }
            *(u32x4*)(WSP(bf16, WS_YSR) + (size_t)(row0 + i) * DFF + c) = pack8(o); }
    }
    for (size_t it = gt; it < (size_t)NSEQ * 2 * DFF2; it += NT) {
        const int c = (int)(it % DFF2), j = (int)(it / DFF2) % 2, sq = (int)(it / (2 * DFF2)); const SeqInfo s = seq_of_idx(sq);
        float* dst = C.out + (s.sample ? O_SFFC + ((size_t)l * SBT + s.b) * 2 * DFF2 : O_PFFC + ((size_t)l * NB + s.b) * 2 * DFF2);
        dst[j * DFF2 + c] = bf2f(U[(size_t)(s.row0 + s.L - 2 + j) * DFF2 + c]);
    }
}

struct SEpiGate0 { const bf16* P; float* M0; static constexpr bool ROWSUM = false; __device__ __forceinline__ float operator()(int row, int col, float v) const { M0[(size_t)row * DM + col] = v * sigmoidf_(bf2f(P[(size_t)row * NPROJ + PGATE + col])); return 0.f; } };
struct SEpiGate1 { const bf16* P; const float* M0; bf16* O; static constexpr bool ROWSUM = false; __device__ __forceinline__ float operator()(int row, int col, float v) const { O[(size_t)row * DM + col] = (bf16)f2bf(M0[(size_t)row * DM + col] + v * sigmoidf_(bf2f(P[(size_t)row * NPROJ + PGATE + DM + col]))); return 0.f; } };
struct SEpiResid { float* X; bf16* H; float* SS; static constexpr bool ROWSUM = true; __device__ __forceinline__ float operator()(int row, int col, float v) const { const float x = X[(size_t)row * DM + col] + v; X[(size_t)row * DM + col] = x; H[(size_t)row * DM + col] = (bf16)f2bf(x); return x * x; } };
struct SEpiBf16 { bf16* O; const float* SS; static constexpr bool ROWSUM = false; __device__ __forceinline__ float operator()(int row, int col, float v) const { O[(size_t)row * DM + col] = (bf16)f2bf(v * row_rstd(SS, row)); return 0.f; } };
template <class SE>
__device__ __forceinline__ void sample_gemm(const Ctx& C, size_t a_off, size_t b_off, int K, const SE& E) {
    const int lane = C.lane, fr = lane & 15, fq = lane >> 4; const unsigned char* wsb = C.ws;
    const int slot = C.bid * 8 + C.wave, NSLOT = C.G * 8;
    for (int t = slot; t < 16 * (DM / 16); t += NSLOT) { const int rt = t / (DM / 16), ct = t % (DM / 16);
        unsigned ao = (unsigned)(a_off + ((size_t)(TP + 16 * rt + fr) * K + 8 * fq) * 2), bo = (unsigned)(b_off + ((size_t)(16 * ct + fr) * K + 8 * fq) * 2);
        f32x4 acc = (f32x4){0.f, 0.f, 0.f, 0.f};
        bf16x8 a0[8], b0[8], a1[8], b1[8];
#pragma unroll
        for (int j = 0; j < 8; ++j) { a0[j] = *(const bf16x8*)(wsb + ao + 64 * j); b0[j] = *(const bf16x8*)(wsb + bo + 64 * j); }
        for (int k0 = 0; k0 < K; k0 += 512) {
#pragma unroll
            for (int j = 0; j < 8; ++j) { a1[j] = *(const bf16x8*)(wsb + ao + 512 + 64 * j); b1[j] = *(const bf16x8*)(wsb + bo + 512 + 64 * j); }
            __builtin_amdgcn_sched_barrier(0);
#pragma unroll
            for (int j = 0; j < 8; ++j) acc = MFMA32(a0[j], b0[j], acc);
            __builtin_amdgcn_sched_barrier(0);
            const unsigned adv = (k0 + 512 < K) ? 1024u : 0u;
#pragma unroll
            for (int j = 0; j < 8; ++j) { a0[j] = *(const bf16x8*)(wsb + ao + adv + 64 * j); b0[j] = *(const bf16x8*)(wsb + bo + adv + 64 * j); }
            __builtin_amdgcn_sched_barrier(0);
#pragma unroll
            for (int j = 0; j < 8; ++j) acc = MFMA32(a1[j], b1[j], acc);
            __builtin_amdgcn_sched_barrier(0);
            ao += 1024; bo += 1024; }
#pragma unroll
        for (int r = 0; r < 4; ++r) { const int row = TP + 16 * rt + 4 * fq + r; float q = E(row, 16 * ct + fr, acc[r]);
            if constexpr (SE::ROWSUM) { q += __shfl_xor(q, 1); q += __shfl_xor(q, 2); q += __shfl_xor(q, 4); q += __shfl_xor(q, 8); if (fr == 0) atomicAdd(E.SS + row, q); } }
    }
}

#ifndef HOST_EMU
#define XB_TMO      128
#define XB_XCNT(j)  (256  + 64 * (j))
#define XB_XSUB(j)  (1280 + 64 * (j))
#define XB_XGEN(j)  (2304 + 64 * (j))
#define XB_TOP      3328
#define XB_TOPGEN   3392
#define XCD_BAR_WORDS 3456
#define XB_SPIN_CAP (1u << 18)
__device__ __forceinline__ unsigned xb_ld(unsigned* p)              { return __hip_atomic_load(p, __ATOMIC_RELAXED, __HIP_MEMORY_SCOPE_AGENT); }
__device__ __forceinline__ unsigned xb_add(unsigned* p, unsigned v) { return __hip_atomic_fetch_add(p, v, __ATOMIC_RELAXED, __HIP_MEMORY_SCOPE_AGENT); }
__device__ __forceinline__ unsigned xb_xcc_id() { return (unsigned)__builtin_amdgcn_s_getreg((3 << 11) | 20) & 0xFu; }
#define XB_SPIN(cond, bar) do { unsigned _sp = 0; while (cond) { __builtin_amdgcn_s_sleep(1); \
    if ((++_sp & 255u) == 0u) { if (xb_ld(&(bar)[XB_TMO])) break; if (_sp > XB_SPIN_CAP) { atomicAdd(&(bar)[XB_TMO], 1u); break; } } } } while (0)
struct XcdBarrier { unsigned* bar; unsigned x; volatile LAS unsigned* st; };
__device__ __forceinline__ XcdBarrier xcd_barrier_post(unsigned* bar, volatile LAS unsigned* st) {
    XcdBarrier b; b.bar = bar; b.x = xb_xcc_id(); b.st = st;
    if (threadIdx.x == 0) (void)xb_add(&bar[XB_XCNT(b.x)], 1u);
    return b;
}
__device__ __forceinline__ void xcd_barrier_complete(unsigned* bar, unsigned x, unsigned& nloc, unsigned& nx) {
    const unsigned G = gridDim.x * gridDim.y * gridDim.z;
    unsigned sum, cnt, mine, sp = 0u;
    for (;;) {
        sum = 0u; cnt = 0u; mine = 0u;
#pragma unroll
        for (unsigned j = 0; j < 16; ++j) { const unsigned c = xb_ld(&bar[XB_XCNT(j)]); sum += c; cnt += (c > 0u) ? 1u : 0u; mine = (j == x) ? c : mine; }
        if (sum == G) break;
        __builtin_amdgcn_s_sleep(1);
        if ((++sp & 255u) == 0u) { if (xb_ld(&bar[XB_TMO])) break; if (sp > XB_SPIN_CAP) { atomicAdd(&bar[XB_TMO], 1u); break; } }
    }
    nloc = mine > 0u ? mine : 1u; nx = cnt > 0u ? cnt : 1u;
}
__device__ __forceinline__ void xcd_barrier(const XcdBarrier& b) {
    asm volatile("s_waitcnt vmcnt(0)" ::: "memory");
    __syncthreads();
    if (threadIdx.x == 0) {
        unsigned* bar = b.bar;
        __builtin_amdgcn_s_waitcnt(0);
        unsigned nloc = b.st[0], nx = b.st[1];
        if (nloc == 0u) { xcd_barrier_complete(bar, b.x, nloc, nx); b.st[0] = nloc; b.st[1] = nx; }
        const unsigned old = xb_add(&bar[XB_XSUB(b.x)], 1u);
        const unsigned gen = old / nloc;
        if (old + 1u == (gen + 1u) * nloc) {
            __builtin_amdgcn_fence(__ATOMIC_RELEASE, "agent");
            asm volatile("s_waitcnt vmcnt(0)" ::: "memory");
            const unsigned og = xb_add(&bar[XB_TOP], 1u);
            const unsigned tg = og / nx;
            if (og + 1u == (tg + 1u) * nx) xb_add(&bar[XB_TOPGEN], 1u);
            else XB_SPIN(xb_ld(&bar[XB_TOPGEN]) == tg, bar);
            __builtin_amdgcn_fence(__ATOMIC_ACQUIRE, "agent");
            xb_add(&bar[XB_XGEN(b.x)], 1u);
            asm volatile("s_waitcnt vmcnt(0)" ::: "memory");
        } else {
            XB_SPIN(xb_ld(&bar[XB_XGEN(b.x)]) == gen, bar);
            __builtin_amdgcn_fence(__ATOMIC_ACQUIRE, "agent");
            asm volatile("s_waitcnt vmcnt(0)" ::: "memory");
        }
    }
    __syncthreads();
}
#endif

constexpr int PH_PRO = 0, PH_KV = 1, PH_L0 = 2, PH_PER_LAYER = 18, PH_FINAL = PH_L0 + 2 * PH_PER_LAYER, NPH = PH_FINAL + 1;
#ifdef HOST_EMU
__device__ __forceinline__ Ctx make_ctx(const Args& args, unsigned char* lds, int) {
    Ctx C; C.lds = lds; C.tid = threadIdx.x; C.lane = C.tid & 63; C.wave = C.tid >> 6; C.G = gridDim.x; C.bid = blockIdx.x; C.ap = &args; C.out = args.out; C.ws = args.ws; return C;
}
#else
__device__ __forceinline__ Ctx make_ctx(const Args& args, unsigned char* lds, int wave_s) {
    Ctx C; int wave = wave_s; asm volatile("" : "+s"(wave));
    int lane = __builtin_amdgcn_mbcnt_hi(~0u, __builtin_amdgcn_mbcnt_lo(~0u, 0u)); asm volatile("" : "+v"(lane));
    int bid = blockIdx.x, G = gridDim.x; asm volatile("" : "+s"(bid), "+s"(G));
    const CAS unsigned char* kp = (const CAS unsigned char*)__builtin_amdgcn_kernarg_segment_ptr(); asm volatile("" : "+s"(kp));
    int tid = wave * 64 + lane; asm volatile("" : "+v"(tid));
    C.lds = (LAS unsigned char*)lds; C.tid = tid; C.lane = tid & 63; C.wave = __builtin_amdgcn_readfirstlane(tid >> 6); C.G = G; C.bid = bid; C.kp = kp;
    C.out = *(float* const CAS*)(kp + 264); C.ws = *(unsigned char* const CAS*)(kp + 272);
    return C;
}
static_assert(sizeof(Args) == 288, "Args layout (kernarg offsets in make_ctx)");
#endif
__global__ void __launch_bounds__(512, 2) mk_fwd(Args args) {
    DYN_LDS(lds);
    const int lo = args.ph_lo, hi = args.ph_hi;
    const int wave_s = __builtin_amdgcn_readfirstlane((int)threadIdx.x >> 6);
#ifndef HOST_EMU
    volatile LAS unsigned* lctl = (volatile LAS unsigned*)((LAS unsigned char*)lds + LDS_CTL_OFF);
    if (threadIdx.x < 64) lctl[threadIdx.x] = 0u;
    __syncthreads();
    if (hi - lo > 1) (void)xcd_barrier_post((unsigned*)(args.ws + WS_CTL) + 4096, lctl + 8);
#define GRID_BAR() do { XcdBarrier bar_; { const CAS unsigned char* kp_ = (const CAS unsigned char*)__builtin_amdgcn_kernarg_segment_ptr(); asm volatile("" : "+s"(kp_)); \
        bar_.bar = (unsigned*)(*(unsigned char* const CAS*)(kp_ + 272) + WS_CTL) + 4096; } bar_.x = xb_xcc_id(); bar_.st = (volatile LAS unsigned*)((LAS unsigned char*)lds + LDS_CTL_OFF) + 8; xcd_barrier(bar_); } while (0)
#else
#define GRID_BAR() ((void)0)
#endif
#define IN(k) (lo <= (k) && (k) < hi)
#define SEAM(k) do { if (IN(k) && IN((k) + 1)) GRID_BAR(); } while (0)
#define CTX const Ctx C = make_ctx(args, lds, wave_s)
#define GEMM_PHASE(EPI, Aoff, Boff, M_, N_, K_, ...) do { CTX; pg8::Gemm g{WSP(const bf16, Aoff), WSP(const bf16, Boff), M_, N_, K_}; pg8::StaticOrder S; S.init(M_, N_, C.G, C.bid); \
        EPI E{__VA_ARGS__}; pg8::gemm_phase<EPI, true>(C.lds, C.tid, g, S, E); } while (0)
    if (IN(PH_PRO)) { { CTX; phase_prologue(C); } __syncthreads(); { CTX; phase_wconv(C, 0); } { CTX; phase_xprep(C); } } SEAM(PH_PRO);
    if (IN(PH_KV)) GEMM_PHASE(EpiMemKV, WS_MEMP, WS_WKV, NB * MTOK, 8192, DM, C.out, WSP(bf16, WS_KP), WSP(bf16, WS_VTP)); SEAM(PH_KV);
#ifndef PROBE_MASK
#define PROBE_MASK 0
#endif
#define LPH(off, ...) do { if (IN(pb + (off))) { __VA_ARGS__; if ((PROBE_MASK >> (off)) & 1) { GRID_BAR(); __VA_ARGS__; } } SEAM(pb + (off)); } while (0)
    for (int l = 0; l < 2; ++l) {
        const int pb = PH_L0 + PH_PER_LAYER * l;
        if (IN(pb + 0)) { if (l > 0) { CTX; phase_wconv(C, l); } if (PROBE_MASK & 1) { GRID_BAR(); CTX; phase_wconv(C, l); } } SEAM(pb + 0);
        LPH(2, GEMM_PHASE(EpiProj, WS_H, WS_WIN, T, NPROJ_PAD, DM, WSP(bf16, WS_PROJ), WSP(float, WS_SMALL), WSP(const float, WS_SS) + (size_t)(3 * l) * T));
        LPH(3, { CTX; phase_prep(C, l); });
        LPH(4, { CTX; phase_chunkprep(C, l); });
        LPH(5, { CTX; phase_scan(C, l); });
        LPH(6, { CTX; phase_ynorm(C, l); });
        LPH(7, { GEMM_PHASE(EpiGate0, WS_YS, WS_WB0, TP, DM, DM, WSP(const bf16, WS_PROJ), WSP(float, WS_YSR)); CTX; sample_gemm(C, WS_YS, WS_WB0, DM, SEpiGate0{WSP(const bf16, WS_PROJ), WSP(float, WS_YSR)}); });
        LPH(8, { GEMM_PHASE(EpiGate1, WS_YG, WS_WB1, TP, DM, DM, WSP(const bf16, WS_PROJ), WSP(const float, WS_YSR), WSP(bf16, WS_MRG)); CTX; sample_gemm(C, WS_YG, WS_WB1, DM, SEpiGate1{WSP(const bf16, WS_PROJ), WSP(const float, WS_YSR), WSP(bf16, WS_MRG)}); });
        LPH(9, { GEMM_PHASE(EpiResid, WS_MRG, WS_WOUT, TP, DM, DM, WSP(float, WS_X), WSP(bf16, WS_H), WSP(float, WS_SS) + (size_t)(3 * l + 1) * T); CTX; sample_gemm(C, WS_MRG, WS_WOUT, DM, SEpiResid{WSP(float, WS_X), WSP(bf16, WS_H), WSP(float, WS_SS) + (size_t)(3 * l + 1) * T}); });
        LPH(11, { GEMM_PHASE(EpiBf16, WS_H, WS_WMQ, TP, DM, DM, WSP(bf16, WS_YS), DM, WSP(const float, WS_SS) + (size_t)(3 * l + 1) * T); CTX; sample_gemm(C, WS_H, WS_WMQ, DM, SEpiBf16{WSP(bf16, WS_YS), WSP(const float, WS_SS) + (size_t)(3 * l + 1) * T}); });
        LPH(12, { CTX; phase_attn(C, l); });
        LPH(13, { GEMM_PHASE(EpiResid, WS_YG, WS_WMO, TP, DM, DM, WSP(float, WS_X), WSP(bf16, WS_H), WSP(float, WS_SS) + (size_t)(3 * l + 2) * T); CTX; sample_gemm(C, WS_YG, WS_WMO, DM, SEpiResid{WSP(float, WS_X), WSP(bf16, WS_H), WSP(float, WS_SS) + (size_t)(3 * l + 2) * T}); });
        LPH(15, GEMM_PHASE(EpiBf16, WS_H, WS_WFI, T, DFF2, DM, WSP(bf16, WS_PROJ), DFF2, WSP(const float, WS_SS) + (size_t)(3 * l + 2) * T));
        LPH(16, { CTX; phase_ffnact(C, l); });
        LPH(17, { GEMM_PHASE(EpiResid, WS_YSR, WS_WFO, TP, DM, DFF, WSP(float, WS_X), WSP(bf16, WS_H), WSP(float, WS_SS) + (size_t)(3 * l + 3) * T); CTX; sample_gemm(C, WS_YSR, WS_WFO, DFF, SEpiResid{WSP(float, WS_X), WSP(bf16, WS_H), WSP(float, WS_SS) + (size_t)(3 * l + 3) * T}); });
    }
    if (IN(PH_FINAL)) { CTX; phase_final(C); }
#undef IN
#undef SEAM
#undef GRID_BAR
}

extern "C" void kernel_launch(void* const* d_in, const int* in_sizes, int n_in, void* d_out, int out_size, void* d_ws, size_t ws_size, hipStream_t stream) {
    static int grid = 0;
    if (grid == 0) {
        if (n_in != 33 || (size_t)out_size != O_END || ws_size < WS_END) { fprintf(stderr, "kernel_launch: unexpected shapes (n_in %d out %d ws %zu; need out %zu ws %zu)\n", n_in, out_size, ws_size, (size_t)O_END, (size_t)WS_END); grid = -1; return; }
        int dev = 0, cus = 0;
        if (hipGetDevice(&dev) != hipSuccess || hipDeviceGetAttribute(&cus, hipDeviceAttributeMultiprocessorCount, dev) != hipSuccess) { grid = -1; return; }
        if (hipFuncSetAttribute((const void*)mk_fwd, hipFuncAttributeMaxDynamicSharedMemorySize, LDS_BYTES) != hipSuccess) { fprintf(stderr, "kernel_launch: hipFuncSetAttribute failed\n"); grid = -1; return; }
        (void)hipGetLastError();
        grid = cus;
    }
    if (grid < 0) return;
    (void)hipMemsetAsync((char*)d_ws + WS_CTL, 0, CTL_BYTES, stream);
    Args a{};
    for (int i = 0; i < 33; ++i) a.in[i] = (const float*)d_in[i];
    a.out = (float*)d_out; a.ws = (unsigned char*)d_ws;
#ifdef HOST_EMU
    const char* e0 = getenv("EMU_PH_LO"); const char* e1 = getenv("EMU_PH_HI");
    const int plo = e0 ? atoi(e0) : 0, phi = e1 ? atoi(e1) : NPH;
    for (int p = plo; p < phi; ++p) { a.ph_lo = p; a.ph_hi = p + 1; fprintf(stderr, "emu: phase %d\n", p); emu_launch(mk_fwd, (unsigned)grid, 512u, (size_t)LDS_BYTES, a); }
#else
#if MK_ONE_LAUNCH
    a.ph_lo = 0; a.ph_hi = NPH;
    hipLaunchKernelGGL(mk_fwd, dim3(grid), dim3(512), LDS_BYTES, stream, a);
#else
    for (int p = 0; p < NPH; ++p) { a.ph_lo = p; a.ph_hi = p + 1; hipLaunchKernelGGL(mk_fwd, dim3(grid), dim3(512), LDS_BYTES, stream, a); }
#endif
#endif
}
```

```cpp
#ifndef HOST_EMU
#include <hip/hip_runtime.h>
#endif
#include <cstdio>
#include <cstdint>

#ifndef CFG_BATCH
#define CFG_BATCH 4
#endif
#ifndef CFG_SEQ
#define CFG_SEQ 2048
#endif
#ifndef MK_ONE_LAUNCH
#define MK_ONE_LAUNCH 1
#endif

#ifdef HOST_EMU
#define LAS
#define VMCNT(n) ((void)emu_wave_op([](unsigned char*) {}, [](unsigned char (*)[64]) {}))
#define LGKMCNT(n) ((void)0)
#define MEMCLOB() ((void)0)
#define WAVE_LDS_SYNC() ((void)emu_wave_op([](unsigned char*) {}, [](unsigned char (*)[64]) {}))
#define DYN_LDS(name) unsigned char* name = emu_lds()
#define LAUNDER_V(x) ((void)0)
#else
#define LAS __attribute__((address_space(3)))
#define VMCNT(n) asm volatile("s_waitcnt vmcnt(" #n ")" ::: "memory")
#define LGKMCNT(n) asm volatile("s_waitcnt lgkmcnt(" #n ")" ::: "memory")
#define MEMCLOB() asm volatile("" ::: "memory")
#define WAVE_LDS_SYNC() asm volatile("s_waitcnt lgkmcnt(0)" ::: "memory")
#define DYN_LDS(name) extern __shared__ __attribute__((aligned(16))) unsigned char name[]
#define LAUNDER_V(x) asm volatile("" : "+v"(x))
#endif

typedef unsigned short bf16;
typedef short bf16x8 __attribute__((ext_vector_type(8)));
typedef float f32x4 __attribute__((ext_vector_type(4)));
typedef float f32x2 __attribute__((ext_vector_type(2)));
typedef unsigned u32x4 __attribute__((ext_vector_type(4)));
typedef unsigned u32x2 __attribute__((ext_vector_type(2)));

__device__ __forceinline__ unsigned f2bf(float f) { unsigned u = __builtin_bit_cast(unsigned, f); return (u + 0x7fffu + ((u >> 16) & 1u)) >> 16; }
__device__ __forceinline__ float bf2f(unsigned b) { return __builtin_bit_cast(float, b << 16); }
__device__ __forceinline__ float bf_lo(unsigned w) { return __builtin_bit_cast(float, w << 16); }
__device__ __forceinline__ float bf_hi(unsigned w) { return __builtin_bit_cast(float, w & 0xffff0000u); }
#ifdef HOST_EMU
__device__ __forceinline__ unsigned cvt_pk_bf16(float lo, float hi) { return f2bf(lo) | (f2bf(hi) << 16); }
#else
typedef __bf16 bf16x2_native __attribute__((ext_vector_type(2)));
__device__ __forceinline__ unsigned cvt_pk_bf16(float lo, float hi) { const f32x2 v = {lo, hi}; return __builtin_bit_cast(unsigned, __builtin_convertvector(v, bf16x2_native)); }
#endif
__device__ __forceinline__ void unpack8(const u32x4 w, float (&v)[8]) { v[0] = bf_lo(w.x); v[1] = bf_hi(w.x); v[2] = bf_lo(w.y); v[3] = bf_hi(w.y); v[4] = bf_lo(w.z); v[5] = bf_hi(w.z); v[6] = bf_lo(w.w); v[7] = bf_hi(w.w); }
__device__ __forceinline__ u32x4 pack8(const float (&v)[8]) { u32x4 w; w.x = cvt_pk_bf16(v[0], v[1]); w.y = cvt_pk_bf16(v[2], v[3]); w.z = cvt_pk_bf16(v[4], v[5]); w.w = cvt_pk_bf16(v[6], v[7]); return w; }
__device__ __forceinline__ u32x4 zero16() { unsigned z = 0u; LAUNDER_V(z); return (u32x4){z, z, z, z}; }
__device__ __forceinline__ bf16x8 zero8h() { return __builtin_bit_cast(bf16x8, zero16()); }
__device__ __forceinline__ float sigmoidf_(float x) { return 1.0f / (1.0f + __expf(-x)); }
__device__ __forceinline__ float siluf_(float x) { return x / (1.0f + __expf(-x)); }
__device__ __forceinline__ float softplusf_(float x) { return x > 20.f ? x : __logf(1.0f + __expf(x)); }
__device__ __forceinline__ float logsigmoidf_(float x) { return fminf(x, 0.f) - __logf(1.0f + __expf(-fabsf(x))); }
__device__ __forceinline__ float wave_sum(float v) {
#pragma unroll
    for (int o = 1; o < 64; o <<= 1) v += __shfl_xor(v, o);
    return v;
}

constexpr int DM = 2048, NB = CFG_BATCH, SEQ = CFG_SEQ, TP = NB * SEQ, SBT = 16, SSQ = 16, TS = SBT * SSQ, T = TP + TS, NSEQ = NB + SBT;
constexpr int MTOK = 256, DFF = 5632, DFF2 = 11264, IN_DIM = 15408, NPROJ = 15360, NPROJ_PAD = 15616, XBCW = 3072;
constexpr int PZ = 0, PXBC = 2048, PQ = 5120, PK = 6144, PV = 7168, PG = 9216, PGATE = 11264;
constexpr float EPSF = 1e-6f;
static_assert(TP % 256 == 0 && SEQ % 16 == 0, "token tiling");
constexpr size_t O_Y = 0, O_PSSD = (size_t)T * DM, O_PSSDC = O_PSSD + (size_t)2 * NB * 32 * 64 * 128, O_PGLA = O_PSSDC + (size_t)2 * NB * 3 * XBCW, O_PFFC = O_PGLA + (size_t)2 * NB * 4 * 256 * 512,
                 O_PMK = O_PFFC + (size_t)2 * NB * 2 * DFF2, O_PMV = O_PMK + (size_t)2 * NB * MTOK * DM, O_SSSD = O_PMV + (size_t)2 * NB * MTOK * DM, O_SSSDC = O_SSSD + (size_t)2 * SBT * 32 * 64 * 128,
                 O_SGLA = O_SSSDC + (size_t)2 * SBT * 3 * XBCW, O_SFFC = O_SGLA + (size_t)2 * SBT * 4 * 256 * 512, O_END = O_SFFC + (size_t)2 * SBT * 2 * DFF2;
constexpr size_t A256(size_t x) { return (x + 255) & ~(size_t)255; }
constexpr size_t WS_CTL = 0, CTL_BYTES = 1u << 20;
constexpr size_t WS_WIN = WS_CTL + CTL_BYTES;
constexpr size_t WS_WB0 = WS_WIN + (size_t)NPROJ_PAD * DM * 2;
constexpr size_t WS_WB1 = WS_WB0 + (size_t)DM * DM * 2, WS_WOUT = WS_WB1 + (size_t)DM * DM * 2, WS_WMQ = WS_WOUT + (size_t)DM * DM * 2, WS_WMO = WS_WMQ + (size_t)DM * DM * 2;
constexpr size_t WS_WFI = WS_WMO + (size_t)DM * DM * 2;
constexpr size_t WS_WFO = WS_WFI + (size_t)DFF2 * DM * 2;
constexpr size_t WS_WKV = WS_WFO + (size_t)DM * DFF * 2;
constexpr size_t WS_X = WS_WKV + (size_t)8192 * DM * 2;
constexpr size_t WS_H = WS_X + (size_t)T * DM * 4;
constexpr size_t WS_PROJ = WS_H + (size_t)T * DM * 2;
constexpr size_t WS_SMALL = WS_PROJ + (size_t)T * NPROJ * 2;
constexpr size_t WS_XBC = WS_SMALL + (size_t)T * 256 * 4;
constexpr size_t WS_DT = WS_XBC + (size_t)T * XBCW * 2;
constexpr size_t WS_LOGA = WS_DT + (size_t)T * 32 * 4;
constexpr size_t WS_YSR = WS_LOGA + (size_t)T * 1024 * 4;
constexpr size_t WS_YGR = WS_YSR + (size_t)T * DM * 4;
constexpr size_t WS_YS = WS_YGR + (size_t)T * DM * 4;
constexpr size_t WS_YG = WS_YS + (size_t)T * DM * 2;
constexpr size_t WS_MRG = WS_YG + (size_t)T * DM * 2;
constexpr size_t WS_KP = WS_MRG + (size_t)T * DM * 2;
constexpr size_t WS_VTP = WS_KP + (size_t)2 * NB * MTOK * DM * 2;
constexpr size_t WS_KS = WS_VTP + (size_t)2 * NB * MTOK * DM * 2;
constexpr size_t WS_VTS = WS_KS + (size_t)2 * SBT * MTOK * DM * 2;
constexpr size_t WS_MEMP = WS_VTS + (size_t)2 * SBT * MTOK * DM * 2;
constexpr int NCK = T / 16, NCP = TP / 64, NCS = NCP + SBT;
static_assert(SEQ % 64 == 0, "SSD chunks must not straddle sequences");
constexpr size_t WS_WCH = WS_MEMP + (size_t)NB * MTOK * DM * 2;
constexpr size_t WS_XT = WS_WCH + (size_t)NCS * 32 * 64 * 64 * 2;
constexpr size_t WS_END0 = WS_XT + (size_t)NCS * DM * 64 * 2;
constexpr size_t WS_VT16 = WS_H;
constexpr size_t WS_QD = WS_MRG, WS_KET = WS_MRG + (size_t)T * 1024 * 2;
constexpr size_t WS_DEC = WS_WKV, WS_ATT = WS_DEC + (size_t)NCK * 1024 * 4, WS_EA = WS_ATT + (size_t)NCK * 4 * 256 * 2, WS_DECS = WS_EA + (size_t)NCS * 32 * 64 * 4;
constexpr size_t SZ_XTE = (size_t)NCS * DM * 64 * 2, SZ_BT = (size_t)NCS * 512 * 64 * 2, SZ_CC = (size_t)NCS * 64 * 512 * 2;
constexpr bool OVL_Y = SZ_XTE + SZ_BT + SZ_CC <= (size_t)2 * T * DM * 2;
constexpr size_t WS_XTE = OVL_Y ? WS_YS : WS_END0, WS_BT = WS_XTE + SZ_XTE, WS_CC = WS_BT + SZ_BT;
constexpr size_t WS_END = OVL_Y ? WS_END0 : WS_CC + SZ_CC;
static_assert(WS_DECS + (size_t)NCS * 32 * 4 <= WS_WKV + (size_t)8192 * DM * 2, "scan operand overlays");
static_assert((size_t)T * DFF * 2 <= (size_t)2 * T * DM * 4, "ACT overlay");
static_assert(WS_END <= (size_t)1081389824, "workspace budget");
constexpr size_t WS_SS = WS_CTL + 65536;
static_assert(65536 + (size_t)7 * T * 4 <= CTL_BYTES, "SS slots inside the zeroed control region");
constexpr int LDS_BYTES = 147456;
constexpr int LDS_CTL_OFF = 131072;

namespace pg8 {
constexpr int BM = 256, BK = 64, HALF = 128, HTB = HALF * BK * 2, STAGE_BYTES = 8 * HTB, NXCD = 8, WGM = 8;
__host__ __device__ __forceinline__ int lds_byte(int r, int c) { const int st = (r >> 4) * 2 + (c >> 5), rr = r & 15, cc = c & 31, ob = rr * 64 + cc * 2; return st * 1024 + (ob ^ (((ob >> 9) & 1) << 5)); }
__host__ __device__ __forceinline__ void stage_rc(int b, int& R, int& C) { const int st = b / 1024, sb = b % 1024, swz = sb ^ (((sb >> 9) & 1) << 5); R = (st >> 1) * 16 + swz / 64; C = (st & 1) * 32 + (swz % 64) / 2; }
__host__ __device__ __forceinline__ int perm32(int rho) { const int n = rho >> 4, i = rho & 15; return 8 * (i >> 2) + 4 * n + (i & 3); }
struct Unit { int pm, pn; };
struct Gemm { const bf16* A; const bf16* Bt; int M, N, K; };
struct StaticOrder {
    int nM, nN, nwg, G, c;
    __host__ __device__ void init(int M, int N, int G_, int c_) { nM = M / BM; nN = N / BM; nwg = nM * nN; G = G_; c = c_; }
    __host__ __device__ bool next(int i, Unit& u) const {
        const long L = (long)i * G + c; if (L >= nwg) return false;
        int wgid = (int)L; { const int q = nwg / NXCD, r = nwg % NXCD, xcd = wgid % NXCD, off = wgid / NXCD; wgid = (xcd < r ? xcd * (q + 1) : r * (q + 1) + (xcd - r) * q) + off; }
        const int nig = WGM * nN, gid = wgid / nig, fm = gid * WGM, gsz = (nM - fm) < WGM ? (nM - fm) : WGM;
        u.pm = fm + ((wgid % nig) % gsz); u.pn = (wgid % nig) / gsz; return true;
    }
};
template <class Epi, bool ALIGN_EPI>
__device__ __forceinline__ void gemm_phase(LAS unsigned char* lds, const int tid, const Gemm g, const StaticOrder& S, const Epi& E) {
    const int wid = __builtin_amdgcn_readfirstlane(tid >> 6), lane = tid & 63, wr = wid >> 2, wc = wid & 3, fr = lane & 15, fq = lane >> 4;
    const int K = g.K, nt = K / BK;
    unsigned voffA[2], voffB[2];
#pragma unroll
    for (int i = 0; i < 2; ++i) { int R, C; stage_rc(tid * 16 + i * 8192, R, C); const int Rb = Epi::PERM ? ((R & ~31) + perm32(R & 31)) : R;
        voffA[i] = (unsigned)(R * K + C) * 2u; voffB[i] = (unsigned)(Rb * K + C) * 2u; }
    const size_t kstep = (size_t)(BK * 2), hstep = (size_t)HALF * K * 2, tstep = 2 * hstep;
    const unsigned ldsw = (unsigned)wid * 1024u;
    const int aoff = lds_byte(wr * 64 + fr, fq * 8), boff = lds_byte(wc * 32 + fr, fq * 8);
#define PG8_SA(b, h) (((b) * 2 + (h)) * HTB)
#define PG8_SB(b, h) ((4 + (b) * 2 + (h)) * HTB)
#define PG8_STAGE(bufoff, gbase, voff) do { _Pragma("unroll") for (int _i = 0; _i < 2; ++_i) \
        __builtin_amdgcn_global_load_lds((const unsigned*)((const char*)(gbase) + (voff)[_i]), (LAS unsigned*)(lds + (bufoff) + ldsw + _i * 8192), 16, 0, 0); } while (0)
#define PG8_LDA(dst, b, h) do { _Pragma("unroll") for (int m = 0; m < 4; ++m) _Pragma("unroll") for (int k = 0; k < 2; ++k) dst[m][k] = *(const LAS bf16x8*)(lds + PG8_SA(b, h) + aoff + m * 2048 + k * 1024); } while (0)
#define PG8_LDB(dst, b, h) do { _Pragma("unroll") for (int n = 0; n < 2; ++n) _Pragma("unroll") for (int k = 0; k < 2; ++k) dst[n][k] = *(const LAS bf16x8*)(lds + PG8_SB(b, h) + boff + n * 2048 + k * 1024); } while (0)
#define PG8_MMA(ai, bj, At, Bt) do { __builtin_amdgcn_s_setprio(1); _Pragma("unroll") for (int m = 0; m < 4; ++m) _Pragma("unroll") for (int n = 0; n < 2; ++n) _Pragma("unroll") for (int k = 0; k < 2; ++k) \
        acc[ai][bj][m][n] = __builtin_amdgcn_mfma_f32_16x16x32_bf16(Bt[n][k], At[m][k], acc[ai][bj][m][n], 0, 0, 0); __builtin_amdgcn_s_setprio(0); } while (0)
#define PG8_BAR __builtin_amdgcn_s_barrier()
#define PG8_SCHED __builtin_amdgcn_sched_barrier(0)
    Unit cur, nxt; int ui = 0;
    if (!S.next(0, cur)) return;
    float zf = 0.f; LAUNDER_V(zf);
    f32x4 acc[2][2][4][2];
#pragma unroll
    for (int a = 0; a < 2; ++a)
#pragma unroll
        for (int b = 0; b < 2; ++b)
#pragma unroll
            for (int m = 0; m < 4; ++m)
#pragma unroll
                for (int n = 0; n < 2; ++n) acc[a][b][m][n] = (f32x4){zf, zf, zf, zf};
    bf16x8 At[4][2], B0[2][2], B1[2][2];
    const char* cA = (const char*)g.A + (size_t)cur.pm * tstep; const char* cB = (const char*)g.Bt + (size_t)cur.pn * tstep;
    PG8_STAGE(PG8_SB(0, 0), cB, voffB); PG8_STAGE(PG8_SB(0, 1), cB + hstep, voffB); PG8_STAGE(PG8_SA(0, 0), cA, voffA); PG8_STAGE(PG8_SA(0, 1), cA + hstep, voffA);
    if (wr == 1) PG8_BAR;
    VMCNT(2); PG8_BAR;
    PG8_STAGE(PG8_SB(1, 0), cB + kstep, voffB); PG8_STAGE(PG8_SA(1, 0), cA + kstep, voffA); PG8_STAGE(PG8_SB(1, 1), cB + hstep + kstep, voffB);
    VMCNT(6); PG8_BAR;
    for (;;) {
        const bool has_next = S.next(ui + 1, nxt);
        const char* nA = has_next ? (const char*)g.A + (size_t)nxt.pm * tstep : cA; const char* nB = has_next ? (const char*)g.Bt + (size_t)nxt.pn * tstep : cB;
        for (int t = 0; t < nt; t += 2) {
            const bool last = (t == nt - 2);
            const char* a1 = cA + (size_t)(t + 1) * kstep;
            const char* a2 = last ? nA : cA + (size_t)(t + 2) * kstep; const char* b2 = last ? nB : cB + (size_t)(t + 2) * kstep;
            const char* a3 = a2 + kstep; const char* b3 = b2 + kstep;
            PG8_LDB(B0, 0, 0); PG8_LDB(B1, 0, 1); PG8_SCHED; PG8_LDA(At, 0, 0); PG8_STAGE(PG8_SA(1, 1), a1 + hstep, voffA);
            VMCNT(8); LGKMCNT(0); PG8_BAR; PG8_MMA(0, 0, At, B0); PG8_MMA(0, 1, At, B1); PG8_BAR; PG8_SCHED;
            PG8_LDA(At, 0, 1); PG8_STAGE(PG8_SB(0, 0), b2, voffB); PG8_STAGE(PG8_SB(0, 1), b2 + hstep, voffB); PG8_STAGE(PG8_SA(0, 0), a2, voffA);
            VMCNT(8); LGKMCNT(0); PG8_BAR; PG8_MMA(1, 0, At, B0); PG8_MMA(1, 1, At, B1); PG8_BAR; PG8_SCHED;
            PG8_LDB(B0, 1, 0); PG8_LDB(B1, 1, 1); PG8_SCHED; PG8_LDA(At, 1, 0); PG8_STAGE(PG8_SA(0, 1), a2 + hstep, voffA);
            VMCNT(8); LGKMCNT(0); PG8_BAR; PG8_MMA(0, 0, At, B0); PG8_MMA(0, 1, At, B1); PG8_BAR; PG8_SCHED;
            PG8_LDA(At, 1, 1); PG8_STAGE(PG8_SB(1, 0), b3, voffB); PG8_STAGE(PG8_SB(1, 1), b3 + hstep, voffB); PG8_STAGE(PG8_SA(1, 0), a3, voffA);
            VMCNT(8); LGKMCNT(0); PG8_BAR; PG8_MMA(1, 0, At, B0); PG8_MMA(1, 1, At, B1); PG8_BAR; PG8_SCHED;
        }
        if constexpr (ALIGN_EPI) { if (wr == 0) PG8_BAR; }
        E(acc, cur, wr, wc, fr, fq);
        if (!has_next) break;
#pragma unroll
        for (int a = 0; a < 2; ++a)
#pragma unroll
            for (int b = 0; b < 2; ++b)
#pragma unroll
                for (int m = 0; m < 4; ++m)
#pragma unroll
                    for (int n = 0; n < 2; ++n) acc[a][b][m][n] = (f32x4){zf, zf, zf, zf};
        cur = nxt; cA = nA; cB = nB; ++ui;
        if constexpr (ALIGN_EPI) { if (wr == 1) PG8_BAR; }
    }
    VMCNT(0);
    if constexpr (!ALIGN_EPI) { if (wr == 0) PG8_BAR; }
    PG8_BAR;
#undef PG8_SA
#undef PG8_SB
#undef PG8_STAGE
#undef PG8_LDA
#undef PG8_LDB
#undef PG8_MMA
#undef PG8_BAR
#undef PG8_SCHED
}
}
using pg8::Unit;

#define EPI_LOOP_ROWS for (int ai = 0; ai < 2; ++ai) _Pragma("unroll") for (int m = 0; m < 4; ++m)
__device__ __forceinline__ float row_rstd(const float* SS, int row) { return 1.0f / sqrtf(SS[row] * (1.0f / DM) + EPSF); }
struct EpiBf16 {
    static constexpr bool PERM = true;
    bf16* O; int ldc; const float* SS;
    __device__ __forceinline__ void operator()(const f32x4 (&acc)[2][2][4][2], const Unit& u, int wr, int wc, int fr, int fq) const {
        const int row0 = u.pm * 256 + wr * 64 + fr, col0 = u.pn * 256 + wc * 32 + 8 * fq;
#pragma unroll
        EPI_LOOP_ROWS { const int row = row0 + ai * 128 + m * 16; const float rs = row_rstd(SS, row); bf16* rowp = O + (size_t)row * ldc + col0;
#pragma unroll
            for (int bj = 0; bj < 2; ++bj) { const f32x4 v0 = acc[ai][bj][m][0] * rs, v1 = acc[ai][bj][m][1] * rs;
                u32x4 w; w.x = cvt_pk_bf16(v0[0], v0[1]); w.y = cvt_pk_bf16(v0[2], v0[3]); w.z = cvt_pk_bf16(v1[0], v1[1]); w.w = cvt_pk_bf16(v1[2], v1[3]);
                *(u32x4*)(rowp + bj * 128) = w; } }
    }
};
struct EpiProj {
    static constexpr bool PERM = true;
    bf16* P; float* Sm; const float* SS;
    __device__ __forceinline__ void operator()(const f32x4 (&acc)[2][2][4][2], const Unit& u, int wr, int wc, int fr, int fq) const {
        const int row0 = u.pm * 256 + wr * 64 + fr;
        if (u.pn < NPROJ / 256) {
            const int col0 = u.pn * 256 + wc * 32 + 8 * fq;
#pragma unroll
            EPI_LOOP_ROWS { const int row = row0 + ai * 128 + m * 16; const float rs = row_rstd(SS, row); bf16* rowp = P + (size_t)row * NPROJ + col0;
#pragma unroll
                for (int bj = 0; bj < 2; ++bj) { const f32x4 v0 = acc[ai][bj][m][0] * rs, v1 = acc[ai][bj][m][1] * rs;
                    u32x4 w; w.x = cvt_pk_bf16(v0[0], v0[1]); w.y = cvt_pk_bf16(v0[2], v0[3]); w.z = cvt_pk_bf16(v1[0], v1[1]); w.w = cvt_pk_bf16(v1[2], v1[3]);
                    *(u32x4*)(rowp + bj * 128) = w; } }
        } else {
            const int col0 = wc * 32 + 8 * fq;
#pragma unroll
            EPI_LOOP_ROWS { const int row = row0 + ai * 128 + m * 16; const float rs = row_rstd(SS, row); float* rowp = Sm + (size_t)row * 256 + col0;
#pragma unroll
                for (int bj = 0; bj < 2; ++bj) { *(f32x4*)(rowp + bj * 128) = acc[ai][bj][m][0] * rs; *(f32x4*)(rowp + bj * 128 + 4) = acc[ai][bj][m][1] * rs; } }
        }
    }
};
struct EpiGate0 {
    static constexpr bool PERM = false;
    const bf16* P; float* M0;
    __device__ __forceinline__ void operator()(const f32x4 (&acc)[2][2][4][2], const Unit& u, int wr, int wc, int fr, int fq) const {
        const int row0 = u.pm * 256 + wr * 64 + fr, col0 = u.pn * 256 + wc * 32 + 4 * fq;
#pragma unroll
        EPI_LOOP_ROWS { const size_t r = (size_t)(row0 + ai * 128 + m * 16);
#pragma unroll
            for (int bj = 0; bj < 2; ++bj)
#pragma unroll
                for (int n = 0; n < 2; ++n) { const int c = col0 + bj * 128 + n * 16; const u32x2 gw = *(const u32x2*)(P + r * NPROJ + PGATE + c); const f32x4 a = acc[ai][bj][m][n];
                    f32x4 o; o[0] = a[0] * sigmoidf_(bf_lo(gw.x)); o[1] = a[1] * sigmoidf_(bf_hi(gw.x)); o[2] = a[2] * sigmoidf_(bf_lo(gw.y)); o[3] = a[3] * sigmoidf_(bf_hi(gw.y));
                    *(f32x4*)(M0 + r * DM + c) = o; } }
    }
};
struct EpiGate1 {
    static constexpr bool PERM = true;
    const bf16* P; const float* M0; bf16* O;
    __device__ __forceinline__ void operator()(const f32x4 (&acc)[2][2][4][2], const Unit& u, int wr, int wc, int fr, int fq) const {
        const int row0 = u.pm * 256 + wr * 64 + fr, col0 = u.pn * 256 + wc * 32 + 8 * fq;
#pragma unroll
        EPI_LOOP_ROWS { const size_t r = (size_t)(row0 + ai * 128 + m * 16);
#pragma unroll
            for (int bj = 0; bj < 2; ++bj) { const int c = col0 + bj * 128; const u32x4 gw = *(const u32x4*)(P + r * NPROJ + PGATE + DM + c); float gv[8]; unpack8(gw, gv);
                const f32x4 m0 = *(const f32x4*)(M0 + r * DM + c), m1 = *(const f32x4*)(M0 + r * DM + c + 4); const f32x4 a0 = acc[ai][bj][m][0], a1 = acc[ai][bj][m][1];
                float o[8];
#pragma unroll
                for (int j = 0; j < 4; ++j) { o[j] = m0[j] + a0[j] * sigmoidf_(gv[j]); o[4 + j] = m1[j] + a1[j] * sigmoidf_(gv[4 + j]); }
                *(u32x4*)(O + r * DM + c) = pack8(o); } }
    }
};
struct EpiResid {
    static constexpr bool PERM = false;
    float* X; bf16* H; float* SS;
    __device__ __forceinline__ void operator()(const f32x4 (&acc)[2][2][4][2], const Unit& u, int wr, int wc, int fr, int fq) const {
        const int row0 = u.pm * 256 + wr * 64 + fr, col0 = u.pn * 256 + wc * 32 + 4 * fq;
#pragma unroll
        EPI_LOOP_ROWS { const int row = row0 + ai * 128 + m * 16; float* rowp = X + (size_t)row * DM + col0; bf16* hp = H + (size_t)row * DM + col0; float ss = 0.f;
#pragma unroll
            for (int bj = 0; bj < 2; ++bj)
#pragma unroll
                for (int n = 0; n < 2; ++n) { f32x4* p = (f32x4*)(rowp + bj * 128 + n * 16); const f32x4 x = *p + acc[ai][bj][m][n]; *p = x;
                    ss += (x[0] * x[0] + x[1] * x[1]) + (x[2] * x[2] + x[3] * x[3]);
                    u32x2 w; w.x = cvt_pk_bf16(x[0], x[1]); w.y = cvt_pk_bf16(x[2], x[3]); *(u32x2*)(hp + bj * 128 + n * 16) = w; }
            ss += __shfl_xor(ss, 16); ss += __shfl_xor(ss, 32);
            if (fq == 0) atomicAdd(SS + row, ss); }
    }
};
struct EpiMemKV {
    static constexpr bool PERM = false;
    float* out; bf16* KP; bf16* VTP;
    __device__ __forceinline__ void operator()(const f32x4 (&acc)[2][2][4][2], const Unit& u, int wr, int wc, int fr, int fq) const {
        const int row0 = u.pm * 256 + wr * 64 + fr, colt = u.pn * 256, l = colt / 4096, kv = (colt / 2048) & 1, cbase = (colt & 2047) + wc * 32 + 4 * fq;
        float* dst = out + (kv ? O_PMV : O_PMK) + (size_t)l * NB * MTOK * DM;
#pragma unroll
        EPI_LOOP_ROWS { const int r = row0 + ai * 128 + m * 16, b = r >> 8, mt = r & 255;
#pragma unroll
            for (int bj = 0; bj < 2; ++bj)
#pragma unroll
                for (int n = 0; n < 2; ++n) { const int c = cbase + bj * 128 + n * 16; const f32x4 a = acc[ai][bj][m][n];
                    *(f32x4*)(dst + (size_t)r * DM + c) = a;
                    if (!kv) { u32x2 w; w.x = cvt_pk_bf16(a[0], a[1]); w.y = cvt_pk_bf16(a[2], a[3]); *(u32x2*)(KP + ((size_t)l * NB * MTOK + r) * DM + c) = w; }
                    else { bf16* vt = VTP + (((size_t)l * NB + b) * DM + c) * MTOK + mt;
#pragma unroll
                        for (int j = 0; j < 4; ++j) vt[(size_t)j * MTOK] = (bf16)f2bf(a[j]); } } }
    }
};

struct Args { const float* in[33]; float* out; unsigned char* ws; int ph_lo, ph_hi; };
#ifdef HOST_EMU
struct Ctx {
    LAS unsigned char* lds; int tid, lane, wave, G, bid;
    const Args* ap; float* out; unsigned char* ws;
    __device__ __forceinline__ const float* in(int i) const { return ap->in[i]; }
};
#else
#define CAS __attribute__((address_space(4)))
struct Ctx {
    LAS unsigned char* lds; int tid, lane, wave, G, bid;
    const CAS unsigned char* kp; float* out; unsigned char* ws;
    __device__ __forceinline__ const float* in(int i) const { return ((const float* const CAS*)kp)[i]; }
};
#endif
#define WSP(type, off) ((type*)(C.ws + (off)))

template <class RowMap>
__device__ __forceinline__ void transpose_item(const float* W, int K, int N, bf16* WT, const float* gain, LAS float* scr, int item, int lane, RowMap rowmap) {
    const int nblk = (N + 31) / 32, kb = item / nblk, nb = item % nblk, k0 = 64 * kb, n0 = 32 * nb;
    float vv[32]; const int nn = n0 + (lane & 31); const bool nok = nn < N; const float* wp = W + (size_t)(k0 + (lane >> 5)) * N + (nok ? nn : 0);
#pragma unroll
    for (int i = 0; i < 32; ++i) vv[i] = nok ? wp[(size_t)(2 * i) * N] : 0.f;
    if (gain) {
#pragma unroll
        for (int i = 0; i < 32; ++i) vv[i] *= gain[k0 + 2 * i + (lane >> 5)]; }
#pragma unroll
    for (int i = 0; i < 32; ++i) scr[(2 * i + (lane >> 5)) * 33 + (lane & 31)] = vv[i];
    WAVE_LDS_SYNC();
    const int c = lane & 7;
#pragma unroll
    for (int j = 0; j < 4; ++j) { const int n = (lane >> 3) + 8 * j; const LAS float* s = scr + (8 * c) * 33 + n;
        if (n0 + n < N) { u32x4 o; o.x = cvt_pk_bf16(s[0 * 33], s[1 * 33]); o.y = cvt_pk_bf16(s[2 * 33], s[3 * 33]); o.z = cvt_pk_bf16(s[4 * 33], s[5 * 33]); o.w = cvt_pk_bf16(s[6 * 33], s[7 * 33]);
            *(u32x4*)(WT + (size_t)rowmap(n0 + n) * K + k0 + 8 * c) = o; } }
    WAVE_LDS_SYNC();
}
struct RowId { int off; __device__ __forceinline__ int operator()(int n) const { return off + n; } };
struct RowWin { __device__ __forceinline__ int operator()(int n) const {
    return n < 5120 ? n : n < 5152 ? NPROJ + (n - 5120) : n < 11296 ? n - 32 : n < 11312 ? NPROJ + 32 + (n - 11296) : n - 48; } };

__device__ __forceinline__ void phase_wconv(const Ctx& C, int l) {
    LAS float* scr = (LAS float*)(C.lds + C.wave * 16384);
    const int gw = C.bid * 8 + C.wave, NGW = C.G * 8;
    const int I_IN = (DM / 64) * ((IN_DIM + 31) / 32), I_SQ = (DM / 64) * (DM / 32), I_FI = (DM / 64) * (DFF2 / 32), I_FO = (DFF / 64) * (DM / 32);
    const int NIT = I_IN + 5 * I_SQ + I_FI + I_FO;
    for (int it = gw; it < NIT; it += NGW) {
        int r = it;
        if (r < I_IN) { transpose_item(C.in(10) + (size_t)l * DM * IN_DIM, DM, IN_DIM, WSP(bf16, WS_WIN), C.in(9) + l * DM, scr, r, C.lane, RowWin{}); continue; } r -= I_IN;
        if (r < I_SQ) { transpose_item(C.in(20) + (size_t)(l * 2 + 0) * DM * DM, DM, DM, WSP(bf16, WS_WB0), (const float*)nullptr, scr, r, C.lane, RowId{0}); continue; } r -= I_SQ;
        if (r < I_SQ) { transpose_item(C.in(20) + (size_t)(l * 2 + 1) * DM * DM, DM, DM, WSP(bf16, WS_WB1), (const float*)nullptr, scr, r, C.lane, RowId{0}); continue; } r -= I_SQ;
        if (r < I_SQ) { transpose_item(C.in(21) + (size_t)l * DM * DM, DM, DM, WSP(bf16, WS_WOUT), (const float*)nullptr, scr, r, C.lane, RowId{0}); continue; } r -= I_SQ;
        if (r < I_SQ) { transpose_item(C.in(23) + (size_t)l * DM * DM, DM, DM, WSP(bf16, WS_WMQ), C.in(22) + l * DM, scr, r, C.lane, RowId{0}); continue; } r -= I_SQ;
        if (r < I_SQ) { transpose_item(C.in(26) + (size_t)l * DM * DM, DM, DM, WSP(bf16, WS_WMO), (const float*)nullptr, scr, r, C.lane, RowId{0}); continue; } r -= I_SQ;
        if (r < I_FI) { transpose_item(C.in(28) + (size_t)l * DM * DFF2, DM, DFF2, WSP(bf16, WS_WFI), C.in(27) + l * DM, scr, r, C.lane, RowId{0}); continue; } r -= I_FI;
        transpose_item(C.in(31) + (size_t)l * DFF * DM, DFF, DM, WSP(bf16, WS_WFO), (const float*)nullptr, scr, r, C.lane, RowId{0});
    }
    { u32x4* z = (u32x4*)(WSP(bf16, WS_WIN) + (size_t)(NPROJ + 48) * DM); const size_t n16 = (size_t)(NPROJ_PAD - NPROJ - 48) * DM * 2 / 16;
      for (size_t i = (size_t)C.bid * 512 + C.tid; i < n16; i += (size_t)C.G * 512) z[i] = zero16(); }
}
__device__ __forceinline__ void phase_prologue(const Ctx& C) {
    const size_t gt = (size_t)C.bid * 512 + C.tid, NT = (size_t)C.G * 512;
    { const f32x4* s = (const f32x4*)C.in(2); u32x2* d = WSP(u32x2, WS_MEMP); const size_t n = (size_t)NB * MTOK * DM / 4;
      for (size_t i = gt; i < n; i += NT) { const f32x4 v = s[i]; u32x2 w; w.x = cvt_pk_bf16(v[0], v[1]); w.y = cvt_pk_bf16(v[2], v[3]); d[i] = w; } }
    { const f32x4* s = (const f32x4*)C.in(7); u32x2* d = WSP(u32x2, WS_KS); const size_t n = (size_t)2 * SBT * MTOK * DM / 4;
      for (size_t i = gt; i < n; i += NT) { const f32x4 v = s[i]; u32x2 w; w.x = cvt_pk_bf16(v[0], v[1]); w.y = cvt_pk_bf16(v[2], v[3]); d[i] = w; } }
    LAS float* scr = (LAS float*)(C.lds + C.wave * 16384);
    const int gw = C.bid * 8 + C.wave, NGW = C.G * 8;
    const int I_V = (MTOK / 64) * (DM / 32), I_SQ = (DM / 64) * (DM / 32);
    const int NIT = 2 * SBT * I_V + 4 * I_SQ;
    for (int it = gw; it < NIT; it += NGW) {
        if (it < 2 * SBT * I_V) { const int lb = it / I_V, r = it % I_V;
            transpose_item(C.in(8) + (size_t)lb * MTOK * DM, MTOK, DM, WSP(bf16, WS_VTS) + (size_t)lb * DM * MTOK, (const float*)nullptr, scr, r, C.lane, RowId{0}); }
        else { const int q = (it - 2 * SBT * I_V) / I_SQ, r = (it - 2 * SBT * I_V) % I_SQ, l = q >> 1, kv = q & 1;
            transpose_item(C.in(kv ? 25 : 24) + (size_t)l * DM * DM, DM, DM, WSP(bf16, WS_WKV), (const float*)nullptr, scr, r, C.lane, RowId{q * DM}); }
    }
}
__device__ __forceinline__ void phase_xprep(const Ctx& C) {
    const int gw = C.bid * 8 + C.wave, NGW = C.G * 8;
    for (int row = gw; row < T; row += NGW) {
        const f32x4* xr = (row < TP ? (const f32x4*)C.in(0) + (size_t)row * (DM / 4) : (const f32x4*)C.in(1) + (size_t)(row - TP) * (DM / 4)) + C.lane; f32x4 v[8]; float s = 0.f;
#pragma unroll
        for (int j = 0; j < 8; ++j) { v[j] = xr[64 * j]; s += (v[j][0] * v[j][0] + v[j][1] * v[j][1]) + (v[j][2] * v[j][2] + v[j][3] * v[j][3]); }
        s = wave_sum(s); if (C.lane == 0) WSP(float, WS_SS)[row] = s;
        u32x2* o = WSP(u32x2, WS_H) + (size_t)row * (DM / 4) + C.lane; f32x4* xo = WSP(f32x4, WS_X) + (size_t)row * (DM / 4) + C.lane;
#pragma unroll
        for (int j = 0; j < 8; ++j) { u32x2 w; w.x = cvt_pk_bf16(v[j][0], v[j][1]); w.y = cvt_pk_bf16(v[j][2], v[j][3]); o[64 * j] = w; xo[64 * j] = v[j]; }
    }
}
__device__ __forceinline__ void phase_final(const Ctx& C) {
    const int gw = C.bid * 8 + C.wave, NGW = C.G * 8; const f32x4* gn = (const f32x4*)C.in(32) + C.lane;
    for (int row = gw; row < T; row += NGW) {
        const f32x4* xr = WSP(const f32x4, WS_X) + (size_t)row * (DM / 4) + C.lane; f32x4 v[8];
#pragma unroll
        for (int j = 0; j < 8; ++j) v[j] = xr[64 * j];
        const float rstd = row_rstd(WSP(const float, WS_SS) + (size_t)6 * T, row);
        f32x4* o = (f32x4*)(C.out + O_Y) + (size_t)row * (DM / 4) + C.lane;
#pragma unroll
        for (int j = 0; j < 8; ++j) o[64 * j] = v[j] * rstd * gn[64 * j];
    }
}
struct SeqInfo { int sample, b, t, L, row0; };
__device__ __forceinline__ SeqInfo seq_of_row(int row) { SeqInfo s; if (row < TP) { s.sample = 0; s.b = row / SEQ; s.t = row % SEQ; s.L = SEQ; s.row0 = s.b * SEQ; } else { const int r = row - TP; s.sample = 1; s.b = r / SSQ; s.t = r % SSQ; s.L = SSQ; s.row0 = TP + s.b * SSQ; } return s; }
__device__ __forceinline__ SeqInfo seq_of_idx(int sq) { SeqInfo s; if (sq < NB) { s.sample = 0; s.b = sq; s.L = SEQ; s.row0 = sq * SEQ; } else { s.sample = 1; s.b = sq - NB; s.L = SSQ; s.row0 = TP + s.b * SSQ; } s.t = 0; return s; }

__device__ __forceinline__ void phase_prep_conv(const Ctx& C, int l) {
    const size_t gt = (size_t)C.bid * 512 + C.tid, NT = (size_t)C.G * 512;
    const bf16* P = WSP(const bf16, WS_PROJ); const float* Sm = WSP(const float, WS_SMALL);
    const float* cw = C.in(11) + (size_t)l * 4 * XBCW; const float* cb = C.in(12) + (size_t)l * XBCW; const float* st = C.in(4) + (size_t)l * SBT * 3 * XBCW;
    for (size_t it = gt; it < (size_t)(T / 16) * (XBCW / 8); it += NT) {
        const int seg = (int)(it / (XBCW / 8)), c = (int)(it % (XBCW / 8)) * 8, row0 = seg * 16; const SeqInfo s = seq_of_row(row0);
        u32x4 raw[19];
#pragma unroll
        for (int i = 0; i < 16; ++i) raw[3 + i] = *(const u32x4*)(P + (size_t)(row0 + i) * NPROJ + PXBC + c);
        float w[4][8], bias[8];
#pragma unroll
        for (int i = 0; i < 4; ++i) { const f32x4 a = *(const f32x4*)(cw + i * XBCW + c), b = *(const f32x4*)(cw + i * XBCW + c + 4);
#pragma unroll
            for (int j = 0; j < 4; ++j) { w[i][j] = a[j]; w[i][4 + j] = b[j]; } }
        { const f32x4 a = *(const f32x4*)(cb + c), b = *(const f32x4*)(cb + c + 4);
#pragma unroll
          for (int j = 0; j < 4; ++j) { bias[j] = a[j]; bias[4 + j] = b[j]; } }
        float hist[3][8];
        if (s.t >= 3) {
#pragma unroll
            for (int i = 0; i < 3; ++i) { raw[i] = *(const u32x4*)(P + (size_t)(row0 - 3 + i) * NPROJ + PXBC + c); unpack8(raw[i], hist[i]); } }
        else if (s.sample) {
#pragma unroll
            for (int i = 0; i < 3; ++i) { const float* sp = st + ((size_t)s.b * 3 + i) * XBCW + c;
#pragma unroll
                for (int j = 0; j < 8; ++j) hist[i][j] = sp[j]; } }
        else {
#pragma unroll
            for (int i = 0; i < 3; ++i)
#pragma unroll
                for (int j = 0; j < 8; ++j) hist[i][j] = 0.f; }
#pragma unroll
        for (int i = 0; i < 16; ++i) { float cur[8], o[8]; unpack8(raw[3 + i], cur);
#pragma unroll
            for (int j = 0; j < 8; ++j) { o[j] = siluf_(bias[j] + hist[0][j] * w[0][j] + hist[1][j] * w[1][j] + hist[2][j] * w[2][j] + cur[j] * w[3][j]); hist[0][j] = hist[1][j]; hist[1][j] = hist[2][j]; hist[2][j] = cur[j]; }
            *(u32x4*)(WSP(bf16, WS_XBC) + (size_t)(row0 + i) * XBCW + c) = pack8(o); }
    }
    for (size_t it = gt; it < (size_t)NSEQ * 3 * XBCW; it += NT) {
        const int c = (int)(it % XBCW), j = (int)(it / XBCW) % 3, sq = (int)(it / (3 * XBCW)); const SeqInfo s = seq_of_idx(sq);
        const float v = bf2f(P[(size_t)(s.row0 + s.L - 3 + j) * NPROJ + PXBC + c]);
        float* dst = C.out + (s.sample ? O_SSSDC + ((size_t)l * SBT + s.b) * 3 * XBCW : O_PSSDC + ((size_t)l * NB + s.b) * 3 * XBCW);
        dst[j * XBCW + c] = v;
    }
    for (size_t it = gt; it < (size_t)T * 32; it += NT) { const int row = (int)(it >> 5), h = (int)(it & 31);
        WSP(float, WS_DT)[it] = softplusf_(Sm[(size_t)row * 256 + h] + C.in(13)[l * 32 + h]); }
}

typedef short bf16x4 __attribute__((ext_vector_type(4)));
#define MFMA32(a, b, c) __builtin_amdgcn_mfma_f32_16x16x32_bf16(a, b, c, 0, 0, 0)
#define MFMA16(a, b, c) __builtin_amdgcn_mfma_f32_16x16x16bf16_1k(a, b, c, 0, 0, 0)
__device__ __forceinline__ bf16x8 mk8(u32x2 lo, u32x2 hi) { u32x4 w; w.x = lo.x; w.y = lo.y; w.z = hi.x; w.w = hi.y; return __builtin_bit_cast(bf16x8, w); }
__device__ __forceinline__ bf16x8 pack_tiles(const f32x4 t0, const f32x4 t1) { u32x4 w; w.x = cvt_pk_bf16(t0[0], t0[1]); w.y = cvt_pk_bf16(t0[2], t0[3]); w.z = cvt_pk_bf16(t1[0], t1[1]); w.w = cvt_pk_bf16(t1[2], t1[3]); return __builtin_bit_cast(bf16x8, w); }
struct ChunkInfo { int row0, nvalid; };
__device__ __forceinline__ ChunkInfo ssd_chunk(int cs) { ChunkInfo c; if (cs < NCP) { c.row0 = 64 * cs; c.nvalid = 64; } else { c.row0 = TP + SSQ * (cs - NCP); c.nvalid = SSQ; } return c; }

__device__ __forceinline__ void gla_prep_task(const Ctx& C, int l, int ck, int h) {
    const int lane = C.lane, fr = lane & 15, fq = lane >> 4, k4 = 4 * lane;
    LAS bf16* Lq = (LAS bf16*)(C.lds + C.wave * 16384); LAS bf16* Lk = Lq + 16 * 256;
    const bf16* P = WSP(const bf16, WS_PROJ); const float* Sm = WSP(const float, WS_SMALL);
    f32x4 bc[16]; f32x4 run = (f32x4){0.f, 0.f, 0.f, 0.f};
    { const float* wa2 = C.in(17) + (size_t)l * 16 * 1024 + h * 256 + k4; f32x4 wv[16];
#pragma unroll
      for (int r = 0; r < 16; ++r) wv[r] = *(const f32x4*)(wa2 + r * 1024);
      const f32x4 bav = *(const f32x4*)(C.in(18) + (size_t)l * 1024 + h * 256 + k4);
#pragma unroll
      for (int i = 0; i < 16; ++i) { const float* ar = Sm + (size_t)(16 * ck + i) * 256 + 32; f32x4 a = bav;
#pragma unroll
          for (int r4 = 0; r4 < 4; ++r4) { const f32x4 av = *(const f32x4*)(ar + 4 * r4);
#pragma unroll
              for (int q = 0; q < 4; ++q) a = a + wv[4 * r4 + q] * av[q]; }
#pragma unroll
          for (int j = 0; j < 4; ++j) run[j] += logsigmoidf_(a[j]) * (1.0f / 16.0f);
          bc[i] = run; } }
    const f32x4 b15 = bc[15];
    unsigned ke[4][8];
#pragma unroll
    for (int i = 0; i < 16; ++i) { const size_t row = (size_t)(16 * ck + i);
        const u32x2 qw = *(const u32x2*)(P + row * NPROJ + PQ + h * 256 + k4), kw = *(const u32x2*)(P + row * NPROJ + PK + h * 256 + k4);
        const float qv[4] = {bf_lo(qw.x), bf_hi(qw.x), bf_lo(qw.y), bf_hi(qw.y)}, kv[4] = {bf_lo(kw.x), bf_hi(kw.x), bf_lo(kw.y), bf_hi(kw.y)};
        float qd[4], ki[4], kend[4];
#pragma unroll
        for (int j = 0; j < 4; ++j) { qd[j] = qv[j] * 0.0625f * __expf(bc[i][j]); ki[j] = kv[j] * __expf(-bc[i][j]); kend[j] = kv[j] * __expf(b15[j] - bc[i][j]); }
        u32x2 w; w.x = cvt_pk_bf16(qd[0], qd[1]); w.y = cvt_pk_bf16(qd[2], qd[3]);
        *(u32x2*)(WSP(bf16, WS_QD) + row * 1024 + h * 256 + k4) = w; *(LAS u32x2*)(Lq + i * 256 + k4) = w;
        u32x2 w2; w2.x = cvt_pk_bf16(ki[0], ki[1]); w2.y = cvt_pk_bf16(ki[2], ki[3]); *(LAS u32x2*)(Lk + i * 256 + k4) = w2;
#pragma unroll
        for (int j = 0; j < 4; ++j) { if (i & 1) ke[j][i >> 1] |= f2bf(kend[j]) << 16; else ke[j][i >> 1] = f2bf(kend[j]); } }
#pragma unroll
    for (int j = 0; j < 4; ++j) { u32x4* d = (u32x4*)(WSP(bf16, WS_KET) + ((size_t)ck * 1024 + h * 256 + k4 + j) * 16);
        d[0] = (u32x4){ke[j][0], ke[j][1], ke[j][2], ke[j][3]}; d[1] = (u32x4){ke[j][4], ke[j][5], ke[j][6], ke[j][7]}; }
    { f32x4 dv; dv[0] = __expf(b15[0]); dv[1] = __expf(b15[1]); dv[2] = __expf(b15[2]); dv[3] = __expf(b15[3]); *(f32x4*)(WSP(float, WS_DEC) + (size_t)ck * 1024 + h * 256 + k4) = dv; }
    WAVE_LDS_SYNC();
    f32x4 att = (f32x4){0.f, 0.f, 0.f, 0.f};
#pragma unroll
    for (int ks = 0; ks < 8; ++ks) { const bf16x8 a = *(const LAS bf16x8*)(Lq + fr * 256 + 32 * ks + 8 * fq), b = *(const LAS bf16x8*)(Lk + fr * 256 + 32 * ks + 8 * fq); att = MFMA32(a, b, att); }
#pragma unroll
    for (int r = 0; r < 4; ++r) { const int i = 4 * fq + r; WSP(bf16, WS_ATT)[(((size_t)ck * 4 + h) * 16 + i) * 16 + fr] = (bf16)(fr <= i ? f2bf(att[r]) : 0u); }
    WAVE_LDS_SYNC();
    unsigned vt[8][8];
#pragma unroll
    for (int i = 0; i < 16; ++i) { float vv[8]; unpack8(*(const u32x4*)(P + (size_t)(16 * ck + i) * NPROJ + PV + h * 512 + 8 * lane), vv);
#pragma unroll
        for (int j = 0; j < 8; ++j) { if (i & 1) vt[j][i >> 1] |= f2bf(vv[j]) << 16; else vt[j][i >> 1] = f2bf(vv[j]); } }
#pragma unroll
    for (int j = 0; j < 8; ++j) { u32x4* d = (u32x4*)(WSP(bf16, WS_VT16) + ((size_t)ck * DM + h * 512 + 8 * lane + j) * 16);
        d[0] = (u32x4){vt[j][0], vt[j][1], vt[j][2], vt[j][3]}; d[1] = (u32x4){vt[j][4], vt[j][5], vt[j][6], vt[j][7]}; }
}
__device__ __forceinline__ void ssd_prep_head(const Ctx& C, int l, int cs, int h) {
    const int lane = C.lane, fr = lane & 15, fq = lane >> 4, g = h >> 3; const ChunkInfo ci = ssd_chunk(cs);
    LAS float* La = (LAS float*)(C.lds + C.wave * 16384); LAS float* Ld = La + 64;
    const bf16* XB = WSP(const bf16, WS_XBC); const float* DT = WSP(const float, WS_DT);
    const bf16x8 z8 = zero8h();
    f32x4 cb[4][4];
#pragma unroll
    for (int mt = 0; mt < 4; ++mt)
#pragma unroll
        for (int nt = 0; nt < 4; ++nt) cb[mt][nt] = (f32x4){0.f, 0.f, 0.f, 0.f};
#pragma unroll
    for (int ks = 0; ks < 4; ++ks) { bf16x8 af[4], bfr[4];
#pragma unroll
        for (int t = 0; t < 4; ++t) { const int i = 16 * t + fr; const bool ok = i < ci.nvalid; const bf16* rp = XB + (size_t)(ci.row0 + (ok ? i : 0)) * XBCW + g * 128 + 32 * ks + 8 * fq;
            af[t] = ok ? *(const bf16x8*)(rp + 2560) : z8; bfr[t] = ok ? *(const bf16x8*)(rp + 2048) : z8; }
#pragma unroll
        for (int mt = 0; mt < 4; ++mt)
#pragma unroll
            for (int nt = 0; nt <= mt; ++nt) cb[mt][nt] = MFMA32(af[mt], bfr[nt], cb[mt][nt]); }
    const bool jok = lane < ci.nvalid; const size_t jrow = (size_t)(ci.row0 + (jok ? lane : 0));
    const float a = -__expf(C.in(14)[l * 32 + h]); const float dtj = jok ? DT[jrow * 32 + h] : 0.f;
    float ac = dtj * a;
#pragma unroll
    for (int d = 1; d < 64; d <<= 1) { const float t = __shfl(ac, (lane - d) & 63); if (lane >= d) ac += t; }
    const float a63 = __shfl(ac, 63), te = __expf(a63 - ac) * dtj;
    La[lane] = ac; Ld[lane] = dtj;
    WSP(float, WS_EA)[((size_t)cs * 32 + h) * 64 + lane] = __expf(ac);
    if (lane == 0) WSP(float, WS_DECS)[(size_t)cs * 32 + h] = __expf(a63);
    u32x4 xr[8];
#pragma unroll
    for (int p8 = 0; p8 < 8; ++p8) xr[p8] = jok ? *(const u32x4*)(XB + jrow * XBCW + h * 64 + 8 * p8) : zero16();
#pragma unroll
    for (int p8 = 0; p8 < 8; ++p8) { float xv[8]; unpack8(xr[p8], xv);
#pragma unroll
        for (int q = 0; q < 8; ++q) { const size_t o = ((size_t)cs * DM + h * 64 + 8 * p8 + q) * 64 + lane; WSP(bf16, WS_XT)[o] = (bf16)f2bf(xv[q]); WSP(bf16, WS_XTE)[o] = (bf16)f2bf(xv[q] * te); } }
    WAVE_LDS_SYNC();
#pragma unroll
    for (int mt = 0; mt < 4; ++mt)
#pragma unroll
        for (int nt = 0; nt < 4; ++nt) { const int j = 16 * nt + fr; const float aj = La[j], dj = Ld[j];
#pragma unroll
            for (int r = 0; r < 4; ++r) { const int i = 16 * mt + 4 * fq + r; const float w = (nt <= mt && j <= i) ? cb[mt][nt][r] * __expf(La[i] - aj) * dj : 0.f;
                WSP(bf16, WS_WCH)[(((size_t)cs * 32 + h) * 64 + i) * 64 + j] = (bf16)f2bf(w); } }
    WAVE_LDS_SYNC();
}
__device__ __forceinline__ void ssd_prep_group(const Ctx& C, int cs, int g) {
    const int lane = C.lane; const ChunkInfo ci = ssd_chunk(cs); const bf16* XB = WSP(const bf16, WS_XBC);
    const bool jok = lane < ci.nvalid; const size_t jrow = (size_t)(ci.row0 + (jok ? lane : 0));
#pragma unroll 4
    for (int n8 = 0; n8 < 16; ++n8) { float bv[8];
        if (jok) unpack8(*(const u32x4*)(XB + jrow * XBCW + 2048 + g * 128 + 8 * n8), bv); else {
#pragma unroll
            for (int q = 0; q < 8; ++q) bv[q] = 0.f; }
#pragma unroll
        for (int q = 0; q < 8; ++q) WSP(bf16, WS_BT)[((size_t)cs * 512 + g * 128 + 8 * n8 + q) * 64 + lane] = (bf16)f2bf(bv[q]); }
#pragma unroll 4
    for (int it = 0; it < 16; ++it) { const int idx = it * 64 + lane, i = idx >> 4, n8 = idx & 15; const bool ok = i < ci.nvalid;
        const u32x4 v = ok ? *(const u32x4*)(XB + (size_t)(ci.row0 + i) * XBCW + 2560 + g * 128 + 8 * n8) : zero16();
        *(u32x4*)(WSP(bf16, WS_CC) + ((size_t)cs * 64 + i) * 512 + g * 128 + 8 * n8) = v; }
}
__device__ __forceinline__ void phase_prep(const Ctx& C, int l) {
    const int gw = C.wave * C.G + C.bid, NGW = C.G * 8;
    for (int t = gw; t < NCK * 4; t += NGW) gla_prep_task(C, l, t >> 2, t & 3);
    phase_prep_conv(C, l);
}
__device__ __forceinline__ void phase_chunkprep(const Ctx& C, int l) {
    const int gw = C.wave * C.G + C.bid, NGW = C.G * 8;
    constexpr int NHT = NCS * 32, NGT = NCS * 4;
    for (int t = gw; t < NHT + NGT; t += NGW) { if (t < NHT) ssd_prep_head(C, l, t >> 5, t & 31); else ssd_prep_group(C, (t - NHT) >> 2, (t - NHT) & 3); }
}
constexpr int GLA_SLOT = 18432, GLA_RING = 3 * GLA_SLOT;
__device__ __forceinline__ void gla_scan_task(const Ctx& C, int l, int sq, int h, int vs) {
    int lane = C.lane; LAUNDER_V(lane);
    const SeqInfo s = seq_of_idx(sq); const int fr = lane & 15, fq = lane >> 4, vc0 = h * 512 + vs * 16;
    f32x4 S[16];
    const size_t st_off = ((((size_t)l * (s.sample ? SBT : NB) + s.b) * 4 + h) * 256) * 512 + vs * 16;
    if (s.sample) { const float* st = C.in(5) + st_off;
#pragma unroll
        for (int kt = 0; kt < 16; ++kt)
#pragma unroll
            for (int r = 0; r < 4; ++r) S[kt][r] = st[(size_t)(16 * kt + 4 * fq + r) * 512 + fr]; }
    else {
#pragma unroll
        for (int kt = 0; kt < 16; ++kt) S[kt] = (f32x4){0.f, 0.f, 0.f, 0.f}; }
    VMCNT(0);
    const int nch = s.L / 16, ck0 = s.row0 / 16;
    const unsigned char* wsb = C.ws;
#define LDW(type, off) (*(const type*)(wsb + (off)))
    LAS unsigned char* ring = C.lds + C.wave * GLA_RING;
    unsigned gq = (unsigned)(WS_QD + ((size_t)(16 * ck0 + (lane & 15)) * 1024 + h * 256) * 2 + (lane >> 4) * 16);
    unsigned gk = (unsigned)(WS_KET + ((size_t)ck0 * 1024 + h * 256) * 32 + lane * 16);
    unsigned gd = (unsigned)(WS_DEC + ((size_t)ck0 * 1024 + h * 256) * 4 + lane * 16);
    unsigned ga = lane < 32 ? (unsigned)(WS_ATT + (((size_t)ck0 * 4 + h) * 256) * 2 + lane * 16) : (unsigned)(WS_VT16 + (((size_t)ck0 * DM + vc0) * 16) * 2 + (lane - 32) * 16);
    const unsigned sa = lane < 32 ? 2048u : (unsigned)(DM * 16 * 2);
#define GLA_DMA(slot) do { LAS unsigned char* sb_ = ring + (slot) * GLA_SLOT; LAUNDER_V(gq); LAUNDER_V(gk); LAUNDER_V(gd); LAUNDER_V(ga);     \
        _Pragma("unroll") for (int i = 0; i < 8; ++i) { \
            __builtin_amdgcn_global_load_lds((const unsigned*)(wsb + gq + i * 64), (LAS unsigned*)(sb_ + i * 1024), 16, 0, 0); \
            __builtin_amdgcn_global_load_lds((const unsigned*)(wsb + gk + i * 1024), (LAS unsigned*)(sb_ + 8192 + i * 1024), 16, 0, 0); } \
        __builtin_amdgcn_global_load_lds((const unsigned*)(wsb + gd), (LAS unsigned*)(sb_ + 16384), 16, 0, 0); \
        __builtin_amdgcn_global_load_lds((const unsigned*)(wsb + ga), (LAS unsigned*)(sb_ + 17408), 16, 0, 0); } while (0)
#define GLA_ADV(on) do { const unsigned a_ = (on) ? 1u : 0u; gq += a_ * (16 * 2048); gk += a_ * (1024 * 32); gd += a_ * 4096; ga += a_ * sa; } while (0)
    GLA_DMA(0); GLA_ADV(1 < nch); GLA_DMA(1); GLA_ADV(2 < nch);
    const int fh = fq & 1; const bool alo = fq < 2;
    const unsigned rq = (unsigned)(fr * 16 + 8 * fh + 256 * (fq >> 1));
    const unsigned rk = (unsigned)(8192 + fr * 32 + 16 * fh);
    const unsigned rat = (unsigned)(17408 + fr * 32 + 16 * fh), rv = rat + 512, rd = (unsigned)(16384 + 16 * fq);
    unsigned yo = (unsigned)(WS_YGR + ((size_t)(16 * ck0 + 4 * fq) * DM + vc0 + fr) * 4);
#define GLA_ITER(SL) do { \
        VMCNT(16); \
        __builtin_amdgcn_sched_barrier(0); \
        GLA_DMA(((SL) + 2) % 3); GLA_ADV(c + 3 < nch); \
        __builtin_amdgcn_sched_barrier(0); \
        const LAS unsigned char* sb = ring + (SL) * GLA_SLOT; \
        f32x4 o0 = (f32x4){0.f, 0.f, 0.f, 0.f}; \
        _Pragma("unroll") for (int ks = 0; ks < 8; ++ks) { \
            const u32x2 qa = *(const LAS u32x2*)(sb + rq + 1024 * ks), qb = *(const LAS u32x2*)(sb + rq + 1024 * ks + 512); \
            o0 = MFMA32(mk8(qa, qb), pack_tiles(S[2 * ks], S[2 * ks + 1]), o0); \
            if (ks & 1) __builtin_amdgcn_sched_barrier(0); } \
        const bf16x8 at = *(const LAS bf16x8*)(sb + rat); bf16x8 v0 = *(const LAS bf16x8*)(sb + rv); if (!alo) v0 = zero8h(); \
        o0 = MFMA32(at, v0, o0); \
        _Pragma("unroll") for (int r = 0; r < 4; ++r) *(float*)(C.ws + yo + (unsigned)(r * DM * 4)) = o0[r]; \
        yo += 16 * DM * 4; \
        _Pragma("unroll") for (int kt = 0; kt < 16; ++kt) { const f32x4 d = *(const LAS f32x4*)(sb + rd + 64 * kt); const bf16x8 ka = *(const LAS bf16x8*)(sb + rk + 512 * kt); \
            S[kt] = MFMA32(ka, v0, S[kt] * d); \
            if ((kt & 3) == 3) __builtin_amdgcn_sched_barrier(0); } \
        ++c; } while (0)
    for (int c = 0; c < nch;) { GLA_ITER(0); if (c >= nch) break; GLA_ITER(1); if (c >= nch) break; GLA_ITER(2); }
#undef GLA_ITER
    VMCNT(0);
#undef GLA_DMA
#undef GLA_ADV
    float* dst = C.out + (s.sample ? O_SGLA : O_PGLA) + st_off;
#pragma unroll
    for (int kt = 0; kt < 16; ++kt)
#pragma unroll
        for (int r = 0; r < 4; ++r) dst[(size_t)(16 * kt + 4 * fq + r) * 512 + fr] = S[kt][r];
}
__device__ __forceinline__ void ssd_scan_task(const Ctx& C, int l, int sq, int h, int ph) {
    const SeqInfo s = seq_of_idx(sq); const int lane = C.lane, fr = lane & 15, fq = lane >> 4, g = h >> 3, ch0 = h * 64 + ph * 32;
    f32x4 H[8][2];
    const size_t st_off = (((size_t)l * (s.sample ? SBT : NB) + s.b) * 32 + h) * 64 * 128;
    if (s.sample) { const float* st = C.in(3) + st_off;
#pragma unroll
        for (int nt = 0; nt < 8; ++nt)
#pragma unroll
            for (int pt = 0; pt < 2; ++pt) H[nt][pt] = *(const f32x4*)(st + (size_t)(ph * 32 + 16 * pt + fr) * 128 + 16 * nt + 4 * fq); }
    else {
#pragma unroll
        for (int nt = 0; nt < 8; ++nt) { H[nt][0] = (f32x4){0.f, 0.f, 0.f, 0.f}; H[nt][1] = (f32x4){0.f, 0.f, 0.f, 0.f}; } }
    const float Dh = C.in(15)[l * 32 + h];
    const int nch = s.sample ? 1 : SEQ / 64, cs0 = s.sample ? NCP + s.b : s.row0 / 64, nvalid = s.sample ? SSQ : 64;
    const unsigned char* wsb = C.ws;
    unsigned co = (unsigned)(WS_CC + (((size_t)cs0 * 64 + fr) * 512 + g * 128 + 4 * fq) * 2);
    unsigned eo = (unsigned)(WS_EA + (((size_t)cs0 * 32 + h) * 64 + 4 * fq) * 4);
    unsigned wo = (unsigned)(WS_WCH + ((((size_t)cs0 * 32 + h) * 64 + fr) * 64 + 8 * fq) * 2);
    unsigned xo = (unsigned)(WS_XT + (((size_t)cs0 * DM + ch0 + fr) * 64) * 2);
    unsigned xeo = (unsigned)(WS_XTE + (((size_t)cs0 * DM + ch0 + fr) * 64 + 8 * fq) * 2);
    unsigned bo = (unsigned)(WS_BT + (((size_t)cs0 * 512 + g * 128 + fr) * 64 + 8 * fq) * 2);
    unsigned deo = (unsigned)(WS_DECS + ((size_t)cs0 * 32 + h) * 4);
    unsigned yo = (unsigned)(WS_YSR + ((size_t)(s.row0 + 4 * fq) * DM + ch0 + fr) * 4);
#define SCHED_FENCE() __builtin_amdgcn_sched_barrier(0)
    for (int c = 0; c < nch; ++c) {
        u32x2 ca[4][4], cb2[4][4]; f32x4 ea[4];
#pragma unroll
        for (int mt = 0; mt < 4; ++mt) { ea[mt] = LDW(f32x4, eo + 64 * mt);
#pragma unroll
            for (int ks = 0; ks < 4; ++ks) { ca[mt][ks] = LDW(u32x2, co + mt * 16384 + 64 * ks); cb2[mt][ks] = LDW(u32x2, co + mt * 16384 + 64 * ks + 32); } }
        f32x4 y[4][2];
#pragma unroll
        for (int mt = 0; mt < 4; ++mt) { y[mt][0] = (f32x4){0.f, 0.f, 0.f, 0.f}; y[mt][1] = (f32x4){0.f, 0.f, 0.f, 0.f}; }
        SCHED_FENCE();
#pragma unroll
        for (int ks = 0; ks < 2; ++ks) { const bf16x8 b0 = pack_tiles(H[2 * ks][0], H[2 * ks + 1][0]), b1 = pack_tiles(H[2 * ks][1], H[2 * ks + 1][1]);
#pragma unroll
            for (int mt = 0; mt < 4; ++mt) { const bf16x8 a = mk8(ca[mt][ks], cb2[mt][ks]); y[mt][0] = MFMA32(a, b0, y[mt][0]); y[mt][1] = MFMA32(a, b1, y[mt][1]); } }
        SCHED_FENCE();
        bf16x8 wf[6], xf[2][2]; u32x2 xd[4][2];
#pragma unroll
        for (int mt = 0; mt < 4; ++mt) wf[mt] = LDW(bf16x8, wo + mt * 2048);
        wf[4] = LDW(bf16x8, wo + 2 * 2048 + 64); wf[5] = LDW(bf16x8, wo + 3 * 2048 + 64);
#pragma unroll
        for (int pt = 0; pt < 2; ++pt) { xf[0][pt] = LDW(bf16x8, xo + pt * 2048 + 16 * fq); xf[1][pt] = LDW(bf16x8, xo + pt * 2048 + 64 + 16 * fq);
#pragma unroll
            for (int mt = 0; mt < 4; ++mt) xd[mt][pt] = LDW(u32x2, xo + pt * 2048 + 32 * mt + 8 * fq); }
        SCHED_FENCE();
#pragma unroll
        for (int ks = 2; ks < 4; ++ks) { const bf16x8 b0 = pack_tiles(H[2 * ks][0], H[2 * ks + 1][0]), b1 = pack_tiles(H[2 * ks][1], H[2 * ks + 1][1]);
#pragma unroll
            for (int mt = 0; mt < 4; ++mt) { const bf16x8 a = mk8(ca[mt][ks], cb2[mt][ks]); y[mt][0] = MFMA32(a, b0, y[mt][0]); y[mt][1] = MFMA32(a, b1, y[mt][1]); } }
#pragma unroll
        for (int mt = 0; mt < 4; ++mt) { y[mt][0] = y[mt][0] * ea[mt]; y[mt][1] = y[mt][1] * ea[mt]; }
        SCHED_FENCE();
        bf16x8 bt0[8], bt1[8], xe[2][2]; const float dec = LDW(float, deo);
#pragma unroll
        for (int nt = 0; nt < 8; ++nt) bt0[nt] = LDW(bf16x8, bo + nt * 2048);
        xe[0][0] = LDW(bf16x8, xeo); xe[0][1] = LDW(bf16x8, xeo + 2048);
        SCHED_FENCE();
#pragma unroll
        for (int mt = 0; mt < 4; ++mt) { y[mt][0] = MFMA32(wf[mt], xf[0][0], y[mt][0]); y[mt][1] = MFMA32(wf[mt], xf[0][1], y[mt][1]); }
        y[2][0] = MFMA32(wf[4], xf[1][0], y[2][0]); y[2][1] = MFMA32(wf[4], xf[1][1], y[2][1]); y[3][0] = MFMA32(wf[5], xf[1][0], y[3][0]); y[3][1] = MFMA32(wf[5], xf[1][1], y[3][1]);
#pragma unroll
        for (int mt = 0; mt < 4; ++mt)
#pragma unroll
            for (int pt = 0; pt < 2; ++pt) { const float xv[4] = {bf_lo(xd[mt][pt].x), bf_hi(xd[mt][pt].x), bf_lo(xd[mt][pt].y), bf_hi(xd[mt][pt].y)};
#pragma unroll
                for (int r = 0; r < 4; ++r) if (16 * mt + 4 * fq + r < nvalid) *(float*)(C.ws + yo + (unsigned)(((16 * mt + r) * DM + 16 * pt) * 4)) = y[mt][pt][r] + Dh * xv[r]; }
        SCHED_FENCE();
#pragma unroll
        for (int nt = 0; nt < 8; ++nt) bt1[nt] = LDW(bf16x8, bo + nt * 2048 + 64);
        xe[1][0] = LDW(bf16x8, xeo + 64); xe[1][1] = LDW(bf16x8, xeo + 2048 + 64);
        SCHED_FENCE();
#pragma unroll
        for (int nt = 0; nt < 8; ++nt) { H[nt][0] = MFMA32(bt0[nt], xe[0][0], H[nt][0] * dec); H[nt][1] = MFMA32(bt0[nt], xe[0][1], H[nt][1] * dec); }
#pragma unroll
        for (int nt = 0; nt < 8; ++nt) { H[nt][0] = MFMA32(bt1[nt], xe[1][0], H[nt][0]); H[nt][1] = MFMA32(bt1[nt], xe[1][1], H[nt][1]); }
        co += 64 * 512 * 2; eo += 32 * 64 * 4; wo += 32 * 64 * 64 * 2; xo += DM * 64 * 2; xeo += DM * 64 * 2; bo += 512 * 64 * 2; deo += 32 * 4; yo += 64 * DM * 4;
    }
    float* dst = C.out + (s.sample ? O_SSSD : O_PSSD) + st_off;
#pragma unroll
    for (int nt = 0; nt < 8; ++nt)
#pragma unroll
        for (int pt = 0; pt < 2; ++pt) *(f32x4*)(dst + (size_t)(ph * 32 + 16 * pt + fr) * 128 + 16 * nt + 4 * fq) = H[nt][pt];
}
__device__ __forceinline__ void phase_scan(const Ctx& C, int l) {
    constexpr int NGP = NB * 4 * 32, NGS = SBT * 4 * 32, NSP = NB * 32 * 2, NSS = SBT * 32 * 2;
    static_assert(2 * GLA_RING <= 131072, "GLA rings fit the phase scratch");
    if (C.wave < 2) {
        for (int t = C.wave * C.G + C.bid; t < NGP + NGS; t += 2 * C.G) {
            if (t < NGP) gla_scan_task(C, l, t / 128, (t % 128) / 32, t % 32);
            else { const int u = t - NGP; gla_scan_task(C, l, NB + u / 128, (u % 128) / 32, u % 32); } }
    } else {
        for (int t = (C.wave - 2) * C.G + C.bid; t < NSP + NSS; t += 6 * C.G) {
            if (t < NSP) ssd_scan_task(C, l, t / 64, (t % 64) / 2, t % 2);
            else { const int r = t - NSP; ssd_scan_task(C, l, NB + r / 64, (r % 64) / 2, r % 2); } }
    }
}
__device__ __forceinline__ void phase_ynorm(const Ctx& C, int l) {
    const int gw = C.bid * 8 + C.wave, NGW = C.G * 8; const bf16* P = WSP(const bf16, WS_PROJ);
    const float* sn = C.in(16) + (size_t)l * DM; const float* gn = C.in(19) + (size_t)l * 512;
    for (int row = gw; row < T; row += NGW) {
#pragma unroll
        for (int gi = 0; gi < 4; ++gi) { const int c = gi * 512 + C.lane * 8;
            const f32x4 y0 = *(const f32x4*)(WSP(const float, WS_YSR) + (size_t)row * DM + c), y1 = *(const f32x4*)(WSP(const float, WS_YSR) + (size_t)row * DM + c + 4);
            float zv[8]; unpack8(*(const u32x4*)(P + (size_t)row * NPROJ + PZ + c), zv); float v[8]; float ss = 0.f;
#pragma unroll
            for (int j = 0; j < 8; ++j) { const float y = j < 4 ? y0[j] : y1[j - 4]; v[j] = y * siluf_(zv[j]); ss += v[j] * v[j]; }
            const float rstd = 1.0f / sqrtf(wave_sum(ss) * (1.0f / 512.0f) + EPSF);
#pragma unroll
            for (int j = 0; j < 8; ++j) v[j] = v[j] * rstd * sn[c + j];
            *(u32x4*)(WSP(bf16, WS_YS) + (size_t)row * DM + c) = pack8(v); }
#pragma unroll
        for (int hh = 0; hh < 4; ++hh) { const int c = hh * 512 + C.lane * 8;
            const f32x4 y0 = *(const f32x4*)(WSP(const float, WS_YGR) + (size_t)row * DM + c), y1 = *(const f32x4*)(WSP(const float, WS_YGR) + (size_t)row * DM + c + 4);
            float gv[8]; unpack8(*(const u32x4*)(P + (size_t)row * NPROJ + PG + c), gv); float v[8]; float ss = 0.f;
#pragma unroll
            for (int j = 0; j < 8; ++j) { v[j] = j < 4 ? y0[j] : y1[j - 4]; ss += v[j] * v[j]; }
            const float rstd = 1.0f / sqrtf(wave_sum(ss) * (1.0f / 512.0f) + EPSF);
#pragma unroll
            for (int j = 0; j < 8; ++j) v[j] = v[j] * rstd * gn[C.lane * 8 + j] * siluf_(gv[j]);
            *(u32x4*)(WSP(bf16, WS_YG) + (size_t)row * DM + c) = pack8(v); }
    }
}
__device__ __forceinline__ void phase_attn(const Ctx& C, int l) {
    constexpr int QT = SEQ / 128, NU_P = NB * 4 * QT, NU = NU_P + SBT * 4;
    constexpr int KROW = 1040, VROW = 528, BUFB = 16896;
    const int tid = C.tid, lane = C.lane, w = C.wave, fr = lane & 15, fq = lane >> 4;
    LAS unsigned char* KV = C.lds;
    LAS bf16* Pl = (LAS bf16*)(C.lds + 2 * BUFB + w * 8448);
    const int krow = tid >> 6, kc = tid & 63, vrow = tid >> 5, vc = tid & 31;
    const unsigned char* wsb = C.ws;
#define LDG(type, off) (*(const type*)(wsb + (off)))
    for (int u = C.bid; u < NU; u += C.G) {
        int row0, h, nvw; unsigned kbo, vbo;
        if (u < NU_P) { const int b = u / (4 * QT), r = u % (4 * QT); h = r / QT; row0 = b * SEQ + (r % QT) * 128; nvw = 8;
            kbo = (unsigned)(WS_KP + (((size_t)l * NB + b) * MTOK * DM + h * 512) * 2); vbo = (unsigned)(WS_VTP + ((((size_t)l * NB + b) * DM + h * 512) * MTOK) * 2); }
        else { const int r = u - NU_P, b = r / 4; h = r % 4; row0 = TP + b * SSQ; nvw = 1;
            kbo = (unsigned)(WS_KS + (((size_t)l * SBT + b) * MTOK * DM + h * 512) * 2); vbo = (unsigned)(WS_VTS + ((((size_t)l * SBT + b) * DM + h * 512) * MTOK) * 2); }
        const bool act = w < nvw; const int qrow = row0 + 16 * w;
        const unsigned kld = kbo + (unsigned)((krow * DM + kc * 8) * 2), vld = vbo + (unsigned)((vrow * MTOK + vc * 8) * 2);
        const unsigned qo = (unsigned)(WS_YS + ((size_t)(qrow + fr) * DM + h * 512 + 8 * fq) * 2), oo = (unsigned)(WS_YG + ((size_t)(qrow + 4 * fq) * DM + h * 512 + fr) * 2);
        __syncthreads();
        u32x4 st0 = LDG(u32x4, kld), st1 = LDG(u32x4, kld + 8 * DM * 2);
        bf16x8 qf[16];
        if (act) {
#pragma unroll
            for (int ks = 0; ks < 16; ++ks) qf[ks] = LDG(bf16x8, qo + 64 * ks); }
        else {
#pragma unroll
            for (int ks = 0; ks < 16; ++ks) qf[ks] = zero8h(); }
        *(LAS u32x4*)(KV + krow * KROW + kc * 16) = st0; *(LAS u32x4*)(KV + (krow + 8) * KROW + kc * 16) = st1;
        __syncthreads();
        f32x4 sacc[16];
#pragma unroll
        for (int kt = 0; kt < 16; ++kt) {
            if (kt < 15) { st0 = LDG(u32x4, kld + (kt + 1) * (16 * DM * 2)); st1 = LDG(u32x4, kld + (kt + 1) * (16 * DM * 2) + 8 * DM * 2); }
            else { st0 = LDG(u32x4, vld); st1 = LDG(u32x4, vld + 16 * MTOK * 2); }
            f32x4 a = (f32x4){0.f, 0.f, 0.f, 0.f};
            if (act) {
#pragma unroll
                for (int ks = 0; ks < 16; ++ks) { const bf16x8 kf = *(const LAS bf16x8*)(KV + (kt & 1) * BUFB + fr * KROW + (32 * ks + 8 * fq) * 2); a = MFMA32(qf[ks], kf, a); } }
            sacc[kt] = a;
            if (kt < 15) { *(LAS u32x4*)(KV + ((kt + 1) & 1) * BUFB + krow * KROW + kc * 16) = st0; *(LAS u32x4*)(KV + ((kt + 1) & 1) * BUFB + (krow + 8) * KROW + kc * 16) = st1; }
            else { *(LAS u32x4*)(KV + vrow * VROW + vc * 16) = st0; *(LAS u32x4*)(KV + (vrow + 16) * VROW + vc * 16) = st1; }
            __syncthreads();
            __builtin_amdgcn_sched_barrier(0);
        }
        bf16x8 pf[8];
        if (act) {
            const float sc = 0.04419417382415922f;
#pragma unroll
            for (int r = 0; r < 4; ++r) { float mx = -3.0e38f;
#pragma unroll
                for (int nt = 0; nt < 16; ++nt) mx = fmaxf(mx, sacc[nt][r]);
                mx = fmaxf(mx, __shfl_xor(mx, 1)); mx = fmaxf(mx, __shfl_xor(mx, 2)); mx = fmaxf(mx, __shfl_xor(mx, 4)); mx = fmaxf(mx, __shfl_xor(mx, 8));
                float sum = 0.f;
#pragma unroll
                for (int nt = 0; nt < 16; ++nt) { const float e = __expf((sacc[nt][r] - mx) * sc); sacc[nt][r] = e; sum += e; }
                sum += __shfl_xor(sum, 1); sum += __shfl_xor(sum, 2); sum += __shfl_xor(sum, 4); sum += __shfl_xor(sum, 8);
                const float inv = 1.0f / sum;
#pragma unroll
                for (int nt = 0; nt < 16; ++nt) Pl[(4 * fq + r) * 264 + 16 * nt + fr] = (bf16)f2bf(sacc[nt][r] * inv); }
            WAVE_LDS_SYNC();
#pragma unroll
            for (int ks = 0; ks < 8; ++ks) pf[ks] = *(const LAS bf16x8*)(Pl + fr * 264 + 32 * ks + 8 * fq);
            WAVE_LDS_SYNC();
        } else {
#pragma unroll
            for (int ks = 0; ks < 8; ++ks) pf[ks] = zero8h(); }
#pragma unroll
        for (int vt = 0; vt < 16; ++vt) {
            if (vt < 15) { st0 = LDG(u32x4, vld + (vt + 1) * (32 * MTOK * 2)); st1 = LDG(u32x4, vld + (vt + 1) * (32 * MTOK * 2) + 16 * MTOK * 2); }
            if (act) {
#pragma unroll
                for (int d2 = 0; d2 < 2; ++d2) { f32x4 a = (f32x4){0.f, 0.f, 0.f, 0.f};
#pragma unroll
                    for (int ks = 0; ks < 8; ++ks) { const bf16x8 vf = *(const LAS bf16x8*)(KV + (vt & 1) * BUFB + (16 * d2 + fr) * VROW + (32 * ks + 8 * fq) * 2); a = MFMA32(pf[ks], vf, a); }
#pragma unroll
                    for (int r = 0; r < 4; ++r) *(bf16*)(C.ws + oo + (unsigned)((r * DM + 32 * vt + 16 * d2) * 2)) = (bf16)f2bf(a[r]); } }
            if (vt < 15) { *(LAS u32x4*)(KV + ((vt + 1) & 1) * BUFB + vrow * VROW + vc * 16) = st0; *(LAS u32x4*)(KV + ((vt + 1) & 1) * BUFB + (vrow + 16) * VROW + vc * 16) = st1;
                __syncthreads(); }
            __builtin_amdgcn_sched_barrier(0);
        }
    }
#undef LDG
}
__device__ __forceinline__ void phase_ffnact(const Ctx& C, int l) {
    const size_t gt = (size_t)C.bid * 512 + C.tid, NT = (size_t)C.G * 512;
    const bf16* U = WSP(const bf16, WS_PROJ);
    const float* cw = C.in(29) + (size_t)l * 3 * DFF2; const float* cb = C.in(30) + (size_t)l * DFF2; const float* st = C.in(6) + (size_t)l * SBT * 2 * DFF2;
    for (size_t it = gt; it < (size_t)(T / 8) * (DFF / 8); it += NT) {
        const int seg = (int)(it / (DFF / 8)), c = (int)(it % (DFF / 8)) * 8, row0 = seg * 8; const SeqInfo s = seq_of_row(row0);
        u32x4 ru[10], rg[10];
#pragma unroll
        for (int i = 0; i < 8; ++i) { ru[2 + i] = *(const u32x4*)(U + (size_t)(row0 + i) * DFF2 + c); rg[2 + i] = *(const u32x4*)(U + (size_t)(row0 + i) * DFF2 + DFF + c); }
        float wu[3][8], wg[3][8], bu[8], bg[8];
#pragma unroll
        for (int i = 0; i < 3; ++i)
#pragma unroll
            for (int hlf = 0; hlf < 2; ++hlf) { const f32x4 a = *(const f32x4*)(cw + i * DFF2 + c + 4 * hlf), b = *(const f32x4*)(cw + i * DFF2 + DFF + c + 4 * hlf);
#pragma unroll
                for (int j = 0; j < 4; ++j) { wu[i][4 * hlf + j] = a[j]; wg[i][4 * hlf + j] = b[j]; } }
#pragma unroll
        for (int hlf = 0; hlf < 2; ++hlf) { const f32x4 a = *(const f32x4*)(cb + c + 4 * hlf), b = *(const f32x4*)(cb + DFF + c + 4 * hlf);
#pragma unroll
            for (int j = 0; j < 4; ++j) { bu[4 * hlf + j] = a[j]; bg[4 * hlf + j] = b[j]; } }
        float hu[2][8], hg[2][8];
        if (s.t >= 2) {
#pragma unroll
            for (int i = 0; i < 2; ++i) { ru[i] = *(const u32x4*)(U + (size_t)(row0 - 2 + i) * DFF2 + c); rg[i] = *(const u32x4*)(U + (size_t)(row0 - 2 + i) * DFF2 + DFF + c); unpack8(ru[i], hu[i]); unpack8(rg[i], hg[i]); } }
        else if (s.sample) {
#pragma unroll
            for (int i = 0; i < 2; ++i) { const float* sp = st + ((size_t)s.b * 2 + i) * DFF2 + c;
#pragma unroll
                for (int j = 0; j < 8; ++j) { hu[i][j] = sp[j]; hg[i][j] = sp[DFF + j]; } } }
        else {
#pragma unroll
            for (int i = 0; i < 2; ++i)
#pragma unroll
                for (int j = 0; j < 8; ++j) { hu[i][j] = 0.f; hg[i][j] = 0.f; } }
#pragma unroll
        for (int i = 0; i < 8; ++i) { float cu[8], cg[8], o[8]; unpack8(ru[2 + i], cu); unpack8(rg[2 + i], cg);
#pragma unroll
            for (int j = 0; j < 8; ++j) { const float au = bu[j] + hu[0][j] * wu[0][j] + hu[1][j] * wu[1][j] + cu[j] * wu[2][j], ag = bg[j] + hg[0][j] * wg[0][j] + hg[1][j] * wg[1][j] + cg[j] * wg[2][j];
                o[j] = siluf_(ag) * au; hu[0][j] = hu[1][j]; hu[1][j] = cu[j]; hg[0][j] = hg[1][j]; hg[1][j] = cg[j]; }
            *(u32x4*)(WSP(bf16, WS_YSR) + (size_t)(row0 + i) * DFF + c) = pack8(o); }
    }
    for (size_t it = gt; it < (size_t)NSEQ * 2 * DFF2; it += NT) {
        const int c = (int)(it % DFF2), j = (int)(it / DFF2) % 2, sq = (int)(it / (2 * DFF2)); const SeqInfo s = seq_of_idx(sq);
        float* dst = C.out + (s.sample ? O_SFFC + ((size_t)l * SBT + s.b) * 2 * DFF2 : O_PFFC + ((size_t)l * NB + s.b) * 2 * DFF2);
        dst[j * DFF2 + c] = bf2f(U[(size_t)(s.row0 + s.L - 2 + j) * DFF2 + c]);
    }
}

struct SEpiGate0 { const bf16* P; float* M0; static constexpr bool ROWSUM = false; __device__ __forceinline__ float operator()(int row, int col, float v) const { M0[(size_t)row * DM + col] = v * sigmoidf_(bf2f(P[(size_t)row * NPROJ + PGATE + col])); return 0.f; } };
struct SEpiGate1 { const bf16* P; const float* M0; bf16* O; static constexpr bool ROWSUM = false; __device__ __forceinline__ float operator()(int row, int col, float v) const { O[(size_t)row * DM + col] = (bf16)f2bf(M0[(size_t)row * DM + col] + v * sigmoidf_(bf2f(P[(size_t)row * NPROJ + PGATE + DM + col]))); return 0.f; } };
struct SEpiResid { float* X; bf16* H; float* SS; static constexpr bool ROWSUM = true; __device__ __forceinline__ float operator()(int row, int col, float v) const { const float x = X[(size_t)row * DM + col] + v; X[(size_t)row * DM + col] = x; H[(size_t)row * DM + col] = (bf16)f2bf(x); return x * x; } };
struct SEpiBf16 { bf16* O; const float* SS; static constexpr bool ROWSUM = false; __device__ __forceinline__ float operator()(int row, int col, float v) const { O[(size_t)row * DM + col] = (bf16)f2bf(v * row_rstd(SS, row)); return 0.f; } };
template <class SE>
__device__ __forceinline__ void sample_gemm(const Ctx& C, size_t a_off, size_t b_off, int K, const SE& E) {
    const int lane = C.lane, fr = lane & 15, fq = lane >> 4; const unsigned char* wsb = C.ws;
    const int slot = C.bid * 8 + C.wave, NSLOT = C.G * 8;
    for (int t = slot; t < 16 * (DM / 16); t += NSLOT) { const int rt = t / (DM / 16), ct = t % (DM / 16);
        unsigned ao = (unsigned)(a_off + ((size_t)(TP + 16 * rt + fr) * K + 8 * fq) * 2), bo = (unsigned)(b_off + ((size_t)(16 * ct + fr) * K + 8 * fq) * 2);
        f32x4 acc = (f32x4){0.f, 0.f, 0.f, 0.f};
        bf16x8 a0[8], b0[8], a1[8], b1[8];
#pragma unroll
        for (int j = 0; j < 8; ++j) { a0[j] = *(const bf16x8*)(wsb + ao + 64 * j); b0[j] = *(const bf16x8*)(wsb + bo + 64 * j); }
        for (int k0 = 0; k0 < K; k0 += 512) {
#pragma unroll
            for (int j = 0; j < 8; ++j) { a1[j] = *(const bf16x8*)(wsb + ao + 512 + 64 * j); b1[j] = *(const bf16x8*)(wsb + bo + 512 + 64 * j); }
            __builtin_amdgcn_sched_barrier(0);
#pragma unroll
            for (int j = 0; j < 8; ++j) acc = MFMA32(a0[j], b0[j], acc);
            __builtin_amdgcn_sched_barrier(0);
            const unsigned adv = (k0 + 512 < K) ? 1024u : 0u;
#pragma unroll
            for (int j = 0; j < 8; ++j) { a0[j] = *(const bf16x8*)(wsb + ao + adv + 64 * j); b0[j] = *(const bf16x8*)(wsb + bo + adv + 64 * j); }
            __builtin_amdgcn_sched_barrier(0);
#pragma unroll
            for (int j = 0; j < 8; ++j) acc = MFMA32(a1[j], b1[j], acc);
            __builtin_amdgcn_sched_barrier(0);
            ao += 1024; bo += 1024; }
#pragma unroll
        for (int r = 0; r < 4; ++r) { const int row = TP + 16 * rt + 4 * fq + r; float q = E(row, 16 * ct + fr, acc[r]);
            if constexpr (SE::ROWSUM) { q += __shfl_xor(q, 1); q += __shfl_xor(q, 2); q += __shfl_xor(q, 4); q += __shfl_xor(q, 8); if (fr == 0) atomicAdd(E.SS + row, q); } }
    }
}

#ifndef HOST_EMU
#define XB_TMO      128
#define XB_XCNT(j)  (256  + 64 * (j))
#define XB_XSUB(j)  (1280 + 64 * (j))
#define XB_XGEN(j)  (2304 + 64 * (j))
#define XB_TOP      3328
#define XB_TOPGEN   3392
#define XCD_BAR_WORDS 3456
#define XB_SPIN_CAP (1u << 18)
__device__ __forceinline__ unsigned xb_ld(unsigned* p)              { return __hip_atomic_load(p, __ATOMIC_RELAXED, __HIP_MEMORY_SCOPE_AGENT); }
__device__ __forceinline__ unsigned xb_add(unsigned* p, unsigned v) { return __hip_atomic_fetch_add(p, v, __ATOMIC_RELAXED, __HIP_MEMORY_SCOPE_AGENT); }
__device__ __forceinline__ unsigned xb_xcc_id() { return (unsigned)__builtin_amdgcn_s_getreg((3 << 11) | 20) & 0xFu; }
#define XB_SPIN(cond, bar) do { unsigned _sp = 0; while (cond) { __builtin_amdgcn_s_sleep(1); \
    if ((++_sp & 255u) == 0u) { if (xb_ld(&(bar)[XB_TMO])) break; if (_sp > XB_SPIN_CAP) { atomicAdd(&(bar)[XB_TMO], 1u); break; } } } } while (0)
struct XcdBarrier { unsigned* bar; unsigned x; volatile LAS unsigned* st; };
__device__ __forceinline__ XcdBarrier xcd_barrier_post(unsigned* bar, volatile LAS unsigned* st) {
    XcdBarrier b; b.bar = bar; b.x = xb_xcc_id(); b.st = st;
    if (threadIdx.x == 0) (void)xb_add(&bar[XB_XCNT(b.x)], 1u);
    return b;
}
__device__ __forceinline__ void xcd_barrier_complete(unsigned* bar, unsigned x, unsigned& nloc, unsigned& nx) {
    const unsigned G = gridDim.x * gridDim.y * gridDim.z;
    unsigned sum, cnt, mine, sp = 0u;
    for (;;) {
        sum = 0u; cnt = 0u; mine = 0u;
#pragma unroll
        for (unsigned j = 0; j < 16; ++j) { const unsigned c = xb_ld(&bar[XB_XCNT(j)]); sum += c; cnt += (c > 0u) ? 1u : 0u; mine = (j == x) ? c : mine; }
        if (sum == G) break;
        __builtin_amdgcn_s_sleep(1);
        if ((++sp & 255u) == 0u) { if (xb_ld(&bar[XB_TMO])) break; if (sp > XB_SPIN_CAP) { atomicAdd(&bar[XB_TMO], 1u); break; } }
    }
    nloc = mine > 0u ? mine : 1u; nx = cnt > 0u ? cnt : 1u;
}
__device__ __forceinline__ void xcd_barrier(const XcdBarrier& b) {
    asm volatile("s_waitcnt vmcnt(0)" ::: "memory");
    __syncthreads();
    if (threadIdx.x == 0) {
        unsigned* bar = b.bar;
        __builtin_amdgcn_s_waitcnt(0);
        unsigned nloc = b.st[0], nx = b.st[1];
        if (nloc == 0u) { xcd_barrier_complete(bar, b.x, nloc, nx); b.st[0] = nloc; b.st[1] = nx; }
        const unsigned old = xb_add(&bar[XB_XSUB(b.x)], 1u);
        const unsigned gen = old / nloc;
        if (old + 1u == (gen + 1u) * nloc) {
            __builtin_amdgcn_fence(__ATOMIC_RELEASE, "agent");
            asm volatile("s_waitcnt vmcnt(0)" ::: "memory");
            const unsigned og = xb_add(&bar[XB_TOP], 1u);
            const unsigned tg = og / nx;
            if (og + 1u == (tg + 1u) * nx) xb_add(&bar[XB_TOPGEN], 1u);
            else XB_SPIN(xb_ld(&bar[XB_TOPGEN]) == tg, bar);
            __builtin_amdgcn_fence(__ATOMIC_ACQUIRE, "agent");
            xb_add(&bar[XB_XGEN(b.x)], 1u);
            asm volatile("s_waitcnt vmcnt(0)" ::: "memory");
        } else {
            XB_SPIN(xb_ld(&bar[XB_XGEN(b.x)]) == gen, bar);
            __builtin_amdgcn_fence(__ATOMIC_ACQUIRE, "agent");
            asm volatile("s_waitcnt vmcnt(0)" ::: "memory");
        }
    }
    __syncthreads();
}
#endif

constexpr int PH_PRO = 0, PH_KV = 1, PH_L0 = 2, PH_PER_LAYER = 18, PH_FINAL = PH_L0 + 2 * PH_PER_LAYER, NPH = PH_FINAL + 1;
#ifdef HOST_EMU
__device__ __forceinline__ Ctx make_ctx(const Args& args, unsigned char* lds, int) {
    Ctx C; C.lds = lds; C.tid = threadIdx.x; C.lane = C.tid & 63; C.wave = C.tid >> 6; C.G = gridDim.x; C.bid = blockIdx.x; C.ap = &args; C.out = args.out; C.ws = args.ws; return C;
}
#else
__device__ __forceinline__ Ctx make_ctx(const Args& args, unsigned char* lds, int wave_s) {
    Ctx C; int wave = wave_s; asm volatile("" : "+s"(wave));
    int lane = __builtin_amdgcn_mbcnt_hi(~0u, __builtin_amdgcn_mbcnt_lo(~0u, 0u)); asm volatile("" : "+v"(lane));
    int bid = blockIdx.x, G = gridDim.x; asm volatile("" : "+s"(bid), "+s"(G));
    const CAS unsigned char* kp = (const CAS unsigned char*)__builtin_amdgcn_kernarg_segment_ptr(); asm volatile("" : "+s"(kp));
    int tid = wave * 64 + lane; asm volatile("" : "+v"(tid));
    C.lds = (LAS unsigned char*)lds; C.tid = tid; C.lane = tid & 63; C.wave = __builtin_amdgcn_readfirstlane(tid >> 6); C.G = G; C.bid = bid; C.kp = kp;
    C.out = *(float* const CAS*)(kp + 264); C.ws = *(unsigned char* const CAS*)(kp + 272);
    return C;
}
static_assert(sizeof(Args) == 288, "Args layout (kernarg offsets in make_ctx)");
#endif
__global__ void __launch_bounds__(512, 2) mk_fwd(Args args) {
    DYN_LDS(lds);
    const int lo = args.ph_lo, hi = args.ph_hi;
    const int wave_s = __builtin_amdgcn_readfirstlane((int)threadIdx.x >> 6);
#ifndef HOST_EMU
    volatile LAS unsigned* lctl = (volatile LAS unsigned*)((LAS unsigned char*)lds + LDS_CTL_OFF);
    if (threadIdx.x < 64) lctl[threadIdx.x] = 0u;
    __syncthreads();
    if (hi - lo > 1) (void)xcd_barrier_post((unsigned*)(args.ws + WS_CTL) + 4096, lctl + 8);
#define GRID_BAR() do { XcdBarrier bar_; { const CAS unsigned char* kp_ = (const CAS unsigned char*)__builtin_amdgcn_kernarg_segment_ptr(); asm volatile("" : "+s"(kp_)); \
        bar_.bar = (unsigned*)(*(unsigned char* const CAS*)(kp_ + 272) + WS_CTL) + 4096; } bar_.x = xb_xcc_id(); bar_.st = (volatile LAS unsigned*)((LAS unsigned char*)lds + LDS_CTL_OFF) + 8; xcd_barrier(bar_); } while (0)
#else
#define GRID_BAR() ((void)0)
#endif
#define IN(k) (lo <= (k) && (k) < hi)
#define SEAM(k) do { if (IN(k) && IN((k) + 1)) GRID_BAR(); } while (0)
#define CTX const Ctx C = make_ctx(args, lds, wave_s)
#define GEMM_PHASE(EPI, Aoff, Boff, M_, N_, K_, ...) do { CTX; pg8::Gemm g{WSP(const bf16, Aoff), WSP(const bf16, Boff), M_, N_, K_}; pg8::StaticOrder S; S.init(M_, N_, C.G, C.bid); \
        EPI E{__VA_ARGS__}; pg8::gemm_phase<EPI, true>(C.lds, C.tid, g, S, E); } while (0)
    if (IN(PH_PRO)) { { CTX; phase_prologue(C); } __syncthreads(); { CTX; phase_wconv(C, 0); } { CTX; phase_xprep(C); } } SEAM(PH_PRO);
    if (IN(PH_KV)) GEMM_PHASE(EpiMemKV, WS_MEMP, WS_WKV, NB * MTOK, 8192, DM, C.out, WSP(bf16, WS_KP), WSP(bf16, WS_VTP)); SEAM(PH_KV);
#ifndef PROBE_MASK
#define PROBE_MASK 0
#endif
#define LPH(off, ...) do { if (IN(pb + (off))) { __VA_ARGS__; if ((PROBE_MASK >> (off)) & 1) { GRID_BAR(); __VA_ARGS__; } } SEAM(pb + (off)); } while (0)
    for (int l = 0; l < 2; ++l) {
        const int pb = PH_L0 + PH_PER_LAYER * l;
        if (IN(pb + 0)) { if (l > 0) { CTX; phase_wconv(C, l); } if (PROBE_MASK & 1) { GRID_BAR(); CTX; phase_wconv(C, l); } } SEAM(pb + 0);
        LPH(2, GEMM_PHASE(EpiProj, WS_H, WS_WIN, T, NPROJ_PAD, DM, WSP(bf16, WS_PROJ), WSP(float, WS_SMALL), WSP(const float, WS_SS) + (size_t)(3 * l) * T));
        LPH(3, { CTX; phase_prep(C, l); });
        LPH(4, { CTX; phase_chunkprep(C, l); });
        LPH(5, { CTX; phase_scan(C, l); });
        LPH(6, { CTX; phase_ynorm(C, l); });
        LPH(7, { GEMM_PHASE(EpiGate0, WS_YS, WS_WB0, TP, DM, DM, WSP(const bf16, WS_PROJ), WSP(float, WS_YSR)); CTX; sample_gemm(C, WS_YS, WS_WB0, DM, SEpiGate0{WSP(const bf16, WS_PROJ), WSP(float, WS_YSR)}); });
        LPH(8, { GEMM_PHASE(EpiGate1, WS_YG, WS_WB1, TP, DM, DM, WSP(const bf16, WS_PROJ), WSP(const float, WS_YSR), WSP(bf16, WS_MRG)); CTX; sample_gemm(C, WS_YG, WS_WB1, DM, SEpiGate1{WSP(const bf16, WS_PROJ), WSP(const float, WS_YSR), WSP(bf16, WS_MRG)}); });
        LPH(9, { GEMM_PHASE(EpiResid, WS_MRG, WS_WOUT, TP, DM, DM, WSP(float, WS_X), WSP(bf16, WS_H), WSP(float, WS_SS) + (size_t)(3 * l + 1) * T); CTX; sample_gemm(C, WS_MRG, WS_WOUT, DM, SEpiResid{WSP(float, WS_X), WSP(bf16, WS_H), WSP(float, WS_SS) + (size_t)(3 * l + 1) * T}); });
        LPH(11, { GEMM_PHASE(EpiBf16, WS_H, WS_WMQ, TP, DM, DM, WSP(bf16, WS_YS), DM, WSP(const float, WS_SS) + (size_t)(3 * l + 1) * T); CTX; sample_gemm(C, WS_H, WS_WMQ, DM, SEpiBf16{WSP(bf16, WS_YS), WSP(const float, WS_SS) + (size_t)(3 * l + 1) * T}); });
        LPH(12, { CTX; phase_attn(C, l); });
        LPH(13, { GEMM_PHASE(EpiResid, WS_YG, WS_WMO, TP, DM, DM, WSP(float, WS_X), WSP(bf16, WS_H), WSP(float, WS_SS) + (size_t)(3 * l + 2) * T); CTX; sample_gemm(C, WS_YG, WS_WMO, DM, SEpiResid{WSP(float, WS_X), WSP(bf16, WS_H), WSP(float, WS_SS) + (size_t)(3 * l + 2) * T}); });
        LPH(15, GEMM_PHASE(EpiBf16, WS_H, WS_WFI, T, DFF2, DM, WSP(bf16, WS_PROJ), DFF2, WSP(const float, WS_SS) + (size_t)(3 * l + 2) * T));
        LPH(16, { CTX; phase_ffnact(C, l); });
        LPH(17, { GEMM_PHASE(EpiResid, WS_YSR, WS_WFO, TP, DM, DFF, WSP(float, WS_X), WSP(bf16, WS_H), WSP(float, WS_SS) + (size_t)(3 * l + 3) * T); CTX; sample_gemm(C, WS_YSR, WS_WFO, DFF, SEpiResid{WSP(float, WS_X), WSP(bf16, WS_H), WSP(float, WS_SS) + (size_t)(3 * l + 3) * T}); });
    }
    if (IN(PH_FINAL)) { CTX; phase_final(C); }
#undef IN
#undef SEAM
#undef GRID_BAR
}

extern "C" void kernel_launch(void* const* d_in, const int* in_sizes, int n_in, void* d_out, int out_size, void* d_ws, size_t ws_size, hipStream_t stream) {
    static int grid = 0;
    if (grid == 0) {
        if (n_in != 33 || (size_t)out_size != O_END || ws_size < WS_END) { fprintf(stderr, "kernel_launch: unexpected shapes (n_in %d out %d ws %zu; need out %zu ws %zu)\n", n_in, out_size, ws_size, (size_t)O_END, (size_t)WS_END); grid = -1; return; }
        int dev = 0, cus = 0;
        if (hipGetDevice(&dev) != hipSuccess || hipDeviceGetAttribute(&cus, hipDeviceAttributeMultiprocessorCount, dev) != hipSuccess) { grid = -1; return; }
        if (hipFuncSetAttribute((const void*)mk_fwd, hipFuncAttributeMaxDynamicSharedMemorySize, LDS_BYTES) != hipSuccess) { fprintf(stderr, "kernel_launch: hipFuncSetAttribute failed\n"); grid = -1; return; }
        (void)hipGetLastError();
        grid = cus;
    }
    if (grid < 0) return;
    (void)hipMemsetAsync((char*)d_ws + WS_CTL, 0, CTL_BYTES, stream);
    Args a{};
    for (int i = 0; i < 33; ++i) a.in[i] = (const float*)d_in[i];
    a.out = (float*)d_out; a.ws = (unsigned char*)d_ws;
#ifdef HOST_EMU
    const char* e0 = getenv("EMU_PH_LO"); const char* e1 = getenv("EMU_PH_HI");
    const int plo = e0 ? atoi(e0) : 0, phi = e1 ? atoi(e1) : NPH;
    for (int p = plo; p < phi; ++p) { a.ph_lo = p; a.ph_hi = p + 1; fprintf(stderr, "emu: phase %d\n", p); emu_launch(mk_fwd, (unsigned)grid, 512u, (size_t)LDS_BYTES, a); }
#else
#if MK_ONE_LAUNCH
    a.ph_lo = 0; a.ph_hi = NPH;
    hipLaunchKernelGGL(mk_fwd, dim3(grid), dim3(512), LDS_BYTES, stream, a);
#else
    for (int p = 0; p < NPH; ++p) { a.ph_lo = p; a.ph_hi = p + 1; hipLaunchKernelGGL(mk_fwd, dim3(grid), dim3(512), LDS_BYTES, stream, a); }
#endif
#endif
}
```

```cpp
#ifndef HOST_EMU
#include <hip/hip_runtime.h>
#endif
#include <cstdio>
#include <cstdint>

#ifndef CFG_BATCH
#define CFG_BATCH 4
#endif
#ifndef CFG_SEQ
#define CFG_SEQ 2048
#endif
#ifndef MK_ONE_LAUNCH
#define MK_ONE_LAUNCH 1
#endif

#ifdef HOST_EMU
#define LAS
#define VMCNT(n) ((void)emu_wave_op([](unsigned char*) {}, [](unsigned char (*)[64]) {}))
#define LGKMCNT(n) ((void)0)
#define MEMCLOB() ((void)0)
#define WAVE_LDS_SYNC() ((void)emu_wave_op([](unsigned char*) {}, [](unsigned char (*)[64]) {}))
#define DYN_LDS(name) unsigned char* name = emu_lds()
#define LAUNDER_V(x) ((void)0)
#else
#define LAS __attribute__((address_space(3)))
#define VMCNT(n) asm volatile("s_waitcnt vmcnt(" #n ")" ::: "memory")
#define LGKMCNT(n) asm volatile("s_waitcnt lgkmcnt(" #n ")" ::: "memory")
#define MEMCLOB() asm volatile("" ::: "memory")
#define WAVE_LDS_SYNC() asm volatile("s_waitcnt lgkmcnt(0)" ::: "memory")
#define DYN_LDS(name) extern __shared__ __attribute__((aligned(16))) unsigned char name[]
#define LAUNDER_V(x) asm volatile("" : "+v"(x))
#endif

typedef unsigned short bf16;
typedef short bf16x8 __attribute__((ext_vector_type(8)));
typedef float f32x4 __attribute__((ext_vector_type(4)));
typedef float f32x2 __attribute__((ext_vector_type(2)));
typedef unsigned u32x4 __attribute__((ext_vector_type(4)));
typedef unsigned u32x2 __attribute__((ext_vector_type(2)));

__device__ __forceinline__ unsigned f2bf(float f) { unsigned u = __builtin_bit_cast(unsigned, f); return (u + 0x7fffu + ((u >> 16) & 1u)) >> 16; }
__device__ __forceinline__ float bf2f(unsigned b) { return __builtin_bit_cast(float, b << 16); }
__device__ __forceinline__ float bf_lo(unsigned w) { return __builtin_bit_cast(float, w << 16); }
__device__ __forceinline__ float bf_hi(unsigned w) { return __builtin_bit_cast(float, w & 0xffff0000u); }
#ifdef HOST_EMU
__device__ __forceinline__ unsigned cvt_pk_bf16(float lo, float hi) { return f2bf(lo) | (f2bf(hi) << 16); }
#else
typedef __bf16 bf16x2_native __attribute__((ext_vector_type(2)));
__device__ __forceinline__ unsigned cvt_pk_bf16(float lo, float hi) { const f32x2 v = {lo, hi}; return __builtin_bit_cast(unsigned, __builtin_convertvector(v, bf16x2_native)); }
#endif
__device__ __forceinline__ void unpack8(const u32x4 w, float (&v)[8]) { v[0] = bf_lo(w.x); v[1] = bf_hi(w.x); v[2] = bf_lo(w.y); v[3] = bf_hi(w.y); v[4] = bf_lo(w.z); v[5] = bf_hi(w.z); v[6] = bf_lo(w.w); v[7] = bf_hi(w.w); }
__device__ __forceinline__ u32x4 pack8(const float (&v)[8]) { u32x4 w; w.x = cvt_pk_bf16(v[0], v[1]); w.y = cvt_pk_bf16(v[2], v[3]); w.z = cvt_pk_bf16(v[4], v[5]); w.w = cvt_pk_bf16(v[6], v[7]); return w; }
__device__ __forceinline__ u32x4 zero16() { unsigned z = 0u; LAUNDER_V(z); return (u32x4){z, z, z, z}; }
__device__ __forceinline__ bf16x8 zero8h() { return __builtin_bit_cast(bf16x8, zero16()); }
__device__ __forceinline__ float sigmoidf_(float x) { return 1.0f / (1.0f + __expf(-x)); }
__device__ __forceinline__ float siluf_(float x) { return x / (1.0f + __expf(-x)); }
__device__ __forceinline__ float softplusf_(float x) { return x > 20.f ? x : __logf(1.0f + __expf(x)); }
__device__ __forceinline__ float logsigmoidf_(float x) { return fminf(x, 0.f) - __logf(1.0f + __expf(-fabsf(x))); }
__device__ __forceinline__ float wave_sum(float v) {
#pragma unroll
    for (int o = 1; o < 64; o <<= 1) v += __shfl_xor(v, o);
    return v;
}

constexpr int DM = 2048, NB = CFG_BATCH, SEQ = CFG_SEQ, TP = NB * SEQ, SBT = 16, SSQ = 16, TS = SBT * SSQ, T = TP + TS, NSEQ = NB + SBT;
constexpr int MTOK = 256, DFF = 5632, DFF2 = 11264, IN_DIM = 15408, NPROJ = 15360, NPROJ_PAD = 15616, XBCW = 3072;
constexpr int PZ = 0, PXBC = 2048, PQ = 5120, PK = 6144, PV = 7168, PG = 9216, PGATE = 11264;
constexpr float EPSF = 1e-6f;
static_assert(TP % 256 == 0 && SEQ % 16 == 0, "token tiling");
constexpr size_t O_Y = 0, O_PSSD = (size_t)T * DM, O_PSSDC = O_PSSD + (size_t)2 * NB * 32 * 64 * 128, O_PGLA = O_PSSDC + (size_t)2 * NB * 3 * XBCW, O_PFFC = O_PGLA + (size_t)2 * NB * 4 * 256 * 512,
                 O_PMK = O_PFFC + (size_t)2 * NB * 2 * DFF2, O_PMV = O_PMK + (size_t)2 * NB * MTOK * DM, O_SSSD = O_PMV + (size_t)2 * NB * MTOK * DM, O_SSSDC = O_SSSD + (size_t)2 * SBT * 32 * 64 * 128,
                 O_SGLA = O_SSSDC + (size_t)2 * SBT * 3 * XBCW, O_SFFC = O_SGLA + (size_t)2 * SBT * 4 * 256 * 512, O_END = O_SFFC + (size_t)2 * SBT * 2 * DFF2;
constexpr size_t A256(size_t x) { return (x + 255) & ~(size_t)255; }
constexpr size_t WS_CTL = 0, CTL_BYTES = 1u << 20;
constexpr size_t WS_WIN = WS_CTL + CTL_BYTES;
constexpr size_t WS_WB0 = WS_WIN + (size_t)NPROJ_PAD * DM * 2;
constexpr size_t WS_WB1 = WS_WB0 + (size_t)DM * DM * 2, WS_WOUT = WS_WB1 + (size_t)DM * DM * 2, WS_WMQ = WS_WOUT + (size_t)DM * DM * 2, WS_WMO = WS_WMQ + (size_t)DM * DM * 2;
constexpr size_t WS_WFI = WS_WMO + (size_t)DM * DM * 2;
constexpr size_t WS_WFO = WS_WFI + (size_t)DFF2 * DM * 2;
constexpr size_t WS_WKV = WS_WFO + (size_t)DM * DFF * 2;
constexpr size_t WS_X = WS_WKV + (size_t)8192 * DM * 2;
constexpr size_t WS_H = WS_X + (size_t)T * DM * 4;
constexpr size_t WS_PROJ = WS_H + (size_t)T * DM * 2;
constexpr size_t WS_SMALL = WS_PROJ + (size_t)T * NPROJ * 2;
constexpr size_t WS_XBC = WS_SMALL + (size_t)T * 256 * 4;
constexpr size_t WS_DT = WS_XBC + (size_t)T * XBCW * 2;
constexpr size_t WS_LOGA = WS_DT + (size_t)T * 32 * 4;
constexpr size_t WS_YSR = WS_LOGA + (size_t)T * 1024 * 4;
constexpr size_t WS_YGR = WS_YSR + (size_t)T * DM * 4;
constexpr size_t WS_YS = WS_YGR + (size_t)T * DM * 4;
constexpr size_t WS_YG = WS_YS + (size_t)T * DM * 2;
constexpr size_t WS_MRG = WS_YG + (size_t)T * DM * 2;
constexpr size_t WS_KP = WS_MRG + (size_t)T * DM * 2;
constexpr size_t WS_VTP = WS_KP + (size_t)2 * NB * MTOK * DM * 2;
constexpr size_t WS_KS = WS_VTP + (size_t)2 * NB * MTOK * DM * 2;
constexpr size_t WS_VTS = WS_KS + (size_t)2 * SBT * MTOK * DM * 2;
constexpr size_t WS_MEMP = WS_VTS + (size_t)2 * SBT * MTOK * DM * 2;
constexpr int NCK = T / 16, NCP = TP / 64, NCS = NCP + SBT;
static_assert(SEQ % 64 == 0, "SSD chunks must not straddle sequences");
constexpr size_t WS_WCH = WS_MEMP + (size_t)NB * MTOK * DM * 2;
constexpr size_t WS_XT = WS_WCH + (size_t)NCS * 32 * 64 * 64 * 2;
constexpr size_t WS_END0 = WS_XT + (size_t)NCS * DM * 64 * 2;
constexpr size_t WS_VT16 = WS_H;
constexpr size_t WS_QD = WS_MRG, WS_KET = WS_MRG + (size_t)T * 1024 * 2;
constexpr size_t WS_DEC = WS_WKV, WS_ATT = WS_DEC + (size_t)NCK * 1024 * 4, WS_EA = WS_ATT + (size_t)NCK * 4 * 256 * 2, WS_DECS = WS_EA + (size_t)NCS * 32 * 64 * 4;
constexpr size_t SZ_XTE = (size_t)NCS * DM * 64 * 2, SZ_BT = (size_t)NCS * 512 * 64 * 2, SZ_CC = (size_t)NCS * 64 * 512 * 2;
constexpr bool OVL_Y = SZ_XTE + SZ_BT + SZ_CC <= (size_t)2 * T * DM * 2;
constexpr size_t WS_XTE = OVL_Y ? WS_YS : WS_END0, WS_BT = WS_XTE + SZ_XTE, WS_CC = WS_BT + SZ_BT;
constexpr size_t WS_END = OVL_Y ? WS_END0 : WS_CC + SZ_CC;
static_assert(WS_DECS + (size_t)NCS * 32 * 4 <= WS_WKV + (size_t)8192 * DM * 2, "scan operand overlays");
static_assert((size_t)T * DFF * 2 <= (size_t)2 * T * DM * 4, "ACT overlay");
static_assert(WS_END <= (size_t)1081389824, "workspace budget");
constexpr size_t WS_SS = WS_CTL + 65536;
static_assert(65536 + (size_t)7 * T * 4 <= CTL_BYTES, "SS slots inside the zeroed control region");
constexpr int LDS_BYTES = 147456;
constexpr int LDS_CTL_OFF = 131072;

namespace pg8 {
constexpr int BM = 256, BK = 64, HALF = 128, HTB = HALF * BK * 2, STAGE_BYTES = 8 * HTB, NXCD = 8, WGM = 8;
__host__ __device__ __forceinline__ int lds_byte(int r, int c) { const int st = (r >> 4) * 2 + (c >> 5), rr = r & 15, cc = c & 31, ob = rr * 64 + cc * 2; return st * 1024 + (ob ^ (((ob >> 9) & 1) << 5)); }
__host__ __device__ __forceinline__ void stage_rc(int b, int& R, int& C) { const int st = b / 1024, sb = b % 1024, swz = sb ^ (((sb >> 9) & 1) << 5); R = (st >> 1) * 16 + swz / 64; C = (st & 1) * 32 + (swz % 64) / 2; }
__host__ __device__ __forceinline__ int perm32(int rho) { const int n = rho >> 4, i = rho & 15; return 8 * (i >> 2) + 4 * n + (i & 3); }
struct Unit { int pm, pn; };
struct Gemm { const bf16* A; const bf16* Bt; int M, N, K; };
struct StaticOrder {
    int nM, nN, nwg, G, c;
    __host__ __device__ void init(int M, int N, int G_, int c_) { nM = M / BM; nN = N / BM; nwg = nM * nN; G = G_; c = c_; }
    __host__ __device__ bool next(int i, Unit& u) const {
        const long L = (long)i * G + c; if (L >= nwg) return false;
        int wgid = (int)L; { const int q = nwg / NXCD, r = nwg % NXCD, xcd = wgid % NXCD, off = wgid / NXCD; wgid = (xcd < r ? xcd * (q + 1) : r * (q + 1) + (xcd - r) * q) + off; }
        const int nig = WGM * nN, gid = wgid / nig, fm = gid * WGM, gsz = (nM - fm) < WGM ? (nM - fm) : WGM;
        u.pm = fm + ((wgid % nig) % gsz); u.pn = (wgid % nig) / gsz; return true;
    }
};
template <class Epi, bool ALIGN_EPI>
__device__ __forceinline__ void gemm_phase(LAS unsigned char* lds, const int tid, const Gemm g, const StaticOrder& S, const Epi& E) {
    const int wid = __builtin_amdgcn_readfirstlane(tid >> 6), lane = tid & 63, wr = wid >> 2, wc = wid & 3, fr = lane & 15, fq = lane >> 4;
    const int K = g.K, nt = K / BK;
    unsigned voffA[2], voffB[2];
#pragma unroll
    for (int i = 0; i < 2; ++i) { int R, C; stage_rc(tid * 16 + i * 8192, R, C); const int Rb = Epi::PERM ? ((R & ~31) + perm32(R & 31)) : R;
        voffA[i] = (unsigned)(R * K + C) * 2u; voffB[i] = (unsigned)(Rb * K + C) * 2u; }
    const size_t kstep = (size_t)(BK * 2), hstep = (size_t)HALF * K * 2, tstep = 2 * hstep;
    const unsigned ldsw = (unsigned)wid * 1024u;
    const int aoff = lds_byte(wr * 64 + fr, fq * 8), boff = lds_byte(wc * 32 + fr, fq * 8);
#define PG8_SA(b, h) (((b) * 2 + (h)) * HTB)
#define PG8_SB(b, h) ((4 + (b) * 2 + (h)) * HTB)
#define PG8_STAGE(bufoff, gbase, voff) do { _Pragma("unroll") for (int _i = 0; _i < 2; ++_i) \
        __builtin_amdgcn_global_load_lds((const unsigned*)((const char*)(gbase) + (voff)[_i]), (LAS unsigned*)(lds + (bufoff) + ldsw + _i * 8192), 16, 0, 0); } while (0)
#define PG8_LDA(dst, b, h) do { _Pragma("unroll") for (int m = 0; m < 4; ++m) _Pragma("unroll") for (int k = 0; k < 2; ++k) dst[m][k] = *(const LAS bf16x8*)(lds + PG8_SA(b, h) + aoff + m * 2048 + k * 1024); } while (0)
#define PG8_LDB(dst, b, h) do { _Pragma("unroll") for (int n = 0; n < 2; ++n) _Pragma("unroll") for (int k = 0; k < 2; ++k) dst[n][k] = *(const LAS bf16x8*)(lds + PG8_SB(b, h) + boff + n * 2048 + k * 1024); } while (0)
#define PG8_MMA(ai, bj, At, Bt) do { __builtin_amdgcn_s_setprio(1); _Pragma("unroll") for (int m = 0; m < 4; ++m) _Pragma("unroll") for (int n = 0; n < 2; ++n) _Pragma("unroll") for (int k = 0; k < 2; ++k) \
        acc[ai][bj][m][n] = __builtin_amdgcn_mfma_f32_16x16x32_bf16(Bt[n][k], At[m][k], acc[ai][bj][m][n], 0, 0, 0); __builtin_amdgcn_s_setprio(0); } while (0)
#define PG8_BAR __builtin_amdgcn_s_barrier()
#define PG8_SCHED __builtin_amdgcn_sched_barrier(0)
    Unit cur, nxt; int ui = 0;
    if (!S.next(0, cur)) return;
    float zf = 0.f; LAUNDER_V(zf);
    f32x4 acc[2][2][4][2];
#pragma unroll
    for (int a = 0; a < 2; ++a)
#pragma unroll
        for (int b = 0; b < 2; ++b)
#pragma unroll
            for (int m = 0; m < 4; ++m)
#pragma unroll
                for (int n = 0; n < 2; ++n) acc[a][b][m][n] = (f32x4){zf, zf, zf, zf};
    bf16x8 At[4][2], B0[2][2], B1[2][2];
    const char* cA = (const char*)g.A + (size_t)cur.pm * tstep; const char* cB = (const char*)g.Bt + (size_t)cur.pn * tstep;
    PG8_STAGE(PG8_SB(0, 0), cB, voffB); PG8_STAGE(PG8_SB(0, 1), cB + hstep, voffB); PG8_STAGE(PG8_SA(0, 0), cA, voffA); PG8_STAGE(PG8_SA(0, 1), cA + hstep, voffA);
    if (wr == 1) PG8_BAR;
    VMCNT(2); PG8_BAR;
    PG8_STAGE(PG8_SB(1, 0), cB + kstep, voffB); PG8_STAGE(PG8_SA(1, 0), cA + kstep, voffA); PG8_STAGE(PG8_SB(1, 1), cB + hstep + kstep, voffB);
    VMCNT(6); PG8_BAR;
    for (;;) {
        const bool has_next = S.next(ui + 1, nxt);
        const char* nA = has_next ? (const char*)g.A + (size_t)nxt.pm * tstep : cA; const char* nB = has_next ? (const char*)g.Bt + (size_t)nxt.pn * tstep : cB;
        for (int t = 0; t < nt; t += 2) {
            const bool last = (t == nt - 2);
            const char* a1 = cA + (size_t)(t + 1) * kstep;
            const char* a2 = last ? nA : cA + (size_t)(t + 2) * kstep; const char* b2 = last ? nB : cB + (size_t)(t + 2) * kstep;
            const char* a3 = a2 + kstep; const char* b3 = b2 + kstep;
            PG8_LDB(B0, 0, 0); PG8_LDB(B1, 0, 1); PG8_SCHED; PG8_LDA(At, 0, 0); PG8_STAGE(PG8_SA(1, 1), a1 + hstep, voffA);
            VMCNT(8); LGKMCNT(0); PG8_BAR; PG8_MMA(0, 0, At, B0); PG8_MMA(0, 1, At, B1); PG8_BAR; PG8_SCHED;
            PG8_LDA(At, 0, 1); PG8_STAGE(PG8_SB(0, 0), b2, voffB); PG8_STAGE(PG8_SB(0, 1), b2 + hstep, voffB); PG8_STAGE(PG8_SA(0, 0), a2, voffA);
            VMCNT(8); LGKMCNT(0); PG8_BAR; PG8_MMA(1, 0, At, B0); PG8_MMA(1, 1, At, B1); PG8_BAR; PG8_SCHED;
            PG8_LDB(B0, 1, 0); PG8_LDB(B1, 1, 1); PG8_SCHED; PG8_LDA(At, 1, 0); PG8_STAGE(PG8_SA(0, 1), a2 + hstep, voffA);
            VMCNT(8); LGKMCNT(0); PG8_BAR; PG8_MMA(0, 0, At, B0); PG8_MMA(0, 1, At, B1); PG8_BAR; PG8_SCHED;
            PG8_LDA(At, 1, 1); PG8_STAGE(PG8_SB(1, 0), b3, voffB); PG8_STAGE(PG8_SB(1, 1), b3 + hstep, voffB); PG8_STAGE(PG8_SA(1, 0), a3, voffA);
            VMCNT(8); LGKMCNT(0); PG8_BAR; PG8_MMA(1, 0, At, B0); PG8_MMA(1, 1, At, B1); PG8_BAR; PG8_SCHED;
        }
        if constexpr (ALIGN_EPI) { if (wr == 0) PG8_BAR; }
        E(acc, cur, wr, wc, fr, fq);
        if (!has_next) break;
#pragma unroll
        for (int a = 0; a < 2; ++a)
#pragma unroll
            for (int b = 0; b < 2; ++b)
#pragma unroll
                for (int m = 0; m < 4; ++m)
#pragma unroll
                    for (int n = 0; n < 2; ++n) acc[a][b][m][n] = (f32x4){zf, zf, zf, zf};
        cur = nxt; cA = nA; cB = nB; ++ui;
        if constexpr (ALIGN_EPI) { if (wr == 1) PG8_BAR; }
    }
    VMCNT(0);
    if constexpr (!ALIGN_EPI) { if (wr == 0) PG8_BAR; }
    PG8_BAR;
#undef PG8_SA
#undef PG8_SB
#undef PG8_STAGE
#undef PG8_LDA
#undef PG8_LDB
#undef PG8_MMA
#undef PG8_BAR
#undef PG8_SCHED
}
}
using pg8::Unit;

#define EPI_LOOP_ROWS for (int ai = 0; ai < 2; ++ai) _Pragma("unroll") for (int m = 0; m < 4; ++m)
__device__ __forceinline__ float row_rstd(const float* SS, int row) { return 1.0f / sqrtf(SS[row] * (1.0f / DM) + EPSF); }
struct EpiBf16 {
    static constexpr bool PERM = true;
    bf16* O; int ldc; const float* SS;
    __device__ __forceinline__ void operator()(const f32x4 (&acc)[2][2][4][2], const Unit& u, int wr, int wc, int fr, int fq) const {
        const int row0 = u.pm * 256 + wr * 64 + fr, col0 = u.pn * 256 + wc * 32 + 8 * fq;
#pragma unroll
        EPI_LOOP_ROWS { const int row = row0 + ai * 128 + m * 16; const float rs = row_rstd(SS, row); bf16* rowp = O + (size_t)row * ldc + col0;
#pragma unroll
            for (int bj = 0; bj < 2; ++bj) { const f32x4 v0 = acc[ai][bj][m][0] * rs, v1 = acc[ai][bj][m][1] * rs;
                u32x4 w; w.x = cvt_pk_bf16(v0[0], v0[1]); w.y = cvt_pk_bf16(v0[2], v0[3]); w.z = cvt_pk_bf16(v1[0], v1[1]); w.w = cvt_pk_bf16(v1[2], v1[3]);
                *(u32x4*)(rowp + bj * 128) = w; } }
    }
};
struct EpiProj {
    static constexpr bool PERM = true;
    bf16* P; float* Sm; const float* SS;
    __device__ __forceinline__ void operator()(const f32x4 (&acc)[2][2][4][2], const Unit& u, int wr, int wc, int fr, int fq) const {
        const int row0 = u.pm * 256 + wr * 64 + fr;
        if (u.pn < NPROJ / 256) {
            const int col0 = u.pn * 256 + wc * 32 + 8 * fq;
#pragma unroll
            EPI_LOOP_ROWS { const int row = row0 + ai * 128 + m * 16; const float rs = row_rstd(SS, row); bf16* rowp = P + (size_t)row * NPROJ + col0;
#pragma unroll
                for (int bj = 0; bj < 2; ++bj) { const f32x4 v0 = acc[ai][bj][m][0] * rs, v1 = acc[ai][bj][m][1] * rs;
                    u32x4 w; w.x = cvt_pk_bf16(v0[0], v0[1]); w.y = cvt_pk_bf16(v0[2], v0[3]); w.z = cvt_pk_bf16(v1[0], v1[1]); w.w = cvt_pk_bf16(v1[2], v1[3]);
                    *(u32x4*)(rowp + bj * 128) = w; } }
        } else {
            const int col0 = wc * 32 + 8 * fq;
#pragma unroll
            EPI_LOOP_ROWS { const int row = row0 + ai * 128 + m * 16; const float rs = row_rstd(SS, row); float* rowp = Sm + (size_t)row * 256 + col0;
#pragma unroll
                for (int bj = 0; bj < 2; ++bj) { *(f32x4*)(rowp + bj * 128) = acc[ai][bj][m][0] * rs; *(f32x4*)(rowp + bj * 128 + 4) = acc[ai][bj][m][1] * rs; } }
        }
    }
};
struct EpiGate0 {
    static constexpr bool PERM = false;
    const bf16* P; float* M0;
    __device__ __forceinline__ void operator()(const f32x4 (&acc)[2][2][4][2], const Unit& u, int wr, int wc, int fr, int fq) const {
        const int row0 = u.pm * 256 + wr * 64 + fr, col0 = u.pn * 256 + wc * 32 + 4 * fq;
#pragma unroll
        EPI_LOOP_ROWS { const size_t r = (size_t)(row0 + ai * 128 + m * 16);
#pragma unroll
            for (int bj = 0; bj < 2; ++bj)
#pragma unroll
                for (int n = 0; n < 2; ++n) { const int c = col0 + bj * 128 + n * 16; const u32x2 gw = *(const u32x2*)(P + r * NPROJ + PGATE + c); const f32x4 a = acc[ai][bj][m][n];
                    f32x4 o; o[0] = a[0] * sigmoidf_(bf_lo(gw.x)); o[1] = a[1] * sigmoidf_(bf_hi(gw.x)); o[2] = a[2] * sigmoidf_(bf_lo(gw.y)); o[3] = a[3] * sigmoidf_(bf_hi(gw.y));
                    *(f32x4*)(M0 + r * DM + c) = o; } }
    }
};
struct EpiGate1 {
    static constexpr bool PERM = true;
    const bf16* P; const float* M0; bf16* O;
    __device__ __forceinline__ void operator()(const f32x4 (&acc)[2][2][4][2], const Unit& u, int wr, int wc, int fr, int fq) const {
        const int row0 = u.pm * 256 + wr * 64 + fr, col0 = u.pn * 256 + wc * 32 + 8 * fq;
#pragma unroll
        EPI_LOOP_ROWS { const size_t r = (size_t)(row0 + ai * 128 + m * 16);
#pragma unroll
            for (int bj = 0; bj < 2; ++bj) { const int c = col0 + bj * 128; const u32x4 gw = *(const u32x4*)(P + r * NPROJ + PGATE + DM + c); float gv[8]; unpack8(gw, gv);
                const f32x4 m0 = *(const f32x4*)(M0 + r * DM + c), m1 = *(const f32x4*)(M0 + r * DM + c + 4); const f32x4 a0 = acc[ai][bj][m][0], a1 = acc[ai][bj][m][1];
                float o[8];
#pragma unroll
                for (int j = 0; j < 4; ++j) { o[j] = m0[j] + a0[j] * sigmoidf_(gv[j]); o[4 + j] = m1[j] + a1[j] * sigmoidf_(gv[4 + j]); }
                *(u32x4*)(O + r * DM + c) = pack8(o); } }
    }
};
struct EpiResid {
    static constexpr bool PERM = false;
    float* X; bf16* H; float* SS;
    __device__ __forceinline__ void operator()(const f32x4 (&acc)[2][2][4][2], const Unit& u, int wr, int wc, int fr, int fq) const {
        const int row0 = u.pm * 256 + wr * 64 + fr, col0 = u.pn * 256 + wc * 32 + 4 * fq;
#pragma unroll
        EPI_LOOP_ROWS { const int row = row0 + ai * 128 + m * 16; float* rowp = X + (size_t)row * DM + col0; bf16* hp = H + (size_t)row * DM + col0; float ss = 0.f;
#pragma unroll
            for (int bj = 0; bj < 2; ++bj)
#pragma unroll
                for (int n = 0; n < 2; ++n) { f32x4* p = (f32x4*)(rowp + bj * 128 + n * 16); const f32x4 x = *p + acc[ai][bj][m][n]; *p = x;
                    ss += (x[0] * x[0] + x[1] * x[1]) + (x[2] * x[2] + x[3] * x[3]);
                    u32x2 w; w.x = cvt_pk_bf16(x[0], x[1]); w.y = cvt_pk_bf16(x[2], x[3]); *(u32x2*)(hp + bj * 128 + n * 16) = w; }
            ss += __shfl_xor(ss, 16); ss += __shfl_xor(ss, 32);
            if (fq == 0) atomicAdd(SS + row, ss); }
    }
};
struct EpiMemKV {
    static constexpr bool PERM = false;
    float* out; bf16* KP; bf16* VTP;
    __device__ __forceinline__ void operator()(const f32x4 (&acc)[2][2][4][2], const Unit& u, int wr, int wc, int fr, int fq) const {
        const int row0 = u.pm * 256 + wr * 64 + fr, colt = u.pn * 256, l = colt / 4096, kv = (colt / 2048) & 1, cbase = (colt & 2047) + wc * 32 + 4 * fq;
        float* dst = out + (kv ? O_PMV : O_PMK) + (size_t)l * NB * MTOK * DM;
#pragma unroll
        EPI_LOOP_ROWS { const int r = row0 + ai * 128 + m * 16, b = r >> 8, mt = r & 255;
#pragma unroll
            for (int bj = 0; bj < 2; ++bj)
#pragma unroll
                for (int n = 0; n < 2; ++n) { const int c = cbase + bj * 128 + n * 16; const f32x4 a = acc[ai][bj][m][n];
                    *(f32x4*)(dst + (size_t)r * DM + c) = a;
                    if (!kv) { u32x2 w; w.x = cvt_pk_bf16(a[0], a[1]); w.y = cvt_pk_bf16(a[2], a[3]); *(u32x2*)(KP + ((size_t)l * NB * MTOK + r) * DM + c) = w; }
                    else { bf16* vt = VTP + (((size_t)l * NB + b) * DM + c) * MTOK + mt;
#pragma unroll
                        for (int j = 0; j < 4; ++j) vt[(size_t)j * MTOK] = (bf16)f2bf(a[j]); } } }
    }
};

struct Args { const float* in[33]; float* out; unsigned char* ws; int ph_lo, ph_hi; };
#ifdef HOST_EMU
struct Ctx {
    LAS unsigned char* lds; int tid, lane, wave, G, bid;
    const Args* ap; float* out; unsigned char* ws;
    __device__ __forceinline__ const float* in(int i) const { return ap->in[i]; }
};
#else
#define CAS __attribute__((address_space(4)))
struct Ctx {
    LAS unsigned char* lds; int tid, lane, wave, G, bid;
    const CAS unsigned char* kp; float* out; unsigned char* ws;
    __device__ __forceinline__ const float* in(int i) const { return ((const float* const CAS*)kp)[i]; }
};
#endif
#define WSP(type, off) ((type*)(C.ws + (off)))

template <class RowMap>
__device__ __forceinline__ void transpose_item(const float* W, int K, int N, bf16* WT, const float* gain, LAS float* scr, int item, int lane, RowMap rowmap) {
    const int nblk = (N + 31) / 32, kb = item / nblk, nb = item % nblk, k0 = 64 * kb, n0 = 32 * nb;
    float vv[32]; const int nn = n0 + (lane & 31); const bool nok = nn < N; const float* wp = W + (size_t)(k0 + (lane >> 5)) * N + (nok ? nn : 0);
#pragma unroll
    for (int i = 0; i < 32; ++i) vv[i] = nok ? wp[(size_t)(2 * i) * N] : 0.f;
    if (gain) {
#pragma unroll
        for (int i = 0; i < 32; ++i) vv[i] *= gain[k0 + 2 * i + (lane >> 5)]; }
#pragma unroll
    for (int i = 0; i < 32; ++i) scr[(2 * i + (lane >> 5)) * 33 + (lane & 31)] = vv[i];
    WAVE_LDS_SYNC();
    const int c = lane & 7;
#pragma unroll
    for (int j = 0; j < 4; ++j) { const int n = (lane >> 3) + 8 * j; const LAS float* s = scr + (8 * c) * 33 + n;
        if (n0 + n < N) { u32x4 o; o.x = cvt_pk_bf16(s[0 * 33], s[1 * 33]); o.y = cvt_pk_bf16(s[2 * 33], s[3 * 33]); o.z = cvt_pk_bf16(s[4 * 33], s[5 * 33]); o.w = cvt_pk_bf16(s[6 * 33], s[7 * 33]);
            *(u32x4*)(WT + (size_t)rowmap(n0 + n) * K + k0 + 8 * c) = o; } }
    WAVE_LDS_SYNC();
}
struct RowId { int off; __device__ __forceinline__ int operator()(int n) const { return off + n; } };
struct RowWin { __device__ __forceinline__ int operator()(int n) const {
    return n < 5120 ? n : n < 5152 ? NPROJ + (n - 5120) : n < 11296 ? n - 32 : n < 11312 ? NPROJ + 32 + (n - 11296) : n - 48; } };

__device__ __forceinline__ void phase_wconv(const Ctx& C, int l) {
    LAS float* scr = (LAS float*)(C.lds + C.wave * 16384);
    const int gw = C.bid * 8 + C.wave, NGW = C.G * 8;
    const int I_IN = (DM / 64) * ((IN_DIM + 31) / 32), I_SQ = (DM / 64) * (DM / 32), I_FI = (DM / 64) * (DFF2 / 32), I_FO = (DFF / 64) * (DM / 32);
    const int NIT = I_IN + 5 * I_SQ + I_FI + I_FO;
    for (int it = gw; it < NIT; it += NGW) {
        int r = it;
        if (r < I_IN) { transpose_item(C.in(10) + (size_t)l * DM * IN_DIM, DM, IN_DIM, WSP(bf16, WS_WIN), C.in(9) + l * DM, scr, r, C.lane, RowWin{}); continue; } r -= I_IN;
        if (r < I_SQ) { transpose_item(C.in(20) + (size_t)(l * 2 + 0) * DM * DM, DM, DM, WSP(bf16, WS_WB0), (const float*)nullptr, scr, r, C.lane, RowId{0}); continue; } r -= I_SQ;
        if (r < I_SQ) { transpose_item(C.in(20) + (size_t)(l * 2 + 1) * DM * DM, DM, DM, WSP(bf16, WS_WB1), (const float*)nullptr, scr, r, C.lane, RowId{0}); continue; } r -= I_SQ;
        if (r < I_SQ) { transpose_item(C.in(21) + (size_t)l * DM * DM, DM, DM, WSP(bf16, WS_WOUT), (const float*)nullptr, scr, r, C.lane, RowId{0}); continue; } r -= I_SQ;
        if (r < I_SQ) { transpose_item(C.in(23) + (size_t)l * DM * DM, DM, DM, WSP(bf16, WS_WMQ), C.in(22) + l * DM, scr, r, C.lane, RowId{0}); continue; } r -= I_SQ;
        if (r < I_SQ) { transpose_item(C.in(26) + (size_t)l * DM * DM, DM, DM, WSP(bf16, WS_WMO), (const float*)nullptr, scr, r, C.lane, RowId{0}); continue; } r -= I_SQ;
        if (r < I_FI) { transpose_item(C.in(28) + (size_t)l * DM * DFF2, DM, DFF2, WSP(bf16, WS_WFI), C.in(27) + l * DM, scr, r, C.lane, RowId{0}); continue; } r -= I_FI;
        transpose_item(C.in(31) + (size_t)l * DFF * DM, DFF, DM, WSP(bf16, WS_WFO), (const float*)nullptr, scr, r, C.lane, RowId{0});
    }
    { u32x4* z = (u32x4*)(WSP(bf16, WS_WIN) + (size_t)(NPROJ + 48) * DM); const size_t n16 = (size_t)(NPROJ_PAD - NPROJ - 48) * DM * 2 / 16;
      for (size_t i = (size_t)C.bid * 512 + C.tid; i < n16; i += (size_t)C.G * 512) z[i] = zero16(); }
}
__device__ __forceinline__ void phase_prologue(const Ctx& C) {
    const size_t gt = (size_t)C.bid * 512 + C.tid, NT = (size_t)C.G * 512;
    { const f32x4* s = (const f32x4*)C.in(2); u32x2* d = WSP(u32x2, WS_MEMP); const size_t n = (size_t)NB * MTOK * DM / 4;
      for (size_t i = gt; i < n; i += NT) { const f32x4 v = s[i]; u32x2 w; w.x = cvt_pk_bf16(v[0], v[1]); w.y = cvt_pk_bf16(v[2], v[3]); d[i] = w; } }
    { const f32x4* s = (const f32x4*)C.in(7); u32x2* d = WSP(u32x2, WS_KS); const size_t n = (size_t)2 * SBT * MTOK * DM / 4;
      for (size_t i = gt; i < n; i += NT) { const f32x4 v = s[i]; u32x2 w; w.x = cvt_pk_bf16(v[0], v[1]); w.y = cvt_pk_bf16(v[2], v[3]); d[i] = w; } }
    LAS float* scr = (LAS float*)(C.lds + C.wave * 16384);
    const int gw = C.bid * 8 + C.wave, NGW = C.G * 8;
    const int I_V = (MTOK / 64) * (DM / 32), I_SQ = (DM / 64) * (DM / 32);
    const int NIT = 2 * SBT * I_V + 4 * I_SQ;
    for (int it = gw; it < NIT; it += NGW) {
        if (it < 2 * SBT * I_V) { const int lb = it / I_V, r = it % I_V;
            transpose_item(C.in(8) + (size_t)lb * MTOK * DM, MTOK, DM, WSP(bf16, WS_VTS) + (size_t)lb * DM * MTOK, (const float*)nullptr, scr, r, C.lane, RowId{0}); }
        else { const int q = (it - 2 * SBT * I_V) / I_SQ, r = (it - 2 * SBT * I_V) % I_SQ, l = q >> 1, kv = q & 1;
            transpose_item(C.in(kv ? 25 : 24) + (size_t)l * DM * DM, DM, DM, WSP(bf16, WS_WKV), (const float*)nullptr, scr, r, C.lane, RowId{q * DM}); }
    }
}
__device__ __forceinline__ void phase_xprep(const Ctx& C) {
    const int gw = C.bid * 8 + C.wave, NGW = C.G * 8;
    for (int row = gw; row < T; row += NGW) {
        const f32x4* xr = (row < TP ? (const f32x4*)C.in(0) + (size_t)row * (DM / 4) : (const f32x4*)C.in(1) + (size_t)(row - TP) * (DM / 4)) + C.lane; f32x4 v[8]; float s = 0.f;
#pragma unroll
        for (int j = 0; j < 8; ++j) { v[j] = xr[64 * j]; s += (v[j][0] * v[j][0] + v[j][1] * v[j][1]) + (v[j][2] * v[j][2] + v[j][3] * v[j][3]); }
        s = wave_sum(s); if (C.lane == 0) WSP(float, WS_SS)[row] = s;
        u32x2* o = WSP(u32x2, WS_H) + (size_t)row * (DM / 4) + C.lane; f32x4* xo = WSP(f32x4, WS_X) + (size_t)row * (DM / 4) + C.lane;
#pragma unroll
        for (int j = 0; j < 8; ++j) { u32x2 w; w.x = cvt_pk_bf16(v[j][0], v[j][1]); w.y = cvt_pk_bf16(v[j][2], v[j][3]); o[64 * j] = w; xo[64 * j] = v[j]; }
    }
}
__device__ __forceinline__ void phase_final(const Ctx& C) {
    const int gw = C.bid * 8 + C.wave, NGW = C.G * 8; const f32x4* gn = (const f32x4*)C.in(32) + C.lane;
    for (int row = gw; row < T; row += NGW) {
        const f32x4* xr = WSP(const f32x4, WS_X) + (size_t)row * (DM / 4) + C.lane; f32x4 v[8];
#pragma unroll
        for (int j = 0; j < 8; ++j) v[j] = xr[64 * j];
        const float rstd = row_rstd(WSP(const float, WS_SS) + (size_t)6 * T, row);
        f32x4* o = (f32x4*)(C.out + O_Y) + (size_t)row * (DM / 4) + C.lane;
#pragma unroll
        for (int j = 0; j < 8; ++j) o[64 * j] = v[j] * rstd * gn[64 * j];
    }
}
struct SeqInfo { int sample, b, t, L, row0; };
__device__ __forceinline__ SeqInfo seq_of_row(int row) { SeqInfo s; if (row < TP) { s.sample = 0; s.b = row / SEQ; s.t = row % SEQ; s.L = SEQ; s.row0 = s.b * SEQ; } else { const int r = row - TP; s.sample = 1; s.b = r / SSQ; s.t = r % SSQ; s.L = SSQ; s.row0 = TP + s.b * SSQ; } return s; }
__device__ __forceinline__ SeqInfo seq_of_idx(int sq) { SeqInfo s; if (sq < NB) { s.sample = 0; s.b = sq; s.L = SEQ; s.row0 = sq * SEQ; } else { s.sample = 1; s.b = sq - NB; s.L = SSQ; s.row0 = TP + s.b * SSQ; } s.t = 0; return s; }

__device__ __forceinline__ void phase_prep_conv(const Ctx& C, int l) {
    const size_t gt = (size_t)C.bid * 512 + C.tid, NT = (size_t)C.G * 512;
    const bf16* P = WSP(const bf16, WS_PROJ); const float* Sm = WSP(const float, WS_SMALL);
    const float* cw = C.in(11) + (size_t)l * 4 * XBCW; const float* cb = C.in(12) + (size_t)l * XBCW; const float* st = C.in(4) + (size_t)l * SBT * 3 * XBCW;
    for (size_t it = gt; it < (size_t)(T / 16) * (XBCW / 8); it += NT) {
        const int seg = (int)(it / (XBCW / 8)), c = (int)(it % (XBCW / 8)) * 8, row0 = seg * 16; const SeqInfo s = seq_of_row(row0);
        u32x4 raw[19];
#pragma unroll
        for (int i = 0; i < 16; ++i) raw[3 + i] = *(const u32x4*)(P + (size_t)(row0 + i) * NPROJ + PXBC + c);
        float w[4][8], bias[8];
#pragma unroll
        for (int i = 0; i < 4; ++i) { const f32x4 a = *(const f32x4*)(cw + i * XBCW + c), b = *(const f32x4*)(cw + i * XBCW + c + 4);
#pragma unroll
            for (int j = 0; j < 4; ++j) { w[i][j] = a[j]; w[i][4 + j] = b[j]; } }
        { const f32x4 a = *(const f32x4*)(cb + c), b = *(const f32x4*)(cb + c + 4);
#pragma unroll
          for (int j = 0; j < 4; ++j) { bias[j] = a[j]; bias[4 + j] = b[j]; } }
        float hist[3][8];
        if (s.t >= 3) {
#pragma unroll
            for (int i = 0; i < 3; ++i) { raw[i] = *(const u32x4*)(P + (size_t)(row0 - 3 + i) * NPROJ + PXBC + c); unpack8(raw[i], hist[i]); } }
        else if (s.sample) {
#pragma unroll
            for (int i = 0; i < 3; ++i) { const float* sp = st + ((size_t)s.b * 3 + i) * XBCW + c;
#pragma unroll
                for (int j = 0; j < 8; ++j) hist[i][j] = sp[j]; } }
        else {
#pragma unroll
            for (int i = 0; i < 3; ++i)
#pragma unroll
                for (int j = 0; j < 8; ++j) hist[i][j] = 0.f; }
#pragma unroll
        for (int i = 0; i < 16; ++i) { float cur[8], o[8]; unpack8(raw[3 + i], cur);
#pragma unroll
            for (int j = 0; j < 8; ++j) { o[j] = siluf_(bias[j] + hist[0][j] * w[0][j] + hist[1][j] * w[1][j] + hist[2][j] * w[2][j] + cur[j] * w[3][j]); hist[0][j] = hist[1][j]; hist[1][j] = hist[2][j]; hist[2][j] = cur[j]; }
            *(u32x4*)(WSP(bf16, WS_XBC) + (size_t)(row0 + i) * XBCW + c) = pack8(o); }
    }
    for (size_t it = gt; it < (size_t)NSEQ * 3 * XBCW; it += NT) {
        const int c = (int)(it % XBCW), j = (int)(it / XBCW) % 3, sq = (int)(it / (3 * XBCW)); const SeqInfo s = seq_of_idx(sq);
        const float v = bf2f(P[(size_t)(s.row0 + s.L - 3 + j) * NPROJ + PXBC + c]);
        float* dst = C.out + (s.sample ? O_SSSDC + ((size_t)l * SBT + s.b) * 3 * XBCW : O_PSSDC + ((size_t)l * NB + s.b) * 3 * XBCW);
        dst[j * XBCW + c] = v;
    }
    for (size_t it = gt; it < (size_t)T * 32; it += NT) { const int row = (int)(it >> 5), h = (int)(it & 31);
        WSP(float, WS_DT)[it] = softplusf_(Sm[(size_t)row * 256 + h] + C.in(13)[l * 32 + h]); }
}

typedef short bf16x4 __attribute__((ext_vector_type(4)));
#define MFMA32(a, b, c) __builtin_amdgcn_mfma_f32_16x16x32_bf16(a, b, c, 0, 0, 0)
#define MFMA16(a, b, c) __builtin_amdgcn_mfma_f32_16x16x16bf16_1k(a, b, c, 0, 0, 0)
__device__ __forceinline__ bf16x8 mk8(u32x2 lo, u32x2 hi) { u32x4 w; w.x = lo.x; w.y = lo.y; w.z = hi.x; w.w = hi.y; return __builtin_bit_cast(bf16x8, w); }
__device__ __forceinline__ bf16x8 pack_tiles(const f32x4 t0, const f32x4 t1) { u32x4 w; w.x = cvt_pk_bf16(t0[0], t0[1]); w.y = cvt_pk_bf16(t0[2], t0[3]); w.z = cvt_pk_bf16(t1[0], t1[1]); w.w = cvt_pk_bf16(t1[2], t1[3]); return __builtin_bit_cast(bf16x8, w); }
struct ChunkInfo { int row0, nvalid; };
__device__ __forceinline__ ChunkInfo ssd_chunk(int cs) { ChunkInfo c; if (cs < NCP) { c.row0 = 64 * cs; c.nvalid = 64; } else { c.row0 = TP + SSQ * (cs - NCP); c.nvalid = SSQ; } return c; }

__device__ __forceinline__ void gla_prep_task(const Ctx& C, int l, int ck, int h) {
    const int lane = C.lane, fr = lane & 15, fq = lane >> 4, k4 = 4 * lane;
    LAS bf16* Lq = (LAS bf16*)(C.lds + C.wave * 16384); LAS bf16* Lk = Lq + 16 * 256;
    const bf16* P = WSP(const bf16, WS_PROJ); const float* Sm = WSP(const float, WS_SMALL);
    f32x4 bc[16]; f32x4 run = (f32x4){0.f, 0.f, 0.f, 0.f};
    { const float* wa2 = C.in(17) + (size_t)l * 16 * 1024 + h * 256 + k4; f32x4 wv[16];
#pragma unroll
      for (int r = 0; r < 16; ++r) wv[r] = *(const f32x4*)(wa2 + r * 1024);
      const f32x4 bav = *(const f32x4*)(C.in(18) + (size_t)l * 1024 + h * 256 + k4);
#pragma unroll
      for (int i = 0; i < 16; ++i) { const float* ar = Sm + (size_t)(16 * ck + i) * 256 + 32; f32x4 a = bav;
#pragma unroll
          for (int r4 = 0; r4 < 4; ++r4) { const f32x4 av = *(const f32x4*)(ar + 4 * r4);
#pragma unroll
              for (int q = 0; q < 4; ++q) a = a + wv[4 * r4 + q] * av[q]; }
#pragma unroll
          for (int j = 0; j < 4; ++j) run[j] += logsigmoidf_(a[j]) * (1.0f / 16.0f);
          bc[i] = run; } }
    const f32x4 b15 = bc[15];
    unsigned ke[4][8];
#pragma unroll
    for (int i = 0; i < 16; ++i) { const size_t row = (size_t)(16 * ck + i);
        const u32x2 qw = *(const u32x2*)(P + row * NPROJ + PQ + h * 256 + k4), kw = *(const u32x2*)(P + row * NPROJ + PK + h * 256 + k4);
        const float qv[4] = {bf_lo(qw.x), bf_hi(qw.x), bf_lo(qw.y), bf_hi(qw.y)}, kv[4] = {bf_lo(kw.x), bf_hi(kw.x), bf_lo(kw.y), bf_hi(kw.y)};
        float qd[4], ki[4], kend[4];
#pragma unroll
        for (int j = 0; j < 4; ++j) { qd[j] = qv[j] * 0.0625f * __expf(bc[i][j]); ki[j] = kv[j] * __expf(-bc[i][j]); kend[j] = kv[j] * __expf(b15[j] - bc[i][j]); }
        u32x2 w; w.x = cvt_pk_bf16(qd[0], qd[1]); w.y = cvt_pk_bf16(qd[2], qd[3]);
        *(u32x2*)(WSP(bf16, WS_QD) + row * 1024 + h * 256 + k4) = w; *(LAS u32x2*)(Lq + i * 256 + k4) = w;
        u32x2 w2; w2.x = cvt_pk_bf16(ki[0], ki[1]); w2.y = cvt_pk_bf16(ki[2], ki[3]); *(LAS u32x2*)(Lk + i * 256 + k4) = w2;
#pragma unroll
        for (int j = 0; j < 4; ++j) { if (i & 1) ke[j][i >> 1] |= f2bf(kend[j]) << 16; else ke[j][i >> 1] = f2bf(kend[j]); } }
#pragma unroll
    for (int j = 0; j < 4; ++j) { u32x4* d = (u32x4*)(WSP(bf16, WS_KET) + ((size_t)ck * 1024 + h * 256 + k4 + j) * 16);
        d[0] = (u32x4){ke[j][0], ke[j][1], ke[j][2], ke[j][3]}; d[1] = (u32x4){ke[j][4], ke[j][5], ke[j][6], ke[j][7]}; }
    { f32x4 dv; dv[0] = __expf(b15[0]); dv[1] = __expf(b15[1]); dv[2] = __expf(b15[2]); dv[3] = __expf(b15[3]); *(f32x4*)(WSP(float, WS_DEC) + (size_t)ck * 1024 + h * 256 + k4) = dv; }
    WAVE_LDS_SYNC();
    f32x4 att = (f32x4){0.f, 0.f, 0.f, 0.f};
#pragma unroll
    for (int ks = 0; ks < 8; ++ks) { const bf16x8 a = *(const LAS bf16x8*)(Lq + fr * 256 + 32 * ks + 8 * fq), b = *(const LAS bf16x8*)(Lk + fr * 256 + 32 * ks + 8 * fq); att = MFMA32(a, b, att); }
#pragma unroll
    for (int r = 0; r < 4; ++r) { const int i = 4 * fq + r; WSP(bf16, WS_ATT)[(((size_t)ck * 4 + h) * 16 + i) * 16 + fr] = (bf16)(fr <= i ? f2bf(att[r]) : 0u); }
    WAVE_LDS_SYNC();
    unsigned vt[8][8];
#pragma unroll
    for (int i = 0; i < 16; ++i) { float vv[8]; unpack8(*(const u32x4*)(P + (size_t)(16 * ck + i) * NPROJ + PV + h * 512 + 8 * lane), vv);
#pragma unroll
        for (int j = 0; j < 8; ++j) { if (i & 1) vt[j][i >> 1] |= f2bf(vv[j]) << 16; else vt[j][i >> 1] = f2bf(vv[j]); } }
#pragma unroll
    for (int j = 0; j < 8; ++j) { u32x4* d = (u32x4*)(WSP(bf16, WS_VT16) + ((size_t)ck * DM + h * 512 + 8 * lane + j) * 16);
        d[0] = (u32x4){vt[j][0], vt[j][1], vt[j][2], vt[j][3]}; d[1] = (u32x4){vt[j][4], vt[j][5], vt[j][6], vt[j][7]}; }
}
__device__ __forceinline__ void ssd_prep_head(const Ctx& C, int l, int cs, int h) {
    const int lane = C.lane, fr = lane & 15, fq = lane >> 4, g = h >> 3; const ChunkInfo ci = ssd_chunk(cs);
    LAS float* La = (LAS float*)(C.lds + C.wave * 16384); LAS float* Ld = La + 64;
    const bf16* XB = WSP(const bf16, WS_XBC); const float* DT = WSP(const float, WS_DT);
    const bf16x8 z8 = zero8h();
    f32x4 cb[4][4];
#pragma unroll
    for (int mt = 0; mt < 4; ++mt)
#pragma unroll
        for (int nt = 0; nt < 4; ++nt) cb[mt][nt] = (f32x4){0.f, 0.f, 0.f, 0.f};
#pragma unroll
    for (int ks = 0; ks < 4; ++ks) { bf16x8 af[4], bfr[4];
#pragma unroll
        for (int t = 0; t < 4; ++t) { const int i = 16 * t + fr; const bool ok = i < ci.nvalid; const bf16* rp = XB + (size_t)(ci.row0 + (ok ? i : 0)) * XBCW + g * 128 + 32 * ks + 8 * fq;
            af[t] = ok ? *(const bf16x8*)(rp + 2560) : z8; bfr[t] = ok ? *(const bf16x8*)(rp + 2048) : z8; }
#pragma unroll
        for (int mt = 0; mt < 4; ++mt)
#pragma unroll
            for (int nt = 0; nt <= mt; ++nt) cb[mt][nt] = MFMA32(af[mt], bfr[nt], cb[mt][nt]); }
    const bool jok = lane < ci.nvalid; const size_t jrow = (size_t)(ci.row0 + (jok ? lane : 0));
    const float a = -__expf(C.in(14)[l * 32 + h]); const float dtj = jok ? DT[jrow * 32 + h] : 0.f;
    float ac = dtj * a;
#pragma unroll
    for (int d = 1; d < 64; d <<= 1) { const float t = __shfl(ac, (lane - d) & 63); if (lane >= d) ac += t; }
    const float a63 = __shfl(ac, 63), te = __expf(a63 - ac) * dtj;
    La[lane] = ac; Ld[lane] = dtj;
    WSP(float, WS_EA)[((size_t)cs * 32 + h) * 64 + lane] = __expf(ac);
    if (lane == 0) WSP(float, WS_DECS)[(size_t)cs * 32 + h] = __expf(a63);
    u32x4 xr[8];
#pragma unroll
    for (int p8 = 0; p8 < 8; ++p8) xr[p8] = jok ? *(const u32x4*)(XB + jrow * XBCW + h * 64 + 8 * p8) : zero16();
#pragma unroll
    for (int p8 = 0; p8 < 8; ++p8) { float xv[8]; unpack8(xr[p8], xv);
#pragma unroll
        for (int q = 0; q < 8; ++q) { const size_t o = ((size_t)cs * DM + h * 64 + 8 * p8 + q) * 64 + lane; WSP(bf16, WS_XT)[o] = (bf16)f2bf(xv[q]); WSP(bf16, WS_XTE)[o] = (bf16)f2bf(xv[q] * te); } }
    WAVE_LDS_SYNC();
#pragma unroll
    for (int mt = 0; mt < 4; ++mt)
#pragma unroll
        for (int nt = 0; nt < 4; ++nt) { const int j = 16 * nt + fr; const float aj = La[j], dj = Ld[j];
#pragma unroll
            for (int r = 0; r < 4; ++r) { const int i = 16 * mt + 4 * fq + r; const float w = (nt <= mt && j <= i) ? cb[mt][nt][r] * __expf(La[i] - aj) * dj : 0.f;
                WSP(bf16, WS_WCH)[(((size_t)cs * 32 + h) * 64 + i) * 64 + j] = (bf16)f2bf(w); } }
    WAVE_LDS_SYNC();
}
__device__ __forceinline__ void ssd_prep_group(const Ctx& C, int cs, int g) {
    const int lane = C.lane; const ChunkInfo ci = ssd_chunk(cs); const bf16* XB = WSP(const bf16, WS_XBC);
    const bool jok = lane < ci.nvalid; const size_t jrow = (size_t)(ci.row0 + (jok ? lane : 0));
#pragma unroll 4
    for (int n8 = 0; n8 < 16; ++n8) { float bv[8];
        if (jok) unpack8(*(const u32x4*)(XB + jrow * XBCW + 2048 + g * 128 + 8 * n8), bv); else {
#pragma unroll
            for (int q = 0; q < 8; ++q) bv[q] = 0.f; }
#pragma unroll
        for (int q = 0; q < 8; ++q) WSP(bf16, WS_BT)[((size_t)cs * 512 + g * 128 + 8 * n8 + q) * 64 + lane] = (bf16)f2bf(bv[q]); }
#pragma unroll 4
    for (int it = 0; it < 16; ++it) { const int idx = it * 64 + lane, i = idx >> 4, n8 = idx & 15; const bool ok = i < ci.nvalid;
        const u32x4 v = ok ? *(const u32x4*)(XB + (size_t)(ci.row0 + i) * XBCW + 2560 + g * 128 + 8 * n8) : zero16();
        *(u32x4*)(WSP(bf16, WS_CC) + ((size_t)cs * 64 + i) * 512 + g * 128 + 8 * n8) = v; }
}
__device__ __forceinline__ void phase_prep(const Ctx& C, int l) {
    const int gw = C.wave * C.G + C.bid, NGW = C.G * 8;
    for (int t = gw; t < NCK * 4; t += NGW) gla_prep_task(C, l, t >> 2, t & 3);
    phase_prep_conv(C, l);
}
__device__ __forceinline__ void phase_chunkprep(const Ctx& C, int l) {
    const int gw = C.wave * C.G + C.bid, NGW = C.G * 8;
    constexpr int NHT = NCS * 32, NGT = NCS * 4;
    for (int t = gw; t < NHT + NGT; t += NGW) { if (t < NHT) ssd_prep_head(C, l, t >> 5, t & 31); else ssd_prep_group(C, (t - NHT) >> 2, (t - NHT) & 3); }
}
constexpr int GLA_SLOT = 18432, GLA_RING = 3 * GLA_SLOT;
__device__ __forceinline__ void gla_scan_task(const Ctx& C, int l, int sq, int h, int vs) {
    int lane = C.lane; LAUNDER_V(lane);
    const SeqInfo s = seq_of_idx(sq); const int fr = lane & 15, fq = lane >> 4, vc0 = h * 512 + vs * 16;
    f32x4 S[16];
    const size_t st_off = ((((size_t)l * (s.sample ? SBT : NB) + s.b) * 4 + h) * 256) * 512 + vs * 16;
    if (s.sample) { const float* st = C.in(5) + st_off;
#pragma unroll
        for (int kt = 0; kt < 16; ++kt)
#pragma unroll
            for (int r = 0; r < 4; ++r) S[kt][r] = st[(size_t)(16 * kt + 4 * fq + r) * 512 + fr]; }
    else {
#pragma unroll
        for (int kt = 0; kt < 16; ++kt) S[kt] = (f32x4){0.f, 0.f, 0.f, 0.f}; }
    VMCNT(0);
    const int nch = s.L / 16, ck0 = s.row0 / 16;
    const unsigned char* wsb = C.ws;
#define LDW(type, off) (*(const type*)(wsb + (off)))
    LAS unsigned char* ring = C.lds + C.wave * GLA_RING;
    unsigned gq = (unsigned)(WS_QD + ((size_t)(16 * ck0 + (lane & 15)) * 1024 + h * 256) * 2 + (lane >> 4) * 16);
    unsigned gk = (unsigned)(WS_KET + ((size_t)ck0 * 1024 + h * 256) * 32 + lane * 16);
    unsigned gd = (unsigned)(WS_DEC + ((size_t)ck0 * 1024 + h * 256) * 4 + lane * 16);
    unsigned ga = lane < 32 ? (unsigned)(WS_ATT + (((size_t)ck0 * 4 + h) * 256) * 2 + lane * 16) : (unsigned)(WS_VT16 + (((size_t)ck0 * DM + vc0) * 16) * 2 + (lane - 32) * 16);
    const unsigned sa = lane < 32 ? 2048u : (unsigned)(DM * 16 * 2);
#define GLA_DMA(slot) do { LAS unsigned char* sb_ = ring + (slot) * GLA_SLOT; LAUNDER_V(gq); LAUNDER_V(gk); LAUNDER_V(gd); LAUNDER_V(ga);     \
        _Pragma("unroll") for (int i = 0; i < 8; ++i) { \
            __builtin_amdgcn_global_load_lds((const unsigned*)(wsb + gq + i * 64), (LAS unsigned*)(sb_ + i * 1024), 16, 0, 0); \
            __builtin_amdgcn_global_load_lds((const unsigned*)(wsb + gk + i * 1024), (LAS unsigned*)(sb_ + 8192 + i * 1024), 16, 0, 0); } \
        __builtin_amdgcn_global_load_lds((const unsigned*)(wsb + gd), (LAS unsigned*)(sb_ + 16384), 16, 0, 0); \
        __builtin_amdgcn_global_load_lds((const unsigned*)(wsb + ga), (LAS unsigned*)(sb_ + 17408), 16, 0, 0); } while (0)
#define GLA_ADV(on) do { const unsigned a_ = (on) ? 1u : 0u; gq += a_ * (16 * 2048); gk += a_ * (1024 * 32); gd += a_ * 4096; ga += a_ * sa; } while (0)
    GLA_DMA(0); GLA_ADV(1 < nch); GLA_DMA(1); GLA_ADV(2 < nch);
    const int fh = fq & 1; const bool alo = fq < 2;
    const unsigned rq = (unsigned)(fr * 16 + 8 * fh + 256 * (fq >> 1));
    const unsigned rk = (unsigned)(8192 + fr * 32 + 16 * fh);
    const unsigned rat = (unsigned)(17408 + fr * 32 + 16 * fh), rv = rat + 512, rd = (unsigned)(16384 + 16 * fq);
    unsigned yo = (unsigned)(WS_YGR + ((size_t)(16 * ck0 + 4 * fq) * DM + vc0 + fr) * 4);
#define GLA_ITER(SL) do { \
        VMCNT(16); \
        __builtin_amdgcn_sched_barrier(0); \
        GLA_DMA(((SL) + 2) % 3); GLA_ADV(c + 3 < nch); \
        __builtin_amdgcn_sched_barrier(0); \
        const LAS unsigned char* sb = ring + (SL) * GLA_SLOT; \
        f32x4 o0 = (f32x4){0.f, 0.f, 0.f, 0.f}; \
        _Pragma("unroll") for (int ks = 0; ks < 8; ++ks) { \
            const u32x2 qa = *(const LAS u32x2*)(sb + rq + 1024 * ks), qb = *(const LAS u32x2*)(sb + rq + 1024 * ks + 512); \
            o0 = MFMA32(mk8(qa, qb), pack_tiles(S[2 * ks], S[2 * ks + 1]), o0); \
            if (ks & 1) __builtin_amdgcn_sched_barrier(0); } \
        const bf16x8 at = *(const LAS bf16x8*)(sb + rat); bf16x8 v0 = *(const LAS bf16x8*)(sb + rv); if (!alo) v0 = zero8h(); \
        o0 = MFMA32(at, v0, o0); \
        _Pragma("unroll") for (int r = 0; r < 4; ++r) *(float*)(C.ws + yo + (unsigned)(r * DM * 4)) = o0[r]; \
        yo += 16 * DM * 4; \
        _Pragma("unroll") for (int kt = 0; kt < 16; ++kt) { const f32x4 d = *(const LAS f32x4*)(sb + rd + 64 * kt); const bf16x8 ka = *(const LAS bf16x8*)(sb + rk + 512 * kt); \
            S[kt] = MFMA32(ka, v0, S[kt] * d); \
            if ((kt & 3) == 3) __builtin_amdgcn_sched_barrier(0); } \
        ++c; } while (0)
    for (int c = 0; c < nch;) { GLA_ITER(0); if (c >= nch) break; GLA_ITER(1); if (c >= nch) break; GLA_ITER(2); }
#undef GLA_ITER
    VMCNT(0);
#undef GLA_DMA
#undef GLA_ADV
    float* dst = C.out + (s.sample ? O_SGLA : O_PGLA) + st_off;
#pragma unroll
    for (int kt = 0; kt < 16; ++kt)
#pragma unroll
        for (int r = 0; r < 4; ++r) dst[(size_t)(16 * kt + 4 * fq + r) * 512 + fr] = S[kt][r];
}
__device__ __forceinline__ void ssd_scan_task(const Ctx& C, int l, int sq, int h, int ph) {
    const SeqInfo s = seq_of_idx(sq); const int lane = C.lane, fr = lane & 15, fq = lane >> 4, g = h >> 3, ch0 = h * 64 + ph * 32;
    f32x4 H[8][2];
    const size_t st_off = (((size_t)l * (s.sample ? SBT : NB) + s.b) * 32 + h) * 64 * 128;
    if (s.sample) { const float* st = C.in(3) + st_off;
#pragma unroll
        for (int nt = 0; nt < 8; ++nt)
#pragma unroll
            for (int pt = 0; pt < 2; ++pt) H[nt][pt] = *(const f32x4*)(st + (size_t)(ph * 32 + 16 * pt + fr) * 128 + 16 * nt + 4 * fq); }
    else {
#pragma unroll
        for (int nt = 0; nt < 8; ++nt) { H[nt][0] = (f32x4){0.f, 0.f, 0.f, 0.f}; H[nt][1] = (f32x4){0.f, 0.f, 0.f, 0.f}; } }
    const float Dh = C.in(15)[l * 32 + h];
    const int nch = s.sample ? 1 : SEQ / 64, cs0 = s.sample ? NCP + s.b : s.row0 / 64, nvalid = s.sample ? SSQ : 64;
    const unsigned char* wsb = C.ws;
    unsigned co = (unsigned)(WS_CC + (((size_t)cs0 * 64 + fr) * 512 + g * 128 + 4 * fq) * 2);
    unsigned eo = (unsigned)(WS_EA + (((size_t)cs0 * 32 + h) * 64 + 4 * fq) * 4);
    unsigned wo = (unsigned)(WS_WCH + ((((size_t)cs0 * 32 + h) * 64 + fr) * 64 + 8 * fq) * 2);
    unsigned xo = (unsigned)(WS_XT + (((size_t)cs0 * DM + ch0 + fr) * 64) * 2);
    unsigned xeo = (unsigned)(WS_XTE + (((size_t)cs0 * DM + ch0 + fr) * 64 + 8 * fq) * 2);
    unsigned bo = (unsigned)(WS_BT + (((size_t)cs0 * 512 + g * 128 + fr) * 64 + 8 * fq) * 2);
    unsigned deo = (unsigned)(WS_DECS + ((size_t)cs0 * 32 + h) * 4);
    unsigned yo = (unsigned)(WS_YSR + ((size_t)(s.row0 + 4 * fq) * DM + ch0 + fr) * 4);
#define SCHED_FENCE() __builtin_amdgcn_sched_barrier(0)
    for (int c = 0; c < nch; ++c) {
        u32x2 ca[4][4], cb2[4][4]; f32x4 ea[4];
#pragma unroll
        for (int mt = 0; mt < 4; ++mt) { ea[mt] = LDW(f32x4, eo + 64 * mt);
#pragma unroll
            for (int ks = 0; ks < 4; ++ks) { ca[mt][ks] = LDW(u32x2, co + mt * 16384 + 64 * ks); cb2[mt][ks] = LDW(u32x2, co + mt * 16384 + 64 * ks + 32); } }
        f32x4 y[4][2];
#pragma unroll
        for (int mt = 0; mt < 4; ++mt) { y[mt][0] = (f32x4){0.f, 0.f, 0.f, 0.f}; y[mt][1] = (f32x4){0.f, 0.f, 0.f, 0.f}; }
        SCHED_FENCE();
#pragma unroll
        for (int ks = 0; ks < 2; ++ks) { const bf16x8 b0 = pack_tiles(H[2 * ks][0], H[2 * ks + 1][0]), b1 = pack_tiles(H[2 * ks][1], H[2 * ks + 1][1]);
#pragma unroll
            for (int mt = 0; mt < 4; ++mt) { const bf16x8 a = mk8(ca[mt][ks], cb2[mt][ks]); y[mt][0] = MFMA32(a, b0, y[mt][0]); y[mt][1] = MFMA32(a, b1, y[mt][1]); } }
        SCHED_FENCE();
        bf16x8 wf[6], xf[2][2]; u32x2 xd[4][2];
#pragma unroll
        for (int mt = 0; mt < 4; ++mt) wf[mt] = LDW(bf16x8, wo + mt * 2048);
        wf[4] = LDW(bf16x8, wo + 2 * 2048 + 64); wf[5] = LDW(bf16x8, wo + 3 * 2048 + 64);
#pragma unroll
        for (int pt = 0; pt < 2; ++pt) { xf[0][pt] = LDW(bf16x8, xo + pt * 2048 + 16 * fq); xf[1][pt] = LDW(bf16x8, xo + pt * 2048 + 64 + 16 * fq);
#pragma unroll
            for (int mt = 0; mt < 4; ++mt) xd[mt][pt] = LDW(u32x2, xo + pt * 2048 + 32 * mt + 8 * fq); }
        SCHED_FENCE();
#pragma unroll
        for (int ks = 2; ks < 4; ++ks) { const bf16x8 b0 = pack_tiles(H[2 * ks][0], H[2 * ks + 1][0]), b1 = pack_tiles(H[2 * ks][1], H[2 * ks + 1][1]);
#pragma unroll
            for (int mt = 0; mt < 4; ++mt) { const bf16x8 a = mk8(ca[mt][ks], cb2[mt][ks]); y[mt][0] = MFMA32(a, b0, y[mt][0]); y[mt][1] = MFMA32(a, b1, y[mt][1]); } }
#pragma unroll
        for (int mt = 0; mt < 4; ++mt) { y[mt][0] = y[mt][0] * ea[mt]; y[mt][1] = y[mt][1] * ea[mt]; }
        SCHED_FENCE();
        bf16x8 bt0[8], bt1[8], xe[2][2]; const float dec = LDW(float, deo);
#pragma unroll
        for (int nt = 0; nt < 8; ++nt) bt0[nt] = LDW(bf16x8, bo + nt * 2048);
        xe[0][0] = LDW(bf16x8, xeo); xe[0][1] = LDW(bf16x8, xeo + 2048);
        SCHED_FENCE();
#pragma unroll
        for (int mt = 0; mt < 4; ++mt) { y[mt][0] = MFMA32(wf[mt], xf[0][0], y[mt][0]); y[mt][1] = MFMA32(wf[mt], xf[0][1], y[mt][1]); }
        y[2][0] = MFMA32(wf[4], xf[1][0], y[2][0]); y[2][1] = MFMA32(wf[4], xf[1][1], y[2][1]); y[3][0] = MFMA32(wf[5], xf[1][0], y[3][0]); y[3][1] = MFMA32(wf[5], xf[1][1], y[3][1]);
#pragma unroll
        for (int mt = 0; mt < 4; ++mt)
#pragma unroll
            for (int pt = 0; pt < 2; ++pt) { const float xv[4] = {bf_lo(xd[mt][pt].x), bf_hi(xd[mt][pt].x), bf_lo(xd[mt][pt].y), bf_hi(xd[mt][pt].y)};
#pragma unroll
                for (int r = 0; r < 4; ++r) if (16 * mt + 4 * fq + r < nvalid) *(float*)(C.ws + yo + (unsigned)(((16 * mt + r) * DM + 16 * pt) * 4)) = y[mt][pt][r] + Dh * xv[r]; }
        SCHED_FENCE();
#pragma unroll
        for (int nt = 0; nt < 8; ++nt) bt1[nt] = LDW(bf16x8, bo + nt * 2048 + 64);
        xe[1][0] = LDW(bf16x8, xeo + 64); xe[1][1] = LDW(bf16x8, xeo + 2048 + 64);
        SCHED_FENCE();
#pragma unroll
        for (int nt = 0; nt < 8; ++nt) { H[nt][0] = MFMA32(bt0[nt], xe[0][0], H[nt][0] * dec); H[nt][1] = MFMA32(bt0[nt], xe[0][1], H[nt][1] * dec); }
#pragma unroll
        for (int nt = 0; nt < 8; ++nt) { H[nt][0] = MFMA32(bt1[nt], xe[1][0], H[nt][0]); H[nt][1] = MFMA32(bt1[nt], xe[1][1], H[nt][1]); }
        co += 64 * 512 * 2; eo += 32 * 64 * 4; wo += 32 * 64 * 64 * 2; xo += DM * 64 * 2; xeo += DM * 64 * 2; bo += 512 * 64 * 2; deo += 32 * 4; yo += 64 * DM * 4;
    }
    float* dst = C.out + (s.sample ? O_SSSD : O_PSSD) + st_off;
#pragma unroll
    for (int nt = 0; nt < 8; ++nt)
#pragma unroll
        for (int pt = 0; pt < 2; ++pt) *(f32x4*)(dst + (size_t)(ph * 32 + 16 * pt + fr) * 128 + 16 * nt + 4 * fq) = H[nt][pt];
}
__device__ __forceinline__ void phase_scan(const Ctx& C, int l) {
    constexpr int NGP = NB * 4 * 32, NGS = SBT * 4 * 32, NSP = NB * 32 * 2, NSS = SBT * 32 * 2;
    static_assert(2 * GLA_RING <= 131072, "GLA rings fit the phase scratch");
    if (C.wave < 2) {
        for (int t = C.wave * C.G + C.bid; t < NGP + NGS; t += 2 * C.G) {
            if (t < NGP) gla_scan_task(C, l, t / 128, (t % 128) / 32, t % 32);
            else { const int u = t - NGP; gla_scan_task(C, l, NB + u / 128, (u % 128) / 32, u % 32); } }
    } else {
        for (int t = (C.wave - 2) * C.G + C.bid; t < NSP + NSS; t += 6 * C.G) {
            if (t < NSP) ssd_scan_task(C, l, t / 64, (t % 64) / 2, t % 2);
            else { const int r = t - NSP; ssd_scan_task(C, l, NB + r / 64, (r % 64) / 2, r % 2); } }
    }
}
__device__ __forceinline__ void phase_ynorm(const Ctx& C, int l) {
    const int gw = C.bid * 8 + C.wave, NGW = C.G * 8; const bf16* P = WSP(const bf16, WS_PROJ);
    const float* sn = C.in(16) + (size_t)l * DM; const float* gn = C.in(19) + (size_t)l * 512;
    for (int row = gw; row < T; row += NGW) {
#pragma unroll
        for (int gi = 0; gi < 4; ++gi) { const int c = gi * 512 + C.lane * 8;
            const f32x4 y0 = *(const f32x4*)(WSP(const float, WS_YSR) + (size_t)row * DM + c), y1 = *(const f32x4*)(WSP(const float, WS_YSR) + (size_t)row * DM + c + 4);
            float zv[8]; unpack8(*(const u32x4*)(P + (size_t)row * NPROJ + PZ + c), zv); float v[8]; float ss = 0.f;
#pragma unroll
            for (int j = 0; j < 8; ++j) { const float y = j < 4 ? y0[j] : y1[j - 4]; v[j] = y * siluf_(zv[j]); ss += v[j] * v[j]; }
            const float rstd = 1.0f / sqrtf(wave_sum(ss) * (1.0f / 512.0f) + EPSF);
#pragma unroll
            for (int j = 0; j < 8; ++j) v[j] = v[j] * rstd * sn[c + j];
            *(u32x4*)(WSP(bf16, WS_YS) + (size_t)row * DM + c) = pack8(v); }
#pragma unroll
        for (int hh = 0; hh < 4; ++hh) { const int c = hh * 512 + C.lane * 8;
            const f32x4 y0 = *(const f32x4*)(WSP(const float, WS_YGR) + (size_t)row * DM + c), y1 = *(const f32x4*)(WSP(const float, WS_YGR) + (size_t)row * DM + c + 4);
            float gv[8]; unpack8(*(const u32x4*)(P + (size_t)row * NPROJ + PG + c), gv); float v[8]; float ss = 0.f;
#pragma unroll
            for (int j = 0; j < 8; ++j) { v[j] = j < 4 ? y0[j] : y1[j - 4]; ss += v[j] * v[j]; }
            const float rstd = 1.0f / sqrtf(wave_sum(ss) * (1.0f / 512.0f) + EPSF);
#pragma unroll
            for (int j = 0; j < 8; ++j) v[j] = v[j] * rstd * gn[C.lane * 8 + j] * siluf_(gv[j]);
            *(u32x4*)(WSP(bf16, WS_YG) + (size_t)row * DM + c) = pack8(v); }
    }
}
__device__ __forceinline__ void phase_attn(const Ctx& C, int l) {
    constexpr int QT = SEQ / 128, NU_P = NB * 4 * QT, NU = NU_P + SBT * 4;
    constexpr int KROW = 1040, VROW = 528, BUFB = 16896;
    const int tid = C.tid, lane = C.lane, w = C.wave, fr = lane & 15, fq = lane >> 4;
    LAS unsigned char* KV = C.lds;
    LAS bf16* Pl = (LAS bf16*)(C.lds + 2 * BUFB + w * 8448);
    const int krow = tid >> 6, kc = tid & 63, vrow = tid >> 5, vc = tid & 31;
    const unsigned char* wsb = C.ws;
#define LDG(type, off) (*(const type*)(wsb + (off)))
    for (int u = C.bid; u < NU; u += C.G) {
        int row0, h, nvw; unsigned kbo, vbo;
        if (u < NU_P) { const int b = u / (4 * QT), r = u % (4 * QT); h = r / QT; row0 = b * SEQ + (r % QT) * 128; nvw = 8;
            kbo = (unsigned)(WS_KP + (((size_t)l * NB + b) * MTOK * DM + h * 512) * 2); vbo = (unsigned)(WS_VTP + ((((size_t)l * NB + b) * DM + h * 512) * MTOK) * 2); }
        else { const int r = u - NU_P, b = r / 4; h = r % 4; row0 = TP + b * SSQ; nvw = 1;
            kbo = (unsigned)(WS_KS + (((size_t)l * SBT + b) * MTOK * DM + h * 512) * 2); vbo = (unsigned)(WS_VTS + ((((size_t)l * SBT + b) * DM + h * 512) * MTOK) * 2); }
        const bool act = w < nvw; const int qrow = row0 + 16 * w;
        const unsigned kld = kbo + (unsigned)((krow * DM + kc * 8) * 2), vld = vbo + (unsigned)((vrow * MTOK + vc * 8) * 2);
        const unsigned qo = (unsigned)(WS_YS + ((size_t)(qrow + fr) * DM + h * 512 + 8 * fq) * 2), oo = (unsigned)(WS_YG + ((size_t)(qrow + 4 * fq) * DM + h * 512 + fr) * 2);
        __syncthreads();
        u32x4 st0 = LDG(u32x4, kld), st1 = LDG(u32x4, kld + 8 * DM * 2);
        bf16x8 qf[16];
        if (act) {
#pragma unroll
            for (int ks = 0; ks < 16; ++ks) qf[ks] = LDG(bf16x8, qo + 64 * ks); }
        else {
#pragma unroll
            for (int ks = 0; ks < 16; ++ks) qf[ks] = zero8h(); }
        *(LAS u32x4*)(KV + krow * KROW + kc * 16) = st0; *(LAS u32x4*)(KV + (krow + 8) * KROW + kc * 16) = st1;
        __syncthreads();
        f32x4 sacc[16];
#pragma unroll
        for (int kt = 0; kt < 16; ++kt) {
            if (kt < 15) { st0 = LDG(u32x4, kld + (kt + 1) * (16 * DM * 2)); st1 = LDG(u32x4, kld + (kt + 1) * (16 * DM * 2) + 8 * DM * 2); }
            else { st0 = LDG(u32x4, vld); st1 = LDG(u32x4, vld + 16 * MTOK * 2); }
            f32x4 a = (f32x4){0.f, 0.f, 0.f, 0.f};
            if (act) {
#pragma unroll
                for (int ks = 0; ks < 16; ++ks) { const bf16x8 kf = *(const LAS bf16x8*)(KV + (kt & 1) * BUFB + fr * KROW + (32 * ks + 8 * fq) * 2); a = MFMA32(qf[ks], kf, a); } }
            sacc[kt] = a;
            if (kt < 15) { *(LAS u32x4*)(KV + ((kt + 1) & 1) * BUFB + krow * KROW + kc * 16) = st0; *(LAS u32x4*)(KV + ((kt + 1) & 1) * BUFB + (krow + 8) * KROW + kc * 16) = st1; }
            else { *(LAS u32x4*)(KV + vrow * VROW + vc * 16) = st0; *(LAS u32x4*)(KV + (vrow + 16) * VROW + vc * 16) = st1; }
            __syncthreads();
            __builtin_amdgcn_sched_barrier(0);
        }
        bf16x8 pf[8];
        if (act) {
            const float sc = 0.04419417382415922f;
#pragma unroll
            for (int r = 0; r < 4; ++r) { float mx = -3.0e38f;
#pragma unroll
                for (int nt = 0; nt < 16; ++nt) mx = fmaxf(mx, sacc[nt][r]);
                mx = fmaxf(mx, __shfl_xor(mx, 1)); mx = fmaxf(mx, __shfl_xor(mx, 2)); mx = fmaxf(mx, __shfl_xor(mx, 4)); mx = fmaxf(mx, __shfl_xor(mx, 8));
                float sum = 0.f;
#pragma unroll
                for (int nt = 0; nt < 16; ++nt) { const float e = __expf((sacc[nt][r] - mx) * sc); sacc[nt][r] = e; sum += e; }
                sum += __shfl_xor(sum, 1); sum += __shfl_xor(sum, 2); sum += __shfl_xor(sum, 4); sum += __shfl_xor(sum, 8);
                const float inv = 1.0f / sum;
#pragma unroll
                for (int nt = 0; nt < 16; ++nt) Pl[(4 * fq + r) * 264 + 16 * nt + fr] = (bf16)f2bf(sacc[nt][r] * inv); }
            WAVE_LDS_SYNC();
#pragma unroll
            for (int ks = 0; ks < 8; ++ks) pf[ks] = *(const LAS bf16x8*)(Pl + fr * 264 + 32 * ks + 8 * fq);
            WAVE_LDS_SYNC();
        } else {
#pragma unroll
            for (int ks = 0; ks < 8; ++ks) pf[ks] = zero8h(); }
#pragma unroll
        for (int vt = 0; vt < 16; ++vt) {
            if (vt < 15) { st0 = LDG(u32x4, vld + (vt + 1) * (32 * MTOK * 2)); st1 = LDG(u32x4, vld + (vt + 1) * (32 * MTOK * 2) + 16 * MTOK * 2); }
            if (act) {
#pragma unroll
                for (int d2 = 0; d2 < 2; ++d2) { f32x4 a = (f32x4){0.f, 0.f, 0.f, 0.f};
#pragma unroll
                    for (int ks = 0; ks < 8; ++ks) { const bf16x8 vf = *(const LAS bf16x8*)(KV + (vt & 1) * BUFB + (16 * d2 + fr) * VROW + (32 * ks + 8 * fq) * 2); a = MFMA32(pf[ks], vf, a); }
#pragma unroll
                    for (int r = 0; r < 4; ++r) *(bf16*)(C.ws + oo + (unsigned)((r * DM + 32 * vt + 16 * d2) * 2)) = (bf16)f2bf(a[r]); } }
            if (vt < 15) { *(LAS u32x4*)(KV + ((vt + 1) & 1) * BUFB + vrow * VROW + vc * 16) = st0; *(LAS u32x4*)(KV + ((vt + 1) & 1) * BUFB + (vrow + 16) * VROW + vc * 16) = st1;
                __syncthreads(); }
            __builtin_amdgcn_sched_barrier(0);
        }
    }
#undef LDG
}
__device__ __forceinline__ void phase_ffnact(const Ctx& C, int l) {
    const size_t gt = (size_t)C.bid * 512 + C.tid, NT = (size_t)C.G * 512;
    const bf16* U = WSP(const bf16, WS_PROJ);
    const float* cw = C.in(29) + (size_t)l * 3 * DFF2; const float* cb = C.in(30) + (size_t)l * DFF2; const float* st = C.in(6) + (size_t)l * SBT * 2 * DFF2;
    for (size_t it = gt; it < (size_t)(T / 8) * (DFF / 8); it += NT) {
        const int seg = (int)(it / (DFF / 8)), c = (int)(it % (DFF / 8)) * 8, row0 = seg * 8; const SeqInfo s = seq_of_row(row0);
        u32x4 ru[10], rg[10];
#pragma unroll
        for (int i = 0; i < 8; ++i) { ru[2 + i] = *(const u32x4*)(U + (size_t)(row0 + i) * DFF2 + c); rg[2 + i] = *(const u32x4*)(U + (size_t)(row0 + i) * DFF2 + DFF + c); }
        float wu[3][8], wg[3][8], bu[8], bg[8];
#pragma unroll
        for (int i = 0; i < 3; ++i)
#pragma unroll
            for (int hlf = 0; hlf < 2; ++hlf) { const f32x4 a = *(const f32x4*)(cw + i * DFF2 + c + 4 * hlf), b = *(const f32x4*)(cw + i * DFF2 + DFF + c + 4 * hlf);
#pragma unroll
                for (int j = 0; j < 4; ++j) { wu[i][4 * hlf + j] = a[j]; wg[i][4 * hlf + j] = b[j]; } }
#pragma unroll
        for (int hlf = 0; hlf < 2; ++hlf) { const f32x4 a = *(const f32x4*)(cb + c + 4 * hlf), b = *(const f32x4*)(cb + DFF + c + 4 * hlf);
#pragma unroll
            for (int j = 0; j < 4; ++j) { bu[4 * hlf + j] = a[j]; bg[4 * hlf + j] = b[j]; } }
        float hu[2][8], hg[2][8];
        if (s.t >= 2) {
#pragma unroll
            for (int i = 0; i < 2; ++i) { ru[i] = *(const u32x4*)(U + (size_t)(row0 - 2 + i) * DFF2 + c); rg[i] = *(const u32x4*)(U + (size_t)(row0 - 2 + i) * DFF2 + DFF + c); unpack8(ru[i], hu[i]); unpack8(rg[i], hg[i]); } }
        else if (s.sample) {
#pragma unroll
            for (int i = 0; i < 2; ++i) { const float* sp = st + ((size_t)s.b * 2 + i) * DFF2 + c;
#pragma unroll
                for (int j = 0; j < 8; ++j) { hu[i][j] = sp[j]; hg[i][j] = sp[DFF + j]; } } }
        else {
#pragma unroll
            for (int i = 0; i < 2; ++i)
#pragma unroll
                for (int j = 0; j < 8; ++j) { hu[i][j] = 0.f; hg[i][j] = 0.f; } }
#pragma unroll
        for (int i = 0; i < 8; ++i) { float cu[8], cg[8], o[8]; unpack8(ru[2 + i], cu); unpack8(rg[2 + i], cg);
#pragma unroll
            for (int j = 0; j < 8; ++j) { const float au = bu[j] + hu[0][j] * wu[0][j] + hu[1][j] * wu[1][j] + cu[j] * wu[2][j], ag = bg[j] + hg[0][j] * wg[0][j] + hg[1][j] * wg[1][j] + cg[j] * wg[2][j];
                o[j] = siluf_(ag) * au; hu[0][j] = hu[1][j]; hu[1][j] = cu[j]; hg[0][j] = hg[1][j]; hg[1][j] = cg[j]; }
            *(u32x4*)(WSP(bf16, WS_YSR) + (size_t)(row0 + i) * DFF + c) = pack8(o); }
    }
    for (size_t it = gt; it < (size_t)NSEQ * 2 * DFF2; it += NT) {
        const int c = (int)(it % DFF2), j = (int)(it / DFF2) % 2, sq = (int)(it / (2 * DFF2)); const SeqInfo s = seq_of_idx(sq);
        float* dst = C.out + (s.sample ? O_SFFC + ((size_t)l * SBT + s.b) * 2 * DFF2 : O_PFFC + ((size_t)l * NB + s.b) * 2 * DFF2);
        dst[j * DFF2 + c] = bf2f(U[(size_t)(s.row0 + s.L - 2 + j) * DFF2 + c]);
    }
}

struct SEpiGate0 { const bf16* P; float* M0; static constexpr bool ROWSUM = false; __device__ __forceinline__ float operator()(int row, int col, float v) const { M0[(size_t)row * DM + col] = v * sigmoidf_(bf2f(P[(size_t)row * NPROJ + PGATE + col])); return 0.f; } };
struct SEpiGate1 { const bf16* P; const float* M0; bf16* O; static constexpr bool ROWSUM = false; __device__ __forceinline__ float operator()(int row, int col, float v) const { O[(size_t)row * DM + col] = (bf16)f2bf(M0[(size_t)row * DM + col] + v * sigmoidf_(bf2f(P[(size_t)row * NPROJ + PGATE + DM + col]))); return 0.f; } };
struct SEpiResid { float* X; bf16* H; float* SS; static constexpr bool ROWSUM = true; __device__ __forceinline__ float operator()(int row, int col, float v) const { const float x = X[(size_t)row * DM + col] + v; X[(size_t)row * DM + col] = x; H[(size_t)row * DM + col] = (bf16)f2bf(x); return x * x; } };
struct SEpiBf16 { bf16* O; const float* SS; static constexpr bool ROWSUM = false; __device__ __forceinline__ float operator()(int row, int col, float v) const { O[(size_t)row * DM + col] = (bf16)f2bf(v * row_rstd(SS, row)); return 0.f; } };
template <class SE>
__device__ __forceinline__ void sample_gemm(const Ctx& C, size_t a_off, size_t b_off, int K, const SE& E) {
    const int lane = C.lane, fr = lane & 15, fq = lane >> 4; const unsigned char* wsb = C.ws;
    const int slot = C.bid * 8 + C.wave, NSLOT = C.G * 8;
    for (int t = slot; t < 16 * (DM / 16); t += NSLOT) { const int rt = t / (DM / 16), ct = t % (DM / 16);
        unsigned ao = (unsigned)(a_off + ((size_t)(TP + 16 * rt + fr) * K + 8 * fq) * 2), bo = (unsigned)(b_off + ((size_t)(16 * ct + fr) * K + 8 * fq) * 2);
        f32x4 acc = (f32x4){0.f, 0.f, 0.f, 0.f};
        bf16x8 af[16], bfv[16];
#pragma unroll
        for (int j = 0; j < 16; ++j) { af[j] = *(const bf16x8*)(wsb + ao + 64 * j); bfv[j] = *(const bf16x8*)(wsb + bo + 64 * j); }
        for (int k0 = 0; k0 < K; k0 += 512) {
            const unsigned adv = (k0 + 512 < K) ? 1024u : 0u;
#pragma unroll
            for (int j = 0; j < 16; ++j) { acc = MFMA32(af[j], bfv[j], acc);
                af[j] = *(const bf16x8*)(wsb + ao + adv + 64 * j); bfv[j] = *(const bf16x8*)(wsb + bo + adv + 64 * j);
                __builtin_amdgcn_sched_barrier(0); }
            ao += 1024; bo += 1024; }
#pragma unroll
        for (int r = 0; r < 4; ++r) { const int row = TP + 16 * rt + 4 * fq + r; float q = E(row, 16 * ct + fr, acc[r]);
            if constexpr (SE::ROWSUM) { q += __shfl_xor(q, 1); q += __shfl_xor(q, 2); q += __shfl_xor(q, 4); q += __shfl_xor(q, 8); if (fr == 0) atomicAdd(E.SS + row, q); } }
    }
}

#ifndef HOST_EMU
#define XB_TMO      128
#define XB_XCNT(j)  (256  + 64 * (j))
#define XB_XSUB(j)  (1280 + 64 * (j))
#define XB_XGEN(j)  (2304 + 64 * (j))
#define XB_TOP      3328
#define XB_TOPGEN   3392
#define XCD_BAR_WORDS 3456
#define XB_SPIN_CAP (1u << 18)
__device__ __forceinline__ unsigned xb_ld(unsigned* p)              { return __hip_atomic_load(p, __ATOMIC_RELAXED, __HIP_MEMORY_SCOPE_AGENT); }
__device__ __forceinline__ unsigned xb_add(unsigned* p, unsigned v) { return __hip_atomic_fetch_add(p, v, __ATOMIC_RELAXED, __HIP_MEMORY_SCOPE_AGENT); }
__device__ __forceinline__ unsigned xb_xcc_id() { return (unsigned)__builtin_amdgcn_s_getreg((3 << 11) | 20) & 0xFu; }
#define XB_SPIN(cond, bar) do { unsigned _sp = 0; while (cond) { __builtin_amdgcn_s_sleep(1); \
    if ((++_sp & 255u) == 0u) { if (xb_ld(&(bar)[XB_TMO])) break; if (_sp > XB_SPIN_CAP) { atomicAdd(&(bar)[XB_TMO], 1u); break; } } } } while (0)
struct XcdBarrier { unsigned* bar; unsigned x; volatile LAS unsigned* st; };
__device__ __forceinline__ XcdBarrier xcd_barrier_post(unsigned* bar, volatile LAS unsigned* st) {
    XcdBarrier b; b.bar = bar; b.x = xb_xcc_id(); b.st = st;
    if (threadIdx.x == 0) (void)xb_add(&bar[XB_XCNT(b.x)], 1u);
    return b;
}
__device__ __forceinline__ void xcd_barrier_complete(unsigned* bar, unsigned x, unsigned& nloc, unsigned& nx) {
    const unsigned G = gridDim.x * gridDim.y * gridDim.z;
    unsigned sum, cnt, mine, sp = 0u;
    for (;;) {
        sum = 0u; cnt = 0u; mine = 0u;
#pragma unroll
        for (unsigned j = 0; j < 16; ++j) { const unsigned c = xb_ld(&bar[XB_XCNT(j)]); sum += c; cnt += (c > 0u) ? 1u : 0u; mine = (j == x) ? c : mine; }
        if (sum == G) break;
        __builtin_amdgcn_s_sleep(1);
        if ((++sp & 255u) == 0u) { if (xb_ld(&bar[XB_TMO])) break; if (sp > XB_SPIN_CAP) { atomicAdd(&bar[XB_TMO], 1u); break; } }
    }
    nloc = mine > 0u ? mine : 1u; nx = cnt > 0u ? cnt : 1u;
}
__device__ __forceinline__ void xcd_barrier(const XcdBarrier& b) {
    asm volatile("s_waitcnt vmcnt(0)" ::: "memory");
    __syncthreads();
    if (threadIdx.x == 0) {
        unsigned* bar = b.bar;
        __builtin_amdgcn_s_waitcnt(0);
        unsigned nloc = b.st[0], nx = b.st[1];
        if (nloc == 0u) { xcd_barrier_complete(bar, b.x, nloc, nx); b.st[0] = nloc; b.st[1] = nx; }
        const unsigned old = xb_add(&bar[XB_XSUB(b.x)], 1u);
        const unsigned gen = old / nloc;
        if (old + 1u == (gen + 1u) * nloc) {
            __builtin_amdgcn_fence(__ATOMIC_RELEASE, "agent");
            asm volatile("s_waitcnt vmcnt(0)" ::: "memory");
            const unsigned og = xb_add(&bar[XB_TOP], 1u);
            const unsigned tg = og / nx;
            if (og + 1u == (tg + 1u) * nx) xb_add(&bar[XB_TOPGEN], 1u);
            else XB_SPIN(xb_ld(&bar[XB_TOPGEN]) == tg, bar);
            __builtin_amdgcn_fence(__ATOMIC_ACQUIRE, "agent");
            xb_add(&bar[XB_XGEN(b.x)], 1u);
            asm volatile("s_waitcnt vmcnt(0)" ::: "memory");
        } else {
            XB_SPIN(xb_ld(&bar[XB_XGEN(b.x)]) == gen, bar);
            __builtin_amdgcn_fence(__ATOMIC_ACQUIRE, "agent");
            asm volatile("s_waitcnt vmcnt(0)" ::: "memory");
        }
    }
    __syncthreads();
}
#endif

constexpr int PH_PRO = 0, PH_KV = 1, PH_L0 = 2, PH_PER_LAYER = 18, PH_FINAL = PH_L0 + 2 * PH_PER_LAYER, NPH = PH_FINAL + 1;
#ifdef HOST_EMU
__device__ __forceinline__ Ctx make_ctx(const Args& args, unsigned char* lds, int) {
    Ctx C; C.lds = lds; C.tid = threadIdx.x; C.lane = C.tid & 63; C.wave = C.tid >> 6; C.G = gridDim.x; C.bid = blockIdx.x; C.ap = &args; C.out = args.out; C.ws = args.ws; return C;
}
#else
__device__ __forceinline__ Ctx make_ctx(const Args& args, unsigned char* lds, int wave_s) {
    Ctx C; int wave = wave_s; asm volatile("" : "+s"(wave));
    int lane = __builtin_amdgcn_mbcnt_hi(~0u, __builtin_amdgcn_mbcnt_lo(~0u, 0u)); asm volatile("" : "+v"(lane));
    int bid = blockIdx.x, G = gridDim.x; asm volatile("" : "+s"(bid), "+s"(G));
    const CAS unsigned char* kp = (const CAS unsigned char*)__builtin_amdgcn_kernarg_segment_ptr(); asm volatile("" : "+s"(kp));
    int tid = wave * 64 + lane; asm volatile("" : "+v"(tid));
    C.lds = (LAS unsigned char*)lds; C.tid = tid; C.lane = tid & 63; C.wave = __builtin_amdgcn_readfirstlane(tid >> 6); C.G = G; C.bid = bid; C.kp = kp;
    C.out = *(float* const CAS*)(kp + 264); C.ws = *(unsigned char* const CAS*)(kp + 272);
    return C;
}
static_assert(sizeof(Args) == 288, "Args layout (kernarg offsets in make_ctx)");
#endif
__global__ void __launch_bounds__(512, 2) mk_fwd(Args args) {
    DYN_LDS(lds);
    const int lo = args.ph_lo, hi = args.ph_hi;
    const int wave_s = __builtin_amdgcn_readfirstlane((int)threadIdx.x >> 6);
#ifndef HOST_EMU
    volatile LAS unsigned* lctl = (volatile LAS unsigned*)((LAS unsigned char*)lds + LDS_CTL_OFF);
    if (threadIdx.x < 64) lctl[threadIdx.x] = 0u;
    __syncthreads();
    if (hi - lo > 1) (void)xcd_barrier_post((unsigned*)(args.ws + WS_CTL) + 4096, lctl + 8);
#define GRID_BAR() do { XcdBarrier bar_; { const CAS unsigned char* kp_ = (const CAS unsigned char*)__builtin_amdgcn_kernarg_segment_ptr(); asm volatile("" : "+s"(kp_)); \
        bar_.bar = (unsigned*)(*(unsigned char* const CAS*)(kp_ + 272) + WS_CTL) + 4096; } bar_.x = xb_xcc_id(); bar_.st = (volatile LAS unsigned*)((LAS unsigned char*)lds + LDS_CTL_OFF) + 8; xcd_barrier(bar_); } while (0)
#else
#define GRID_BAR() ((void)0)
#endif
#define IN(k) (lo <= (k) && (k) < hi)
#define SEAM(k) do { if (IN(k) && IN((k) + 1)) GRID_BAR(); } while (0)
#define CTX const Ctx C = make_ctx(args, lds, wave_s)
#define GEMM_PHASE(EPI, Aoff, Boff, M_, N_, K_, ...) do { CTX; pg8::Gemm g{WSP(const bf16, Aoff), WSP(const bf16, Boff), M_, N_, K_}; pg8::StaticOrder S; S.init(M_, N_, C.G, C.bid); \
        EPI E{__VA_ARGS__}; pg8::gemm_phase<EPI, true>(C.lds, C.tid, g, S, E); } while (0)
    if (IN(PH_PRO)) { { CTX; phase_prologue(C); } __syncthreads(); { CTX; phase_wconv(C, 0); } { CTX; phase_xprep(C); } } SEAM(PH_PRO);
    if (IN(PH_KV)) GEMM_PHASE(EpiMemKV, WS_MEMP, WS_WKV, NB * MTOK, 8192, DM, C.out, WSP(bf16, WS_KP), WSP(bf16, WS_VTP)); SEAM(PH_KV);
#ifndef PROBE_MASK
#define PROBE_MASK 0
#endif
#define LPH(off, ...) do { if (IN(pb + (off))) { __VA_ARGS__; if ((PROBE_MASK >> (off)) & 1) { GRID_BAR(); __VA_ARGS__; } } SEAM(pb + (off)); } while (0)
    for (int l = 0; l < 2; ++l) {
        const int pb = PH_L0 + PH_PER_LAYER * l;
        if (IN(pb + 0)) { if (l > 0) { CTX; phase_wconv(C, l); } if (PROBE_MASK & 1) { GRID_BAR(); CTX; phase_wconv(C, l); } } SEAM(pb + 0);
        LPH(2, GEMM_PHASE(EpiProj, WS_H, WS_WIN, T, NPROJ_PAD, DM, WSP(bf16, WS_PROJ), WSP(float, WS_SMALL), WSP(const float, WS_SS) + (size_t)(3 * l) * T));
        LPH(3, { CTX; phase_prep(C, l); });
        LPH(4, { CTX; phase_chunkprep(C, l); });
        LPH(5, { CTX; phase_scan(C, l); });
        LPH(6, { CTX; phase_ynorm(C, l); });
        LPH(7, { GEMM_PHASE(EpiGate0, WS_YS, WS_WB0, TP, DM, DM, WSP(const bf16, WS_PROJ), WSP(float, WS_YSR)); CTX; sample_gemm(C, WS_YS, WS_WB0, DM, SEpiGate0{WSP(const bf16, WS_PROJ), WSP(float, WS_YSR)}); });
        LPH(8, { GEMM_PHASE(EpiGate1, WS_YG, WS_WB1, TP, DM, DM, WSP(const bf16, WS_PROJ), WSP(const float, WS_YSR), WSP(bf16, WS_MRG)); CTX; sample_gemm(C, WS_YG, WS_WB1, DM, SEpiGate1{WSP(const bf16, WS_PROJ), WSP(const float, WS_YSR), WSP(bf16, WS_MRG)}); });
        LPH(9, { GEMM_PHASE(EpiResid, WS_MRG, WS_WOUT, TP, DM, DM, WSP(float, WS_X), WSP(bf16, WS_H), WSP(float, WS_SS) + (size_t)(3 * l + 1) * T); CTX; sample_gemm(C, WS_MRG, WS_WOUT, DM, SEpiResid{WSP(float, WS_X), WSP(bf16, WS_H), WSP(float, WS_SS) + (size_t)(3 * l + 1) * T}); });
        LPH(11, { GEMM_PHASE(EpiBf16, WS_H, WS_WMQ, TP, DM, DM, WSP(bf16, WS_YS), DM, WSP(const float, WS_SS) + (size_t)(3 * l + 1) * T); CTX; sample_gemm(C, WS_H, WS_WMQ, DM, SEpiBf16{WSP(bf16, WS_YS), WSP(const float, WS_SS) + (size_t)(3 * l + 1) * T}); });
        LPH(12, { CTX; phase_attn(C, l); });
        LPH(13, { GEMM_PHASE(EpiResid, WS_YG, WS_WMO, TP, DM, DM, WSP(float, WS_X), WSP(bf16, WS_H), WSP(float, WS_SS) + (size_t)(3 * l + 2) * T); CTX; sample_gemm(C, WS_YG, WS_WMO, DM, SEpiResid{WSP(float, WS_X), WSP(bf16, WS_H), WSP(float, WS_SS) + (size_t)(3 * l + 2) * T}); });
        LPH(15, GEMM_PHASE(EpiBf16, WS_H, WS_WFI, T, DFF2, DM, WSP(bf16, WS_PROJ), DFF2, WSP(const float, WS_SS) + (size_t)(3 * l + 2) * T));
        LPH(16, { CTX; phase_ffnact(C, l); });
        LPH(17, { GEMM_PHASE(EpiResid, WS_YSR, WS_WFO, TP, DM, DFF, WSP(float, WS_X), WSP(bf16, WS_H), WSP(float, WS_SS) + (size_t)(3 * l + 3) * T); CTX; sample_gemm(C, WS_YSR, WS_WFO, DFF, SEpiResid{WSP(float, WS_X), WSP(bf16, WS_H), WSP(float, WS_SS) + (size_t)(3 * l + 3) * T}); });
    }
    if (IN(PH_FINAL)) { CTX; phase_final(C); }
#undef IN
#undef SEAM
#undef GRID_BAR
}

extern "C" void kernel_launch(void* const* d_in, const int* in_sizes, int n_in, void* d_out, int out_size, void* d_ws, size_t ws_size, hipStream_t stream) {
    static int grid = 0;
    if (grid == 0) {
        if (n_in != 33 || (size_t)out_size != O_END || ws_size < WS_END) { fprintf(stderr, "kernel_launch: unexpected shapes (n_in %d out %d ws %zu; need out %zu ws %zu)\n", n_in, out_size, ws_size, (size_t)O_END, (size_t)WS_END); grid = -1; return; }
        int dev = 0, cus = 0;
        if (hipGetDevice(&dev) != hipSuccess || hipDeviceGetAttribute(&cus, hipDeviceAttributeMultiprocessorCount, dev) != hipSuccess) { grid = -1; return; }
        if (hipFuncSetAttribute((const void*)mk_fwd, hipFuncAttributeMaxDynamicSharedMemorySize, LDS_BYTES) != hipSuccess) { fprintf(stderr, "kernel_launch: hipFuncSetAttribute failed\n"); grid = -1; return; }
        (void)hipGetLastError();
        grid = cus;
    }
    if (grid < 0) return;
    (void)hipMemsetAsync((char*)d_ws + WS_CTL, 0, CTL_BYTES, stream);
    Args a{};
    for (int i = 0; i < 33; ++i) a.in[i] = (const float*)d_in[i];
    a.out = (float*)d_out; a.ws = (unsigned char*)d_ws;
#ifdef HOST_EMU
    const char* e0 = getenv("EMU_PH_LO"); const char* e1 = getenv("EMU_PH_HI");
    const int plo = e0 ? atoi(e0) : 0, phi = e1 ? atoi(e1) : NPH;
    for (int p = plo; p < phi; ++p) { a.ph_lo = p; a.ph_hi = p + 1; fprintf(stderr, "emu: phase %d\n", p); emu_launch(mk_fwd, (unsigned)grid, 512u, (size_t)LDS_BYTES, a); }
#else
#if MK_ONE_LAUNCH
    a.ph_lo = 0; a.ph_hi = NPH;
    hipLaunchKernelGGL(mk_fwd, dim3(grid), dim3(512), LDS_BYTES, stream, a);
#else
    for (int p = 0; p < NPH; ++p) { a.ph_lo = p; a.ph_hi = p + 1; hipLaunchKernelGGL(mk_fwd, dim3(grid), dim3(512), LDS_BYTES, stream, a); }
#endif
#endif
}
```

```cpp
#ifndef HOST_EMU
#include <hip/hip_runtime.h>
#endif
#include <cstdio>
#include <cstdint>

#ifndef CFG_BATCH
#define CFG_BATCH 4
#endif
#ifndef CFG_SEQ
#define CFG_SEQ 2048
#endif
#ifndef MK_ONE_LAUNCH
#define MK_ONE_LAUNCH 1
#endif

#ifdef HOST_EMU
#define LAS
#define VMCNT(n) ((void)emu_wave_op([](unsigned char*) {}, [](unsigned char (*)[64]) {}))
#define LGKMCNT(n) ((void)0)
#define MEMCLOB() ((void)0)
#define WAVE_LDS_SYNC() ((void)emu_wave_op([](unsigned char*) {}, [](unsigned char (*)[64]) {}))
#define DYN_LDS(name) unsigned char* name = emu_lds()
#define LAUNDER_V(x) ((void)0)
#else
#define LAS __attribute__((address_space(3)))
#define VMCNT(n) asm volatile("s_waitcnt vmcnt(" #n ")" ::: "memory")
#define LGKMCNT(n) asm volatile("s_waitcnt lgkmcnt(" #n ")" ::: "memory")
#define MEMCLOB() asm volatile("" ::: "memory")
#define WAVE_LDS_SYNC() asm volatile("s_waitcnt lgkmcnt(0)" ::: "memory")
#define DYN_LDS(name) extern __shared__ __attribute__((aligned(16))) unsigned char name[]
#define LAUNDER_V(x) asm volatile("" : "+v"(x))
#endif

typedef unsigned short bf16;
typedef short bf16x8 __attribute__((ext_vector_type(8)));
typedef float f32x4 __attribute__((ext_vector_type(4)));
typedef float f32x2 __attribute__((ext_vector_type(2)));
typedef unsigned u32x4 __attribute__((ext_vector_type(4)));
typedef unsigned u32x2 __attribute__((ext_vector_type(2)));

__device__ __forceinline__ unsigned f2bf(float f) { unsigned u = __builtin_bit_cast(unsigned, f); return (u + 0x7fffu + ((u >> 16) & 1u)) >> 16; }
__device__ __forceinline__ float bf2f(unsigned b) { return __builtin_bit_cast(float, b << 16); }
__device__ __forceinline__ float bf_lo(unsigned w) { return __builtin_bit_cast(float, w << 16); }
__device__ __forceinline__ float bf_hi(unsigned w) { return __builtin_bit_cast(float, w & 0xffff0000u); }
#ifdef HOST_EMU
__device__ __forceinline__ unsigned cvt_pk_bf16(float lo, float hi) { return f2bf(lo) | (f2bf(hi) << 16); }
#else
typedef __bf16 bf16x2_native __attribute__((ext_vector_type(2)));
__device__ __forceinline__ unsigned cvt_pk_bf16(float lo, float hi) { const f32x2 v = {lo, hi}; return __builtin_bit_cast(unsigned, __builtin_convertvector(v, bf16x2_native)); }
#endif
__device__ __forceinline__ void unpack8(const u32x4 w, float (&v)[8]) { v[0] = bf_lo(w.x); v[1] = bf_hi(w.x); v[2] = bf_lo(w.y); v[3] = bf_hi(w.y); v[4] = bf_lo(w.z); v[5] = bf_hi(w.z); v[6] = bf_lo(w.w); v[7] = bf_hi(w.w); }
__device__ __forceinline__ u32x4 pack8(const float (&v)[8]) { u32x4 w; w.x = cvt_pk_bf16(v[0], v[1]); w.y = cvt_pk_bf16(v[2], v[3]); w.z = cvt_pk_bf16(v[4], v[5]); w.w = cvt_pk_bf16(v[6], v[7]); return w; }
__device__ __forceinline__ u32x4 zero16() { unsigned z = 0u; LAUNDER_V(z); return (u32x4){z, z, z, z}; }
__device__ __forceinline__ bf16x8 zero8h() { return __builtin_bit_cast(bf16x8, zero16()); }
__device__ __forceinline__ float sigmoidf_(float x) { return 1.0f / (1.0f + __expf(-x)); }
__device__ __forceinline__ float siluf_(float x) { return x / (1.0f + __expf(-x)); }
__device__ __forceinline__ float softplusf_(float x) { return x > 20.f ? x : __logf(1.0f + __expf(x)); }
__device__ __forceinline__ float logsigmoidf_(float x) { return fminf(x, 0.f) - __logf(1.0f + __expf(-fabsf(x))); }
__device__ __forceinline__ float wave_sum(float v) {
#pragma unroll
    for (int o = 1; o < 64; o <<= 1) v += __shfl_xor(v, o);
    return v;
}

constexpr int DM = 2048, NB = CFG_BATCH, SEQ = CFG_SEQ, TP = NB * SEQ, SBT = 16, SSQ = 16, TS = SBT * SSQ, T = TP + TS, NSEQ = NB + SBT;
constexpr int MTOK = 256, DFF = 5632, DFF2 = 11264, IN_DIM = 15408, NPROJ = 15360, NPROJ_PAD = 15616, XBCW = 3072;
constexpr int PZ = 0, PXBC = 2048, PQ = 5120, PK = 6144, PV = 7168, PG = 9216, PGATE = 11264;
constexpr float EPSF = 1e-6f;
static_assert(TP % 256 == 0 && SEQ % 16 == 0, "token tiling");
constexpr size_t O_Y = 0, O_PSSD = (size_t)T * DM, O_PSSDC = O_PSSD + (size_t)2 * NB * 32 * 64 * 128, O_PGLA = O_PSSDC + (size_t)2 * NB * 3 * XBCW, O_PFFC = O_PGLA + (size_t)2 * NB * 4 * 256 * 512,
                 O_PMK = O_PFFC + (size_t)2 * NB * 2 * DFF2, O_PMV = O_PMK + (size_t)2 * NB * MTOK * DM, O_SSSD = O_PMV + (size_t)2 * NB * MTOK * DM, O_SSSDC = O_SSSD + (size_t)2 * SBT * 32 * 64 * 128,
                 O_SGLA = O_SSSDC + (size_t)2 * SBT * 3 * XBCW, O_SFFC = O_SGLA + (size_t)2 * SBT * 4 * 256 * 512, O_END = O_SFFC + (size_t)2 * SBT * 2 * DFF2;
constexpr size_t A256(size_t x) { return (x + 255) & ~(size_t)255; }
constexpr size_t WS_CTL = 0, CTL_BYTES = 1u << 20;
constexpr size_t WS_WIN = WS_CTL + CTL_BYTES;
constexpr size_t WS_WB0 = WS_WIN + (size_t)NPROJ_PAD * DM * 2;
constexpr size_t WS_WB1 = WS_WB0 + (size_t)DM * DM * 2, WS_WOUT = WS_WB1 + (size_t)DM * DM * 2, WS_WMQ = WS_WOUT + (size_t)DM * DM * 2, WS_WMO = WS_WMQ + (size_t)DM * DM * 2;
constexpr size_t WS_WFI = WS_WMO + (size_t)DM * DM * 2;
constexpr size_t WS_WFO = WS_WFI + (size_t)DFF2 * DM * 2;
constexpr size_t WS_WKV = WS_WFO + (size_t)DM * DFF * 2;
constexpr size_t WS_X = WS_WKV + (size_t)8192 * DM * 2;
constexpr size_t WS_H = WS_X + (size_t)T * DM * 4;
constexpr size_t WS_PROJ = WS_H + (size_t)T * DM * 2;
constexpr size_t WS_SMALL = WS_PROJ + (size_t)T * NPROJ * 2;
constexpr size_t WS_XBC = WS_SMALL + (size_t)T * 256 * 4;
constexpr size_t WS_DT = WS_XBC + (size_t)T * XBCW * 2;
constexpr size_t WS_LOGA = WS_DT + (size_t)T * 32 * 4;
constexpr size_t WS_YSR = WS_LOGA + (size_t)T * 1024 * 4;
constexpr size_t WS_YGR = WS_YSR + (size_t)T * DM * 4;
constexpr size_t WS_YS = WS_YGR + (size_t)T * DM * 4;
constexpr size_t WS_YG = WS_YS + (size_t)T * DM * 2;
constexpr size_t WS_MRG = WS_YG + (size_t)T * DM * 2;
constexpr size_t WS_KP = WS_MRG + (size_t)T * DM * 2;
constexpr size_t WS_VTP = WS_KP + (size_t)2 * NB * MTOK * DM * 2;
constexpr size_t WS_KS = WS_VTP + (size_t)2 * NB * MTOK * DM * 2;
constexpr size_t WS_VTS = WS_KS + (size_t)2 * SBT * MTOK * DM * 2;
constexpr size_t WS_MEMP = WS_VTS + (size_t)2 * SBT * MTOK * DM * 2;
constexpr int NCK = T / 16, NCP = TP / 64, NCS = NCP + SBT;
static_assert(SEQ % 64 == 0, "SSD chunks must not straddle sequences");
constexpr size_t WS_WCH = WS_MEMP + (size_t)NB * MTOK * DM * 2;
constexpr size_t WS_XT = WS_WCH + (size_t)NCS * 32 * 64 * 64 * 2;
constexpr size_t WS_END0 = WS_XT + (size_t)NCS * DM * 64 * 2;
constexpr size_t WS_VT16 = WS_H;
constexpr size_t WS_QD = WS_MRG, WS_KET = WS_MRG + (size_t)T * 1024 * 2;
constexpr size_t WS_DEC = WS_WKV, WS_ATT = WS_DEC + (size_t)NCK * 1024 * 4, WS_EA = WS_ATT + (size_t)NCK * 4 * 256 * 2, WS_DECS = WS_EA + (size_t)NCS * 32 * 64 * 4;
constexpr size_t SZ_XTE = (size_t)NCS * DM * 64 * 2, SZ_BT = (size_t)NCS * 512 * 64 * 2, SZ_CC = (size_t)NCS * 64 * 512 * 2;
constexpr bool OVL_Y = SZ_XTE + SZ_BT + SZ_CC <= (size_t)2 * T * DM * 2;
constexpr size_t WS_XTE = OVL_Y ? WS_YS : WS_END0, WS_BT = WS_XTE + SZ_XTE, WS_CC = WS_BT + SZ_BT;
constexpr size_t WS_END = OVL_Y ? WS_END0 : WS_CC + SZ_CC;
static_assert(WS_DECS + (size_t)NCS * 32 * 4 <= WS_WKV + (size_t)8192 * DM * 2, "scan operand overlays");
static_assert((size_t)T * DFF * 2 <= (size_t)2 * T * DM * 4, "ACT overlay");
static_assert(WS_END <= (size_t)1081389824, "workspace budget");
constexpr size_t WS_SS = WS_CTL + 65536;
static_assert(65536 + (size_t)7 * T * 4 <= CTL_BYTES, "SS slots inside the zeroed control region");
constexpr int LDS_BYTES = 147456;
constexpr int GLP_SLOT = 19456;
constexpr int LDS_CTL_OFF = 139264;

namespace pg8 {
constexpr int BM = 256, BK = 64, HALF = 128, HTB = HALF * BK * 2, STAGE_BYTES = 8 * HTB, NXCD = 8, WGM = 8;
__host__ __device__ __forceinline__ int lds_byte(int r, int c) { const int st = (r >> 4) * 2 + (c >> 5), rr = r & 15, cc = c & 31, ob = rr * 64 + cc * 2; return st * 1024 + (ob ^ (((ob >> 9) & 1) << 5)); }
__host__ __device__ __forceinline__ void stage_rc(int b, int& R, int& C) { const int st = b / 1024, sb = b % 1024, swz = sb ^ (((sb >> 9) & 1) << 5); R = (st >> 1) * 16 + swz / 64; C = (st & 1) * 32 + (swz % 64) / 2; }
__host__ __device__ __forceinline__ int perm32(int rho) { const int n = rho >> 4, i = rho & 15; return 8 * (i >> 2) + 4 * n + (i & 3); }
struct Unit { int pm, pn; };
struct Gemm { const bf16* A; const bf16* Bt; int M, N, K; };
struct StaticOrder {
    int nM, nN, nwg, G, c;
    __host__ __device__ void init(int M, int N, int G_, int c_) { nM = M / BM; nN = N / BM; nwg = nM * nN; G = G_; c = c_; }
    __host__ __device__ bool next(int i, Unit& u) const {
        const long L = (long)i * G + c; if (L >= nwg) return false;
        int wgid = (int)L; { const int q = nwg / NXCD, r = nwg % NXCD, xcd = wgid % NXCD, off = wgid / NXCD; wgid = (xcd < r ? xcd * (q + 1) : r * (q + 1) + (xcd - r) * q) + off; }
        const int nig = WGM * nN, gid = wgid / nig, fm = gid * WGM, gsz = (nM - fm) < WGM ? (nM - fm) : WGM;
        u.pm = fm + ((wgid % nig) % gsz); u.pn = (wgid % nig) / gsz; return true;
    }
};
template <class Epi, bool ALIGN_EPI>
__device__ __forceinline__ void gemm_phase(LAS unsigned char* lds, const int tid, const Gemm g, const StaticOrder& S, const Epi& E) {
    const int wid = __builtin_amdgcn_readfirstlane(tid >> 6), lane = tid & 63, wr = wid >> 2, wc = wid & 3, fr = lane & 15, fq = lane >> 4;
    const int K = g.K, nt = K / BK;
    unsigned voffA[2], voffB[2];
#pragma unroll
    for (int i = 0; i < 2; ++i) { int R, C; stage_rc(tid * 16 + i * 8192, R, C); const int Rb = Epi::PERM ? ((R & ~31) + perm32(R & 31)) : R;
        voffA[i] = (unsigned)(R * K + C) * 2u; voffB[i] = (unsigned)(Rb * K + C) * 2u; }
    const size_t kstep = (size_t)(BK * 2), hstep = (size_t)HALF * K * 2, tstep = 2 * hstep;
    const unsigned ldsw = (unsigned)wid * 1024u;
    const int aoff = lds_byte(wr * 64 + fr, fq * 8), boff = lds_byte(wc * 32 + fr, fq * 8);
#define PG8_SA(b, h) (((b) * 2 + (h)) * HTB)
#define PG8_SB(b, h) ((4 + (b) * 2 + (h)) * HTB)
#define PG8_STAGE(bufoff, gbase, voff) do { _Pragma("unroll") for (int _i = 0; _i < 2; ++_i) \
        __builtin_amdgcn_global_load_lds((const unsigned*)((const char*)(gbase) + (voff)[_i]), (LAS unsigned*)(lds + (bufoff) + ldsw + _i * 8192), 16, 0, 0); } while (0)
#define PG8_LDA(dst, b, h) do { _Pragma("unroll") for (int m = 0; m < 4; ++m) _Pragma("unroll") for (int k = 0; k < 2; ++k) dst[m][k] = *(const LAS bf16x8*)(lds + PG8_SA(b, h) + aoff + m * 2048 + k * 1024); } while (0)
#define PG8_LDB(dst, b, h) do { _Pragma("unroll") for (int n = 0; n < 2; ++n) _Pragma("unroll") for (int k = 0; k < 2; ++k) dst[n][k] = *(const LAS bf16x8*)(lds + PG8_SB(b, h) + boff + n * 2048 + k * 1024); } while (0)
#define PG8_MMA(ai, bj, At, Bt) do { __builtin_amdgcn_s_setprio(1); _Pragma("unroll") for (int m = 0; m < 4; ++m) _Pragma("unroll") for (int n = 0; n < 2; ++n) _Pragma("unroll") for (int k = 0; k < 2; ++k) \
        acc[ai][bj][m][n] = __builtin_amdgcn_mfma_f32_16x16x32_bf16(Bt[n][k], At[m][k], acc[ai][bj][m][n], 0, 0, 0); __builtin_amdgcn_s_setprio(0); } while (0)
#define PG8_BAR __builtin_amdgcn_s_barrier()
#define PG8_SCHED __builtin_amdgcn_sched_barrier(0)
    Unit cur, nxt; int ui = 0;
    if (!S.next(0, cur)) return;
    float zf = 0.f; LAUNDER_V(zf);
    f32x4 acc[2][2][4][2];
#pragma unroll
    for (int a = 0; a < 2; ++a)
#pragma unroll
        for (int b = 0; b < 2; ++b)
#pragma unroll
            for (int m = 0; m < 4; ++m)
#pragma unroll
                for (int n = 0; n < 2; ++n) acc[a][b][m][n] = (f32x4){zf, zf, zf, zf};
    bf16x8 At[4][2], B0[2][2], B1[2][2];
    const char* cA = (const char*)g.A + (size_t)cur.pm * tstep; const char* cB = (const char*)g.Bt + (size_t)cur.pn * tstep;
    PG8_STAGE(PG8_SB(0, 0), cB, voffB); PG8_STAGE(PG8_SB(0, 1), cB + hstep, voffB); PG8_STAGE(PG8_SA(0, 0), cA, voffA); PG8_STAGE(PG8_SA(0, 1), cA + hstep, voffA);
    if (wr == 1) PG8_BAR;
    VMCNT(2); PG8_BAR;
    PG8_STAGE(PG8_SB(1, 0), cB + kstep, voffB); PG8_STAGE(PG8_SA(1, 0), cA + kstep, voffA); PG8_STAGE(PG8_SB(1, 1), cB + hstep + kstep, voffB);
    VMCNT(6); PG8_BAR;
    for (;;) {
        const bool has_next = S.next(ui + 1, nxt);
        const char* nA = has_next ? (const char*)g.A + (size_t)nxt.pm * tstep : cA; const char* nB = has_next ? (const char*)g.Bt + (size_t)nxt.pn * tstep : cB;
        for (int t = 0; t < nt; t += 2) {
            const bool last = (t == nt - 2);
            const char* a1 = cA + (size_t)(t + 1) * kstep;
            const char* a2 = last ? nA : cA + (size_t)(t + 2) * kstep; const char* b2 = last ? nB : cB + (size_t)(t + 2) * kstep;
            const char* a3 = a2 + kstep; const char* b3 = b2 + kstep;
            PG8_LDB(B0, 0, 0); PG8_LDB(B1, 0, 1); PG8_SCHED; PG8_LDA(At, 0, 0); PG8_STAGE(PG8_SA(1, 1), a1 + hstep, voffA);
            VMCNT(8); LGKMCNT(0); PG8_BAR; PG8_MMA(0, 0, At, B0); PG8_MMA(0, 1, At, B1); PG8_BAR; PG8_SCHED;
            PG8_LDA(At, 0, 1); PG8_STAGE(PG8_SB(0, 0), b2, voffB); PG8_STAGE(PG8_SB(0, 1), b2 + hstep, voffB); PG8_STAGE(PG8_SA(0, 0), a2, voffA);
            VMCNT(8); LGKMCNT(0); PG8_BAR; PG8_MMA(1, 0, At, B0); PG8_MMA(1, 1, At, B1); PG8_BAR; PG8_SCHED;
            PG8_LDB(B0, 1, 0); PG8_LDB(B1, 1, 1); PG8_SCHED; PG8_LDA(At, 1, 0); PG8_STAGE(PG8_SA(0, 1), a2 + hstep, voffA);
            VMCNT(8); LGKMCNT(0); PG8_BAR; PG8_MMA(0, 0, At, B0); PG8_MMA(0, 1, At, B1); PG8_BAR; PG8_SCHED;
            PG8_LDA(At, 1, 1); PG8_STAGE(PG8_SB(1, 0), b3, voffB); PG8_STAGE(PG8_SB(1, 1), b3 + hstep, voffB); PG8_STAGE(PG8_SA(1, 0), a3, voffA);
            VMCNT(8); LGKMCNT(0); PG8_BAR; PG8_MMA(1, 0, At, B0); PG8_MMA(1, 1, At, B1); PG8_BAR; PG8_SCHED;
        }
        if constexpr (ALIGN_EPI) { if (wr == 0) PG8_BAR; }
        E(acc, cur, wr, wc, fr, fq);
        if (!has_next) break;
#pragma unroll
        for (int a = 0; a < 2; ++a)
#pragma unroll
            for (int b = 0; b < 2; ++b)
#pragma unroll
                for (int m = 0; m < 4; ++m)
#pragma unroll
                    for (int n = 0; n < 2; ++n) acc[a][b][m][n] = (f32x4){zf, zf, zf, zf};
        cur = nxt; cA = nA; cB = nB; ++ui;
        if constexpr (ALIGN_EPI) { if (wr == 1) PG8_BAR; }
    }
    VMCNT(0);
    if constexpr (!ALIGN_EPI) { if (wr == 0) PG8_BAR; }
    PG8_BAR;
#undef PG8_SA
#undef PG8_SB
#undef PG8_STAGE
#undef PG8_LDA
#undef PG8_LDB
#undef PG8_MMA
#undef PG8_BAR
#undef PG8_SCHED
}
}
using pg8::Unit;

#define EPI_LOOP_ROWS for (int ai = 0; ai < 2; ++ai) _Pragma("unroll") for (int m = 0; m < 4; ++m)
__device__ __forceinline__ float row_rstd(const float* SS, int row) { return 1.0f / sqrtf(SS[row] * (1.0f / DM) + EPSF); }
struct EpiBf16 {
    static constexpr bool PERM = true;
    bf16* O; int ldc; const float* SS;
    __device__ __forceinline__ void operator()(const f32x4 (&acc)[2][2][4][2], const Unit& u, int wr, int wc, int fr, int fq) const {
        const int row0 = u.pm * 256 + wr * 64 + fr, col0 = u.pn * 256 + wc * 32 + 8 * fq;
#pragma unroll
        EPI_LOOP_ROWS { const int row = row0 + ai * 128 + m * 16; const float rs = row_rstd(SS, row); bf16* rowp = O + (size_t)row * ldc + col0;
#pragma unroll
            for (int bj = 0; bj < 2; ++bj) { const f32x4 v0 = acc[ai][bj][m][0] * rs, v1 = acc[ai][bj][m][1] * rs;
                u32x4 w; w.x = cvt_pk_bf16(v0[0], v0[1]); w.y = cvt_pk_bf16(v0[2], v0[3]); w.z = cvt_pk_bf16(v1[0], v1[1]); w.w = cvt_pk_bf16(v1[2], v1[3]);
                *(u32x4*)(rowp + bj * 128) = w; } }
    }
};
struct EpiProj {
    static constexpr bool PERM = true;
    bf16* P; float* Sm; const float* SS;
    __device__ __forceinline__ void operator()(const f32x4 (&acc)[2][2][4][2], const Unit& u, int wr, int wc, int fr, int fq) const {
        const int row0 = u.pm * 256 + wr * 64 + fr;
        if (u.pn < NPROJ / 256) {
            const int col0 = u.pn * 256 + wc * 32 + 8 * fq;
#pragma unroll
            EPI_LOOP_ROWS { const int row = row0 + ai * 128 + m * 16; const float rs = row_rstd(SS, row); bf16* rowp = P + (size_t)row * NPROJ + col0;
#pragma unroll
                for (int bj = 0; bj < 2; ++bj) { const f32x4 v0 = acc[ai][bj][m][0] * rs, v1 = acc[ai][bj][m][1] * rs;
                    u32x4 w; w.x = cvt_pk_bf16(v0[0], v0[1]); w.y = cvt_pk_bf16(v0[2], v0[3]); w.z = cvt_pk_bf16(v1[0], v1[1]); w.w = cvt_pk_bf16(v1[2], v1[3]);
                    *(u32x4*)(rowp + bj * 128) = w; } }
        } else {
            const int col0 = wc * 32 + 8 * fq;
#pragma unroll
            EPI_LOOP_ROWS { const int row = row0 + ai * 128 + m * 16; const float rs = row_rstd(SS, row); float* rowp = Sm + (size_t)row * 256 + col0;
#pragma unroll
                for (int bj = 0; bj < 2; ++bj) { *(f32x4*)(rowp + bj * 128) = acc[ai][bj][m][0] * rs; *(f32x4*)(rowp + bj * 128 + 4) = acc[ai][bj][m][1] * rs; } }
        }
    }
};
struct EpiGate0 {
    static constexpr bool PERM = false;
    const bf16* P; float* M0;
    __device__ __forceinline__ void operator()(const f32x4 (&acc)[2][2][4][2], const Unit& u, int wr, int wc, int fr, int fq) const {
        const int row0 = u.pm * 256 + wr * 64 + fr, col0 = u.pn * 256 + wc * 32 + 4 * fq;
#pragma unroll
        EPI_LOOP_ROWS { const size_t r = (size_t)(row0 + ai * 128 + m * 16);
#pragma unroll
            for (int bj = 0; bj < 2; ++bj)
#pragma unroll
                for (int n = 0; n < 2; ++n) { const int c = col0 + bj * 128 + n * 16; const u32x2 gw = *(const u32x2*)(P + r * NPROJ + PGATE + c); const f32x4 a = acc[ai][bj][m][n];
                    f32x4 o; o[0] = a[0] * sigmoidf_(bf_lo(gw.x)); o[1] = a[1] * sigmoidf_(bf_hi(gw.x)); o[2] = a[2] * sigmoidf_(bf_lo(gw.y)); o[3] = a[3] * sigmoidf_(bf_hi(gw.y));
                    *(f32x4*)(M0 + r * DM + c) = o; } }
    }
};
struct EpiGate1 {
    static constexpr bool PERM = true;
    const bf16* P; const float* M0; bf16* O;
    __device__ __forceinline__ void operator()(const f32x4 (&acc)[2][2][4][2], const Unit& u, int wr, int wc, int fr, int fq) const {
        const int row0 = u.pm * 256 + wr * 64 + fr, col0 = u.pn * 256 + wc * 32 + 8 * fq;
#pragma unroll
        EPI_LOOP_ROWS { const size_t r = (size_t)(row0 + ai * 128 + m * 16);
#pragma unroll
            for (int bj = 0; bj < 2; ++bj) { const int c = col0 + bj * 128; const u32x4 gw = *(const u32x4*)(P + r * NPROJ + PGATE + DM + c); float gv[8]; unpack8(gw, gv);
                const f32x4 m0 = *(const f32x4*)(M0 + r * DM + c), m1 = *(const f32x4*)(M0 + r * DM + c + 4); const f32x4 a0 = acc[ai][bj][m][0], a1 = acc[ai][bj][m][1];
                float o[8];
#pragma unroll
                for (int j = 0; j < 4; ++j) { o[j] = m0[j] + a0[j] * sigmoidf_(gv[j]); o[4 + j] = m1[j] + a1[j] * sigmoidf_(gv[4 + j]); }
                *(u32x4*)(O + r * DM + c) = pack8(o); } }
    }
};
struct EpiResid {
    static constexpr bool PERM = false;
    float* X; bf16* H; float* SS;
    __device__ __forceinline__ void operator()(const f32x4 (&acc)[2][2][4][2], const Unit& u, int wr, int wc, int fr, int fq) const {
        const int row0 = u.pm * 256 + wr * 64 + fr, col0 = u.pn * 256 + wc * 32 + 4 * fq;
#pragma unroll
        EPI_LOOP_ROWS { const int row = row0 + ai * 128 + m * 16; float* rowp = X + (size_t)row * DM + col0; bf16* hp = H + (size_t)row * DM + col0; float ss = 0.f;
#pragma unroll
            for (int bj = 0; bj < 2; ++bj)
#pragma unroll
                for (int n = 0; n < 2; ++n) { f32x4* p = (f32x4*)(rowp + bj * 128 + n * 16); const f32x4 x = *p + acc[ai][bj][m][n]; *p = x;
                    ss += (x[0] * x[0] + x[1] * x[1]) + (x[2] * x[2] + x[3] * x[3]);
                    u32x2 w; w.x = cvt_pk_bf16(x[0], x[1]); w.y = cvt_pk_bf16(x[2], x[3]); *(u32x2*)(hp + bj * 128 + n * 16) = w; }
            ss += __shfl_xor(ss, 16); ss += __shfl_xor(ss, 32);
            if (fq == 0) atomicAdd(SS + row, ss); }
    }
};
struct EpiMemKV {
    static constexpr bool PERM = false;
    float* out; bf16* KP; bf16* VTP;
    __device__ __forceinline__ void operator()(const f32x4 (&acc)[2][2][4][2], const Unit& u, int wr, int wc, int fr, int fq) const {
        const int row0 = u.pm * 256 + wr * 64 + fr, colt = u.pn * 256, l = colt / 4096, kv = (colt / 2048) & 1, cbase = (colt & 2047) + wc * 32 + 4 * fq;
        float* dst = out + (kv ? O_PMV : O_PMK) + (size_t)l * NB * MTOK * DM;
#pragma unroll
        EPI_LOOP_ROWS { const int r = row0 + ai * 128 + m * 16, b = r >> 8, mt = r & 255;
#pragma unroll
            for (int bj = 0; bj < 2; ++bj)
#pragma unroll
                for (int n = 0; n < 2; ++n) { const int c = cbase + bj * 128 + n * 16; const f32x4 a = acc[ai][bj][m][n];
                    *(f32x4*)(dst + (size_t)r * DM + c) = a;
                    if (!kv) { u32x2 w; w.x = cvt_pk_bf16(a[0], a[1]); w.y = cvt_pk_bf16(a[2], a[3]); *(u32x2*)(KP + ((size_t)l * NB * MTOK + r) * DM + c) = w; }
                    else { bf16* vt = VTP + (((size_t)l * NB + b) * DM + c) * MTOK + mt;
#pragma unroll
                        for (int j = 0; j < 4; ++j) vt[(size_t)j * MTOK] = (bf16)f2bf(a[j]); } } }
    }
};

struct Args { const float* in[33]; float* out; unsigned char* ws; int ph_lo, ph_hi; };
#ifdef HOST_EMU
struct Ctx {
    LAS unsigned char* lds; int tid, lane, wave, G, bid;
    const Args* ap; float* out; unsigned char* ws;
    __device__ __forceinline__ const float* in(int i) const { return ap->in[i]; }
};
#else
#define CAS __attribute__((address_space(4)))
struct Ctx {
    LAS unsigned char* lds; int tid, lane, wave, G, bid;
    const CAS unsigned char* kp; float* out; unsigned char* ws;
    __device__ __forceinline__ const float* in(int i) const { return ((const float* const CAS*)kp)[i]; }
};
#endif
#ifdef HOST_EMU
#define SPIN_PAUSE() emu_yield()
#else
#define SPIN_PAUSE() __builtin_amdgcn_s_sleep(1)
#endif
#define WSP(type, off) ((type*)(C.ws + (off)))

template <class RowMap>
__device__ __forceinline__ void transpose_item(const float* W, int K, int N, bf16* WT, const float* gain, LAS float* scr, int item, int lane, RowMap rowmap) {
    const int nblk = (N + 31) / 32, kb = item / nblk, nb = item % nblk, k0 = 64 * kb, n0 = 32 * nb;
    float vv[32]; const int nn = n0 + (lane & 31); const bool nok = nn < N; const float* wp = W + (size_t)(k0 + (lane >> 5)) * N + (nok ? nn : 0);
#pragma unroll
    for (int i = 0; i < 32; ++i) vv[i] = nok ? wp[(size_t)(2 * i) * N] : 0.f;
    if (gain) {
#pragma unroll
        for (int i = 0; i < 32; ++i) vv[i] *= gain[k0 + 2 * i + (lane >> 5)]; }
#pragma unroll
    for (int i = 0; i < 32; ++i) scr[(2 * i + (lane >> 5)) * 33 + (lane & 31)] = vv[i];
    WAVE_LDS_SYNC();
    const int c = lane & 7;
#pragma unroll
    for (int j = 0; j < 4; ++j) { const int n = (lane >> 3) + 8 * j; const LAS float* s = scr + (8 * c) * 33 + n;
        if (n0 + n < N) { u32x4 o; o.x = cvt_pk_bf16(s[0 * 33], s[1 * 33]); o.y = cvt_pk_bf16(s[2 * 33], s[3 * 33]); o.z = cvt_pk_bf16(s[4 * 33], s[5 * 33]); o.w = cvt_pk_bf16(s[6 * 33], s[7 * 33]);
            *(u32x4*)(WT + (size_t)rowmap(n0 + n) * K + k0 + 8 * c) = o; } }
    WAVE_LDS_SYNC();
}
struct RowId { int off; __device__ __forceinline__ int operator()(int n) const { return off + n; } };
struct RowWin { __device__ __forceinline__ int operator()(int n) const {
    return n < 5120 ? n : n < 5152 ? NPROJ + (n - 5120) : n < 11296 ? n - 32 : n < 11312 ? NPROJ + 32 + (n - 11296) : n - 48; } };

__device__ __forceinline__ void phase_wconv(const Ctx& C, int l, int kvb = 0) {
    LAS float* scr = (LAS float*)(C.lds + C.wave * 16384);
    const int gw = C.bid * 8 + C.wave, NGW = C.G * 8;
    const int I_IN = (DM / 64) * ((IN_DIM + 31) / 32), I_SQ = (DM / 64) * (DM / 32), I_FI = (DM / 64) * (DFF2 / 32), I_FO = (DFF / 64) * (DM / 32);
    const int NIT = I_IN + 5 * I_SQ + I_FI + I_FO;
    const int NA = (kvb > 0 && kvb < C.G) ? (int)(((long)NIT * 8) / 25) : 0;
    const int itA = C.bid >= kvb ? (C.bid - kvb) * 8 + C.wave : NA, stA = (C.G - kvb) * 8;
    for (int pass = (NA > 0 ? 0 : 1); pass < 2; ++pass)
    for (int it = pass ? NA + gw : itA; it < (pass ? NIT : NA); it += (pass ? NGW : stA)) {
        int r = it;
        if (r < I_IN) { transpose_item(C.in(10) + (size_t)l * DM * IN_DIM, DM, IN_DIM, WSP(bf16, WS_WIN), C.in(9) + l * DM, scr, r, C.lane, RowWin{}); continue; } r -= I_IN;
        if (r < I_SQ) { transpose_item(C.in(20) + (size_t)(l * 2 + 0) * DM * DM, DM, DM, WSP(bf16, WS_WB0), (const float*)nullptr, scr, r, C.lane, RowId{0}); continue; } r -= I_SQ;
        if (r < I_SQ) { transpose_item(C.in(20) + (size_t)(l * 2 + 1) * DM * DM, DM, DM, WSP(bf16, WS_WB1), (const float*)nullptr, scr, r, C.lane, RowId{0}); continue; } r -= I_SQ;
        if (r < I_SQ) { transpose_item(C.in(21) + (size_t)l * DM * DM, DM, DM, WSP(bf16, WS_WOUT), (const float*)nullptr, scr, r, C.lane, RowId{0}); continue; } r -= I_SQ;
        if (r < I_SQ) { transpose_item(C.in(23) + (size_t)l * DM * DM, DM, DM, WSP(bf16, WS_WMQ), C.in(22) + l * DM, scr, r, C.lane, RowId{0}); continue; } r -= I_SQ;
        if (r < I_SQ) { transpose_item(C.in(26) + (size_t)l * DM * DM, DM, DM, WSP(bf16, WS_WMO), (const float*)nullptr, scr, r, C.lane, RowId{0}); continue; } r -= I_SQ;
        if (r < I_FI) { transpose_item(C.in(28) + (size_t)l * DM * DFF2, DM, DFF2, WSP(bf16, WS_WFI), C.in(27) + l * DM, scr, r, C.lane, RowId{0}); continue; } r -= I_FI;
        transpose_item(C.in(31) + (size_t)l * DFF * DM, DFF, DM, WSP(bf16, WS_WFO), (const float*)nullptr, scr, r, C.lane, RowId{0});
    }
    { u32x4* z = (u32x4*)(WSP(bf16, WS_WIN) + (size_t)(NPROJ + 48) * DM); const size_t n16 = (size_t)(NPROJ_PAD - NPROJ - 48) * DM * 2 / 16;
      for (size_t i = (size_t)C.bid * 512 + C.tid; i < n16; i += (size_t)C.G * 512) z[i] = zero16(); }
}
__device__ __forceinline__ void phase_prologue(const Ctx& C) {
    const size_t gt = (size_t)C.bid * 512 + C.tid, NT = (size_t)C.G * 512;
    { const f32x4* s = (const f32x4*)C.in(2); u32x2* d = WSP(u32x2, WS_MEMP); const size_t n = (size_t)NB * MTOK * DM / 4;
      for (size_t i = gt; i < n; i += NT) { const f32x4 v = s[i]; u32x2 w; w.x = cvt_pk_bf16(v[0], v[1]); w.y = cvt_pk_bf16(v[2], v[3]); d[i] = w; } }
    { const f32x4* s = (const f32x4*)C.in(7); u32x2* d = WSP(u32x2, WS_KS); const size_t n = (size_t)2 * SBT * MTOK * DM / 4;
      for (size_t i = gt; i < n; i += NT) { const f32x4 v = s[i]; u32x2 w; w.x = cvt_pk_bf16(v[0], v[1]); w.y = cvt_pk_bf16(v[2], v[3]); d[i] = w; } }
    LAS float* scr = (LAS float*)(C.lds + C.wave * 16384);
    const int gw = C.bid * 8 + C.wave, NGW = C.G * 8;
    const int I_V = (MTOK / 64) * (DM / 32), I_SQ = (DM / 64) * (DM / 32);
    const int NIT = 2 * SBT * I_V + 4 * I_SQ;
    for (int it = gw; it < NIT; it += NGW) {
        if (it < 2 * SBT * I_V) { const int lb = it / I_V, r = it % I_V;
            transpose_item(C.in(8) + (size_t)lb * MTOK * DM, MTOK, DM, WSP(bf16, WS_VTS) + (size_t)lb * DM * MTOK, (const float*)nullptr, scr, r, C.lane, RowId{0}); }
        else { const int q = (it - 2 * SBT * I_V) / I_SQ, r = (it - 2 * SBT * I_V) % I_SQ, l = q >> 1, kv = q & 1;
            transpose_item(C.in(kv ? 25 : 24) + (size_t)l * DM * DM, DM, DM, WSP(bf16, WS_WKV), (const float*)nullptr, scr, r, C.lane, RowId{q * DM}); }
    }
}
__device__ __forceinline__ void phase_xprep(const Ctx& C) {
    const int gw = C.bid * 8 + C.wave, NGW = C.G * 8;
    for (int row = gw; row < T; row += NGW) {
        const f32x4* xr = (row < TP ? (const f32x4*)C.in(0) + (size_t)row * (DM / 4) : (const f32x4*)C.in(1) + (size_t)(row - TP) * (DM / 4)) + C.lane; f32x4 v[8]; float s = 0.f;
#pragma unroll
        for (int j = 0; j < 8; ++j) { v[j] = xr[64 * j]; s += (v[j][0] * v[j][0] + v[j][1] * v[j][1]) + (v[j][2] * v[j][2] + v[j][3] * v[j][3]); }
        s = wave_sum(s); if (C.lane == 0) WSP(float, WS_SS)[row] = s;
        u32x2* o = WSP(u32x2, WS_H) + (size_t)row * (DM / 4) + C.lane; f32x4* xo = WSP(f32x4, WS_X) + (size_t)row * (DM / 4) + C.lane;
#pragma unroll
        for (int j = 0; j < 8; ++j) { u32x2 w; w.x = cvt_pk_bf16(v[j][0], v[j][1]); w.y = cvt_pk_bf16(v[j][2], v[j][3]); o[64 * j] = w; xo[64 * j] = v[j]; }
    }
}
__device__ __forceinline__ void phase_final(const Ctx& C) {
    const int gw = C.bid * 8 + C.wave, NGW = C.G * 8; const f32x4* gn = (const f32x4*)C.in(32) + C.lane;
    for (int row = gw; row < T; row += NGW) {
        const f32x4* xr = WSP(const f32x4, WS_X) + (size_t)row * (DM / 4) + C.lane; f32x4 v[8];
#pragma unroll
        for (int j = 0; j < 8; ++j) v[j] = xr[64 * j];
        const float rstd = row_rstd(WSP(const float, WS_SS) + (size_t)6 * T, row);
        f32x4* o = (f32x4*)(C.out + O_Y) + (size_t)row * (DM / 4) + C.lane;
#pragma unroll
        for (int j = 0; j < 8; ++j) o[64 * j] = v[j] * rstd * gn[64 * j];
    }
}
struct SeqInfo { int sample, b, t, L, row0; };
__device__ __forceinline__ SeqInfo seq_of_row(int row) { SeqInfo s; if (row < TP) { s.sample = 0; s.b = row / SEQ; s.t = row % SEQ; s.L = SEQ; s.row0 = s.b * SEQ; } else { const int r = row - TP; s.sample = 1; s.b = r / SSQ; s.t = r % SSQ; s.L = SSQ; s.row0 = TP + s.b * SSQ; } return s; }
__device__ __forceinline__ SeqInfo seq_of_idx(int sq) { SeqInfo s; if (sq < NB) { s.sample = 0; s.b = sq; s.L = SEQ; s.row0 = sq * SEQ; } else { s.sample = 1; s.b = sq - NB; s.L = SSQ; s.row0 = TP + s.b * SSQ; } s.t = 0; return s; }

__device__ __forceinline__ void phase_prep_conv(const Ctx& C, int l) {
    const size_t gt = (size_t)C.bid * 512 + C.tid, NT = (size_t)C.G * 512;
    const bf16* P = WSP(const bf16, WS_PROJ); const float* Sm = WSP(const float, WS_SMALL);
    const float* cw = C.in(11) + (size_t)l * 4 * XBCW; const float* cb = C.in(12) + (size_t)l * XBCW; const float* st = C.in(4) + (size_t)l * SBT * 3 * XBCW;
    for (size_t it = gt; it < (size_t)(T / 16) * (XBCW / 8); it += NT) {
        const int seg = (int)(it / (XBCW / 8)), c = (int)(it % (XBCW / 8)) * 8, row0 = seg * 16; const SeqInfo s = seq_of_row(row0);
        u32x4 raw[19];
#pragma unroll
        for (int i = 0; i < 16; ++i) raw[3 + i] = *(const u32x4*)(P + (size_t)(row0 + i) * NPROJ + PXBC + c);
        float w[4][8], bias[8];
#pragma unroll
        for (int i = 0; i < 4; ++i) { const f32x4 a = *(const f32x4*)(cw + i * XBCW + c), b = *(const f32x4*)(cw + i * XBCW + c + 4);
#pragma unroll
            for (int j = 0; j < 4; ++j) { w[i][j] = a[j]; w[i][4 + j] = b[j]; } }
        { const f32x4 a = *(const f32x4*)(cb + c), b = *(const f32x4*)(cb + c + 4);
#pragma unroll
          for (int j = 0; j < 4; ++j) { bias[j] = a[j]; bias[4 + j] = b[j]; } }
        float hist[3][8];
        if (s.t >= 3) {
#pragma unroll
            for (int i = 0; i < 3; ++i) { raw[i] = *(const u32x4*)(P + (size_t)(row0 - 3 + i) * NPROJ + PXBC + c); unpack8(raw[i], hist[i]); } }
        else if (s.sample) {
#pragma unroll
            for (int i = 0; i < 3; ++i) { const float* sp = st + ((size_t)s.b * 3 + i) * XBCW + c;
#pragma unroll
                for (int j = 0; j < 8; ++j) hist[i][j] = sp[j]; } }
        else {
#pragma unroll
            for (int i = 0; i < 3; ++i)
#pragma unroll
                for (int j = 0; j < 8; ++j) hist[i][j] = 0.f; }
#pragma unroll
        for (int i = 0; i < 16; ++i) { float cur[8], o[8]; unpack8(raw[3 + i], cur);
#pragma unroll
            for (int j = 0; j < 8; ++j) { o[j] = siluf_(bias[j] + hist[0][j] * w[0][j] + hist[1][j] * w[1][j] + hist[2][j] * w[2][j] + cur[j] * w[3][j]); hist[0][j] = hist[1][j]; hist[1][j] = hist[2][j]; hist[2][j] = cur[j]; }
            *(u32x4*)(WSP(bf16, WS_XBC) + (size_t)(row0 + i) * XBCW + c) = pack8(o); }
    }
    for (size_t it = gt; it < (size_t)NSEQ * 3 * XBCW; it += NT) {
        const int c = (int)(it % XBCW), j = (int)(it / XBCW) % 3, sq = (int)(it / (3 * XBCW)); const SeqInfo s = seq_of_idx(sq);
        const float v = bf2f(P[(size_t)(s.row0 + s.L - 3 + j) * NPROJ + PXBC + c]);
        float* dst = C.out + (s.sample ? O_SSSDC + ((size_t)l * SBT + s.b) * 3 * XBCW : O_PSSDC + ((size_t)l * NB + s.b) * 3 * XBCW);
        dst[j * XBCW + c] = v;
    }
    for (size_t it = gt; it < (size_t)T * 32; it += NT) { const int row = (int)(it >> 5), h = (int)(it & 31);
        WSP(float, WS_DT)[it] = softplusf_(Sm[(size_t)row * 256 + h] + C.in(13)[l * 32 + h]); }
}

typedef short bf16x4 __attribute__((ext_vector_type(4)));
#define MFMA32(a, b, c) __builtin_amdgcn_mfma_f32_16x16x32_bf16(a, b, c, 0, 0, 0)
#define MFMA16(a, b, c) __builtin_amdgcn_mfma_f32_16x16x16bf16_1k(a, b, c, 0, 0, 0)
__device__ __forceinline__ bf16x8 mk8(u32x2 lo, u32x2 hi) { u32x4 w; w.x = lo.x; w.y = lo.y; w.z = hi.x; w.w = hi.y; return __builtin_bit_cast(bf16x8, w); }
__device__ __forceinline__ bf16x8 pack_tiles(const f32x4 t0, const f32x4 t1) { u32x4 w; w.x = cvt_pk_bf16(t0[0], t0[1]); w.y = cvt_pk_bf16(t0[2], t0[3]); w.z = cvt_pk_bf16(t1[0], t1[1]); w.w = cvt_pk_bf16(t1[2], t1[3]); return __builtin_bit_cast(bf16x8, w); }
struct ChunkInfo { int row0, nvalid; };
__device__ __forceinline__ ChunkInfo ssd_chunk(int cs) { ChunkInfo c; if (cs < NCP) { c.row0 = 64 * cs; c.nvalid = 64; } else { c.row0 = TP + SSQ * (cs - NCP); c.nvalid = SSQ; } return c; }

__device__ __forceinline__ void gla_prep_task(const Ctx& C, int l, int ck, int h) {
    const int lane = C.lane, fr = lane & 15, fq = lane >> 4, k4 = 4 * lane;
    LAS bf16* Lq = (LAS bf16*)(C.lds + C.wave * 16384); LAS bf16* Lk = Lq + 16 * 256;
    const bf16* P = WSP(const bf16, WS_PROJ); const float* Sm = WSP(const float, WS_SMALL);
    f32x4 bc[16]; f32x4 run = (f32x4){0.f, 0.f, 0.f, 0.f};
    { const float* wa2 = C.in(17) + (size_t)l * 16 * 1024 + h * 256 + k4; f32x4 wv[16];
#pragma unroll
      for (int r = 0; r < 16; ++r) wv[r] = *(const f32x4*)(wa2 + r * 1024);
      const f32x4 bav = *(const f32x4*)(C.in(18) + (size_t)l * 1024 + h * 256 + k4);
#pragma unroll
      for (int i = 0; i < 16; ++i) { const float* ar = Sm + (size_t)(16 * ck + i) * 256 + 32; f32x4 a = bav;
#pragma unroll
          for (int r4 = 0; r4 < 4; ++r4) { const f32x4 av = *(const f32x4*)(ar + 4 * r4);
#pragma unroll
              for (int q = 0; q < 4; ++q) a = a + wv[4 * r4 + q] * av[q]; }
#pragma unroll
          for (int j = 0; j < 4; ++j) run[j] += logsigmoidf_(a[j]) * (1.0f / 16.0f);
          bc[i] = run; } }
    const f32x4 b15 = bc[15];
    unsigned ke[4][8];
#pragma unroll
    for (int i = 0; i < 16; ++i) { const size_t row = (size_t)(16 * ck + i);
        const u32x2 qw = *(const u32x2*)(P + row * NPROJ + PQ + h * 256 + k4), kw = *(const u32x2*)(P + row * NPROJ + PK + h * 256 + k4);
        const float qv[4] = {bf_lo(qw.x), bf_hi(qw.x), bf_lo(qw.y), bf_hi(qw.y)}, kv[4] = {bf_lo(kw.x), bf_hi(kw.x), bf_lo(kw.y), bf_hi(kw.y)};
        float qd[4], ki[4], kend[4];
#pragma unroll
        for (int j = 0; j < 4; ++j) { qd[j] = qv[j] * 0.0625f * __expf(bc[i][j]); ki[j] = kv[j] * __expf(-bc[i][j]); kend[j] = kv[j] * __expf(b15[j] - bc[i][j]); }
        u32x2 w; w.x = cvt_pk_bf16(qd[0], qd[1]); w.y = cvt_pk_bf16(qd[2], qd[3]);
        *(u32x2*)(WSP(bf16, WS_QD) + row * 1024 + h * 256 + k4) = w; *(LAS u32x2*)(Lq + i * 256 + k4) = w;
        u32x2 w2; w2.x = cvt_pk_bf16(ki[0], ki[1]); w2.y = cvt_pk_bf16(ki[2], ki[3]); *(LAS u32x2*)(Lk + i * 256 + k4) = w2;
#pragma unroll
        for (int j = 0; j < 4; ++j) { if (i & 1) ke[j][i >> 1] |= f2bf(kend[j]) << 16; else ke[j][i >> 1] = f2bf(kend[j]); } }
#pragma unroll
    for (int j = 0; j < 4; ++j) { u32x4* d = (u32x4*)(WSP(bf16, WS_KET) + ((size_t)ck * 1024 + h * 256 + k4 + j) * 16);
        d[0] = (u32x4){ke[j][0], ke[j][1], ke[j][2], ke[j][3]}; d[1] = (u32x4){ke[j][4], ke[j][5], ke[j][6], ke[j][7]}; }
    { f32x4 dv; dv[0] = __expf(b15[0]); dv[1] = __expf(b15[1]); dv[2] = __expf(b15[2]); dv[3] = __expf(b15[3]); *(f32x4*)(WSP(float, WS_DEC) + (size_t)ck * 1024 + h * 256 + k4) = dv; }
    WAVE_LDS_SYNC();
    f32x4 att = (f32x4){0.f, 0.f, 0.f, 0.f};
#pragma unroll
    for (int ks = 0; ks < 8; ++ks) { const bf16x8 a = *(const LAS bf16x8*)(Lq + fr * 256 + 32 * ks + 8 * fq), b = *(const LAS bf16x8*)(Lk + fr * 256 + 32 * ks + 8 * fq); att = MFMA32(a, b, att); }
#pragma unroll
    for (int r = 0; r < 4; ++r) { const int i = 4 * fq + r; WSP(bf16, WS_ATT)[(((size_t)ck * 4 + h) * 16 + i) * 16 + fr] = (bf16)(fr <= i ? f2bf(att[r]) : 0u); }
    WAVE_LDS_SYNC();
    unsigned vt[8][8];
#pragma unroll
    for (int i = 0; i < 16; ++i) { float vv[8]; unpack8(*(const u32x4*)(P + (size_t)(16 * ck + i) * NPROJ + PV + h * 512 + 8 * lane), vv);
#pragma unroll
        for (int j = 0; j < 8; ++j) { if (i & 1) vt[j][i >> 1] |= f2bf(vv[j]) << 16; else vt[j][i >> 1] = f2bf(vv[j]); } }
#pragma unroll
    for (int j = 0; j < 8; ++j) { u32x4* d = (u32x4*)(WSP(bf16, WS_VT16) + ((size_t)ck * DM + h * 512 + 8 * lane + j) * 16);
        d[0] = (u32x4){vt[j][0], vt[j][1], vt[j][2], vt[j][3]}; d[1] = (u32x4){vt[j][4], vt[j][5], vt[j][6], vt[j][7]}; }
}
__device__ __forceinline__ void ssd_prep_head(const Ctx& C, int l, int cs, int h) {
    const int lane = C.lane, fr = lane & 15, fq = lane >> 4, g = h >> 3; const ChunkInfo ci = ssd_chunk(cs);
    LAS float* La = (LAS float*)(C.lds + C.wave * 16384); LAS float* Ld = La + 64;
    const bf16* XB = WSP(const bf16, WS_XBC); const float* DT = WSP(const float, WS_DT);
    const bf16x8 z8 = zero8h();
    f32x4 cb[4][4];
#pragma unroll
    for (int mt = 0; mt < 4; ++mt)
#pragma unroll
        for (int nt = 0; nt < 4; ++nt) cb[mt][nt] = (f32x4){0.f, 0.f, 0.f, 0.f};
#pragma unroll
    for (int ks = 0; ks < 4; ++ks) { bf16x8 af[4], bfr[4];
#pragma unroll
        for (int t = 0; t < 4; ++t) { const int i = 16 * t + fr; const bool ok = i < ci.nvalid; const bf16* rp = XB + (size_t)(ci.row0 + (ok ? i : 0)) * XBCW + g * 128 + 32 * ks + 8 * fq;
            af[t] = ok ? *(const bf16x8*)(rp + 2560) : z8; bfr[t] = ok ? *(const bf16x8*)(rp + 2048) : z8; }
#pragma unroll
        for (int mt = 0; mt < 4; ++mt)
#pragma unroll
            for (int nt = 0; nt <= mt; ++nt) cb[mt][nt] = MFMA32(af[mt], bfr[nt], cb[mt][nt]); }
    const bool jok = lane < ci.nvalid; const size_t jrow = (size_t)(ci.row0 + (jok ? lane : 0));
    const float a = -__expf(C.in(14)[l * 32 + h]); const float dtj = jok ? DT[jrow * 32 + h] : 0.f;
    float ac = dtj * a;
#pragma unroll
    for (int d = 1; d < 64; d <<= 1) { const float t = __shfl(ac, (lane - d) & 63); if (lane >= d) ac += t; }
    const float a63 = __shfl(ac, 63), te = __expf(a63 - ac) * dtj;
    La[lane] = ac; Ld[lane] = dtj;
    WSP(float, WS_EA)[((size_t)cs * 32 + h) * 64 + lane] = __expf(ac);
    if (lane == 0) WSP(float, WS_DECS)[(size_t)cs * 32 + h] = __expf(a63);
    u32x4 xr[8];
#pragma unroll
    for (int p8 = 0; p8 < 8; ++p8) xr[p8] = jok ? *(const u32x4*)(XB + jrow * XBCW + h * 64 + 8 * p8) : zero16();
#pragma unroll
    for (int p8 = 0; p8 < 8; ++p8) { float xv[8]; unpack8(xr[p8], xv);
#pragma unroll
        for (int q = 0; q < 8; ++q) { const size_t o = ((size_t)cs * DM + h * 64 + 8 * p8 + q) * 64 + lane; WSP(bf16, WS_XT)[o] = (bf16)f2bf(xv[q]); WSP(bf16, WS_XTE)[o] = (bf16)f2bf(xv[q] * te); } }
    WAVE_LDS_SYNC();
#pragma unroll
    for (int mt = 0; mt < 4; ++mt)
#pragma unroll
        for (int nt = 0; nt < 4; ++nt) { const int j = 16 * nt + fr; const float aj = La[j], dj = Ld[j];
#pragma unroll
            for (int r = 0; r < 4; ++r) { const int i = 16 * mt + 4 * fq + r; const float w = (nt <= mt && j <= i) ? cb[mt][nt][r] * __expf(La[i] - aj) * dj : 0.f;
                WSP(bf16, WS_WCH)[(((size_t)cs * 32 + h) * 64 + i) * 64 + j] = (bf16)f2bf(w); } }
    WAVE_LDS_SYNC();
}
__device__ __forceinline__ void ssd_prep_group(const Ctx& C, int cs, int g) {
    const int lane = C.lane; const ChunkInfo ci = ssd_chunk(cs); const bf16* XB = WSP(const bf16, WS_XBC);
    const bool jok = lane < ci.nvalid; const size_t jrow = (size_t)(ci.row0 + (jok ? lane : 0));
#pragma unroll 4
    for (int n8 = 0; n8 < 16; ++n8) { float bv[8];
        if (jok) unpack8(*(const u32x4*)(XB + jrow * XBCW + 2048 + g * 128 + 8 * n8), bv); else {
#pragma unroll
            for (int q = 0; q < 8; ++q) bv[q] = 0.f; }
#pragma unroll
        for (int q = 0; q < 8; ++q) WSP(bf16, WS_BT)[((size_t)cs * 512 + g * 128 + 8 * n8 + q) * 64 + lane] = (bf16)f2bf(bv[q]); }
#pragma unroll 4
    for (int it = 0; it < 16; ++it) { const int idx = it * 64 + lane, i = idx >> 4, n8 = idx & 15; const bool ok = i < ci.nvalid;
        const u32x4 v = ok ? *(const u32x4*)(XB + (size_t)(ci.row0 + i) * XBCW + 2560 + g * 128 + 8 * n8) : zero16();
        *(u32x4*)(WSP(bf16, WS_CC) + ((size_t)cs * 64 + i) * 512 + g * 128 + 8 * n8) = v; }
}
__device__ __forceinline__ void phase_prep(const Ctx& C, int l) {
    const int gw = C.wave * C.G + C.bid, NGW = C.G * 8;
    for (int t = gw; t < NCK * 4; t += NGW) gla_prep_task(C, l, t >> 2, t & 3);
    phase_prep_conv(C, l);
}
__device__ __forceinline__ void phase_chunkprep(const Ctx& C, int l) {
    const int gw = C.wave * C.G + C.bid, NGW = C.G * 8;
    constexpr int NHT = NCS * 32, NGT = NCS * 4;
    for (int t = gw; t < NHT + NGT; t += NGW) { if (t < NHT) ssd_prep_head(C, l, t >> 5, t & 31); else ssd_prep_group(C, (t - NHT) >> 2, (t - NHT) & 3); }
}
constexpr int GLA_SLOT = 18432, GLA_RING = 3 * GLA_SLOT;
#ifdef PROBE_AMP
#define PT_NOW() ((unsigned)__builtin_amdgcn_s_memrealtime())
#define PT_WORDS(C) ((unsigned*)((C).ws + WS_CTL + 32768))
#define PT_MAX(C, slot, dt) do { if ((C).lane == 0) atomicMax(PT_WORDS(C) + (slot), (unsigned)(dt)); } while (0)
#define PT_SUM(C, slot, dt) do { if ((C).lane == 0) atomicAdd(PT_WORDS(C) + (slot), (unsigned)(dt)); } while (0)
#define PT_BLK_ADD(C, k, dt) do { if ((C).tid == 0) atomicAdd(PT_WORDS(C) + 256 + (k) * 256 + (C).bid, (unsigned)(dt)); } while (0)
#else
#define PT_NOW() 0u
#define PT_MAX(C, slot, dt) ((void)0)
#define PT_BLK_ADD(C, k, dt) ((void)0)
#define PT_SUM(C, slot, dt) ((void)0)
#endif
template <int MODE>
__device__ __forceinline__ void gla_scan_task(const Ctx& C, int l, int sq, int h, int vs, LAS unsigned char* ring, unsigned ebase = 0u) {
    constexpr bool ONE = MODE == 1, PAIR = MODE == 2; constexpr int SLOTB = PAIR ? GLP_SLOT : GLA_SLOT;
    const int pw = C.wave & 1; volatile LAS unsigned* gfl = (volatile LAS unsigned*)(C.lds + LDS_CTL_OFF) + 32; (void)pw; (void)gfl;
    int lane = C.lane; LAUNDER_V(lane);
    const SeqInfo s = seq_of_idx(sq); const int fr = lane & 15, fq = lane >> 4, vc0 = h * 512 + vs * 16;
    f32x4 S[16];
    const size_t st_off = ((((size_t)l * (s.sample ? SBT : NB) + s.b) * 4 + h) * 256) * 512 + vs * 16;
    if (s.sample) { const float* st = C.in(5) + st_off;
#pragma unroll
        for (int kt = 0; kt < 16; ++kt)
#pragma unroll
            for (int r = 0; r < 4; ++r) S[kt][r] = st[(size_t)(16 * kt + 4 * fq + r) * 512 + fr]; }
    else {
#pragma unroll
        for (int kt = 0; kt < 16; ++kt) S[kt] = (f32x4){0.f, 0.f, 0.f, 0.f}; }
    VMCNT(0);
    const int nch = s.L / 16, ck0 = s.row0 / 16;
    const unsigned char* wsb = C.ws;
#define LDW(type, off) (*(const type*)(wsb + (off)))
    unsigned gq = (unsigned)(WS_QD + ((size_t)(16 * ck0 + (lane & 15)) * 1024 + h * 256) * 2 + (lane >> 4) * 16);
    unsigned gk = (unsigned)(WS_KET + ((size_t)ck0 * 1024 + h * 256) * 32 + lane * 16);
    unsigned gd = (unsigned)(WS_DEC + ((size_t)ck0 * 1024 + h * 256) * 4 + lane * 16);
    unsigned ga = lane < 32 ? (unsigned)(WS_ATT + (((size_t)ck0 * 4 + h) * 256) * 2 + lane * 16) : (unsigned)(WS_VT16 + (((size_t)ck0 * DM + vc0) * 16) * 2 + (lane - 32) * 16);
    const unsigned sa = lane < 32 ? 2048u : (unsigned)(DM * 16 * 2);
    unsigned gm = pw ? gk : gq; const unsigned mstr = pw ? 1024u : 64u, moff = pw ? 8192u : 0u, madv = pw ? (unsigned)(1024 * 32) : (unsigned)(16 * 2048), poff = PAIR ? 1024u * pw : 0u;
    (void)gm; (void)mstr; (void)moff; (void)madv;
#define GLA_PSYNC(val) do { const unsigned v_ = (val); if (lane == 0) gfl[pw] = v_; while ((int)(gfl[pw ^ 1] - v_) < 0) SPIN_PAUSE(); asm volatile("" ::: "memory"); } while (0)
#define GLA_DMA(slot) do { LAS unsigned char* sb_ = ring + (slot) * SLOTB; LAUNDER_V(gd); LAUNDER_V(ga);     \
        if constexpr (PAIR) { LAUNDER_V(gm); \
            _Pragma("unroll") for (int i = 0; i < 8; ++i) __builtin_amdgcn_global_load_lds((const unsigned*)(wsb + gm + i * mstr), (LAS unsigned*)(sb_ + moff + i * 1024), 16, 0, 0); } \
        else { LAUNDER_V(gq); LAUNDER_V(gk); \
            _Pragma("unroll") for (int i = 0; i < 8; ++i) { \
                __builtin_amdgcn_global_load_lds((const unsigned*)(wsb + gq + i * 64), (LAS unsigned*)(sb_ + i * 1024), 16, 0, 0); \
                __builtin_amdgcn_global_load_lds((const unsigned*)(wsb + gk + i * 1024), (LAS unsigned*)(sb_ + 8192 + i * 1024), 16, 0, 0); } } \
        __builtin_amdgcn_global_load_lds((const unsigned*)(wsb + gd), (LAS unsigned*)(sb_ + 16384), 16, 0, 0); \
        __builtin_amdgcn_global_load_lds((const unsigned*)(wsb + ga), (LAS unsigned*)(sb_ + 17408 + poff), 16, 0, 0); } while (0)
#define GLA_ADV(on) do { const unsigned a_ = (on) ? 1u : 0u; if constexpr (PAIR) gm += a_ * madv; else { gq += a_ * (16 * 2048); gk += a_ * (1024 * 32); } gd += a_ * 4096; ga += a_ * sa; } while (0)
    GLA_DMA(0); if constexpr (!ONE) { GLA_ADV(1 < nch); GLA_DMA(1); GLA_ADV(2 < nch); }
    const int fh = fq & 1; const bool alo = fq < 2;
    const unsigned rq = (unsigned)(fr * 16 + 8 * fh + 256 * (fq >> 1));
    const unsigned rk = (unsigned)(8192 + fr * 32 + 16 * fh);
    const unsigned rat = (unsigned)(17408 + fr * 32 + 16 * fh) + poff, rv = rat + 512, rd = (unsigned)(16384 + 16 * fq);
    unsigned yo = (unsigned)(WS_YGR + ((size_t)(16 * ck0 + 4 * fq) * DM + vc0 + fr) * 4);
#define GLA_RD(G, D, K) _Pragma("unroll") for (int kt = 0; kt < 4; ++kt) { D[kt] = *(const LAS f32x4*)(sb + rd + 64 * (4 * (G) + kt)); K[kt] = *(const LAS bf16x8*)(sb + rk + 512 * (4 * (G) + kt)); }
#define GLA_UP(G, D, K) _Pragma("unroll") for (int kt = 0; kt < 4; ++kt) S[4 * (G) + kt] = MFMA32(K[kt], v0, S[4 * (G) + kt] * D[kt]);
#define GLA_DMA_QK(slot, P) do { LAS unsigned char* sb_ = ring + (slot) * SLOTB; \
        if constexpr (PAIR) { LAUNDER_V(gm); \
            _Pragma("unroll") for (int i = 2 * (P); i < 2 * (P) + 2; ++i) __builtin_amdgcn_global_load_lds((const unsigned*)(wsb + gm + i * mstr), (LAS unsigned*)(sb_ + moff + i * 1024), 16, 0, 0); } \
        else { LAUNDER_V(gq); LAUNDER_V(gk); \
            _Pragma("unroll") for (int i = 2 * (P); i < 2 * (P) + 2; ++i) { \
                __builtin_amdgcn_global_load_lds((const unsigned*)(wsb + gq + i * 64), (LAS unsigned*)(sb_ + i * 1024), 16, 0, 0); \
                __builtin_amdgcn_global_load_lds((const unsigned*)(wsb + gk + i * 1024), (LAS unsigned*)(sb_ + 8192 + i * 1024), 16, 0, 0); } } } while (0)
#define GLA_DMA_DA(slot) do { LAS unsigned char* sb_ = ring + (slot) * SLOTB; LAUNDER_V(gd); LAUNDER_V(ga); \
        __builtin_amdgcn_global_load_lds((const unsigned*)(wsb + gd), (LAS unsigned*)(sb_ + 16384), 16, 0, 0); \
        __builtin_amdgcn_global_load_lds((const unsigned*)(wsb + ga), (LAS unsigned*)(sb_ + 17408 + poff), 16, 0, 0); } while (0)
#ifdef PROBE_AMP
    unsigned ptw = 0;
#define PTW0 const unsigned w0_ = PT_NOW()
#define PTW1 ptw += PT_NOW() - w0_
#else
#define PTW0 ((void)0)
#define PTW1 ((void)0)
#endif
#define GLA_ITER(SL) do { \
        PTW0; if constexpr (ONE) VMCNT(0); else if constexpr (PAIR) { if (c == 0) VMCNT(10); else VMCNT(14); GLA_PSYNC(ebase + (unsigned)c + 1u); } else { if (c == 0) VMCNT(18); else VMCNT(22); } PTW1;               \
        __builtin_amdgcn_sched_barrier(0); \
        if constexpr (!ONE) GLA_DMA_QK(((SL) + 2) % 3, 0); \
        __builtin_amdgcn_sched_barrier(0); \
        const LAS unsigned char* sb = ring + (SL) * SLOTB; \
        u32x2 qa[8], qb[8]; f32x4 dA[4], dB[4]; bf16x8 kA[4], kB[4]; \
        _Pragma("unroll") for (int ks = 0; ks < 8; ++ks) { qa[ks] = *(const LAS u32x2*)(sb + rq + 1024 * ks); qb[ks] = *(const LAS u32x2*)(sb + rq + 1024 * ks + 512); } \
        const bf16x8 at = *(const LAS bf16x8*)(sb + rat); bf16x8 v0 = *(const LAS bf16x8*)(sb + rv); \
        GLA_RD(0, dA, kA) \
        __builtin_amdgcn_sched_barrier(0); \
        if (!alo) v0 = zero8h(); \
        f32x4 o0 = (f32x4){0.f, 0.f, 0.f, 0.f}; \
        _Pragma("unroll") for (int ks = 0; ks < 8; ++ks) o0 = MFMA32(mk8(qa[ks], qb[ks]), pack_tiles(S[2 * ks], S[2 * ks + 1]), o0); \
        o0 = MFMA32(at, v0, o0); \
        __builtin_amdgcn_sched_barrier(0); \
        GLA_RD(1, dB, kB) \
        if constexpr (!ONE) GLA_DMA_QK(((SL) + 2) % 3, 1); \
        _Pragma("unroll") for (int r = 0; r < 4; ++r) *(float*)(C.ws + yo + (unsigned)(r * DM * 4)) = o0[r]; \
        yo += 16 * DM * 4; \
        __builtin_amdgcn_sched_barrier(0); \
        GLA_UP(0, dA, kA) \
        __builtin_amdgcn_sched_barrier(0); \
        GLA_RD(2, dA, kA) \
        if constexpr (!ONE) GLA_DMA_QK(((SL) + 2) % 3, 2); \
        __builtin_amdgcn_sched_barrier(0); \
        GLA_UP(1, dB, kB) \
        __builtin_amdgcn_sched_barrier(0); \
        GLA_RD(3, dB, kB) \
        if constexpr (!ONE) GLA_DMA_QK(((SL) + 2) % 3, 3); \
        __builtin_amdgcn_sched_barrier(0); \
        GLA_UP(2, dA, kA) \
        __builtin_amdgcn_sched_barrier(0); \
        if constexpr (!ONE) { GLA_DMA_DA(((SL) + 2) % 3); GLA_ADV(c + 3 < nch); } \
        __builtin_amdgcn_sched_barrier(0); \
        GLA_UP(3, dB, kB) \
        ++c; } while (0)
    if constexpr (ONE) { int c = 0; GLA_ITER(0); (void)c; }
    else for (int c = 0; c < nch;) { GLA_ITER(0); if (c >= nch) break; GLA_ITER(1); if (c >= nch) break; GLA_ITER(2); }
#undef GLA_ITER
#ifdef PROBE_AMP
    if (nch > 64) PT_SUM(C, 10 + l, ptw);
#endif
#undef GLA_DMA_QK
#undef GLA_DMA_DA
    VMCNT(0);
    if constexpr (PAIR) GLA_PSYNC(ebase + (unsigned)nch + 1u);
#undef GLA_PSYNC
#undef GLA_DMA
#undef GLA_ADV
    int lane2 = C.lane; LAUNDER_V(lane2);
    float* dst = C.out + (s.sample ? O_SGLA : O_PGLA) + st_off + (size_t)(4 * (lane2 >> 4)) * 512 + (lane2 & 15);
#pragma unroll
    for (int kt = 0; kt < 16; ++kt)
#pragma unroll
        for (int r = 0; r < 4; ++r) dst[(size_t)(16 * kt + r) * 512] = S[kt][r];
}
__device__ __forceinline__ void ssd_scan_task(const Ctx& C, int l, int sq, int h, int ph) {
    const SeqInfo s = seq_of_idx(sq); const int lane = C.lane, fr = lane & 15, fq = lane >> 4, g = h >> 3, ch0 = h * 64 + ph * 32;
    f32x4 H[8][2];
    const size_t st_off = (((size_t)l * (s.sample ? SBT : NB) + s.b) * 32 + h) * 64 * 128;
    if (s.sample) { const float* st = C.in(3) + st_off;
#pragma unroll
        for (int nt = 0; nt < 8; ++nt)
#pragma unroll
            for (int pt = 0; pt < 2; ++pt) H[nt][pt] = *(const f32x4*)(st + (size_t)(ph * 32 + 16 * pt + fr) * 128 + 16 * nt + 4 * fq); }
    else {
#pragma unroll
        for (int nt = 0; nt < 8; ++nt) { H[nt][0] = (f32x4){0.f, 0.f, 0.f, 0.f}; H[nt][1] = (f32x4){0.f, 0.f, 0.f, 0.f}; } }
    const float Dh = C.in(15)[l * 32 + h];
    const int nch = s.sample ? 1 : SEQ / 64, cs0 = s.sample ? NCP + s.b : s.row0 / 64, nvalid = s.sample ? SSQ : 64;
    const unsigned char* wsb = C.ws;
    unsigned co = (unsigned)(WS_CC + (((size_t)cs0 * 64 + fr) * 512 + g * 128 + 4 * fq) * 2);
    unsigned eo = (unsigned)(WS_EA + (((size_t)cs0 * 32 + h) * 64 + fr) * 4);
    unsigned wo = (unsigned)(WS_WCH + ((((size_t)cs0 * 32 + h) * 64 + fr) * 64 + 8 * fq) * 2);
    unsigned xo = (unsigned)(WS_XT + (((size_t)cs0 * DM + ch0 + fr) * 64) * 2);
    unsigned xeo = (unsigned)(WS_XTE + (((size_t)cs0 * DM + ch0 + fr) * 64 + 8 * fq) * 2);
    unsigned bo = (unsigned)(WS_BT + (((size_t)cs0 * 512 + g * 128 + fr) * 64 + 8 * fq) * 2);
    unsigned deo = (unsigned)(WS_DECS + ((size_t)cs0 * 32 + h) * 4);
    unsigned yo = (unsigned)(WS_YSR + ((size_t)(s.row0 + fr) * DM + ch0 + 4 * fq) * 4);
    unsigned xbo = (unsigned)(WS_XBC + ((size_t)(s.row0 + fr) * XBCW + ch0 + 4 * fq) * 2);
#define SCHED_FENCE() __builtin_amdgcn_sched_barrier(0)
    for (int c = 0; c < nch; ++c) {
        u32x2 ca[4][4], cb2[4][4]; float ea[4];
#pragma unroll
        for (int mt = 0; mt < 4; ++mt) { ea[mt] = LDW(float, eo + 64 * mt);
#pragma unroll
            for (int ks = 0; ks < 4; ++ks) { ca[mt][ks] = LDW(u32x2, co + mt * 16384 + 64 * ks); cb2[mt][ks] = LDW(u32x2, co + mt * 16384 + 64 * ks + 32); } }
        f32x4 y[4][2];
#pragma unroll
        for (int mt = 0; mt < 4; ++mt) { y[mt][0] = (f32x4){0.f, 0.f, 0.f, 0.f}; y[mt][1] = (f32x4){0.f, 0.f, 0.f, 0.f}; }
        SCHED_FENCE();
#pragma unroll
        for (int ks = 0; ks < 2; ++ks) { const bf16x8 b0 = pack_tiles(H[2 * ks][0], H[2 * ks + 1][0]), b1 = pack_tiles(H[2 * ks][1], H[2 * ks + 1][1]);
#pragma unroll
            for (int mt = 0; mt < 4; ++mt) { const bf16x8 a = mk8(ca[mt][ks], cb2[mt][ks]); y[mt][0] = MFMA32(b0, a, y[mt][0]); y[mt][1] = MFMA32(b1, a, y[mt][1]); } }
        SCHED_FENCE();
        bf16x8 wf[6], xf[2][2]; u32x2 xd[4][2];
#pragma unroll
        for (int mt = 0; mt < 4; ++mt) wf[mt] = LDW(bf16x8, wo + mt * 2048);
        wf[4] = LDW(bf16x8, wo + 2 * 2048 + 64); wf[5] = LDW(bf16x8, wo + 3 * 2048 + 64);
#pragma unroll
        for (int pt = 0; pt < 2; ++pt) { xf[0][pt] = LDW(bf16x8, xo + pt * 2048 + 16 * fq); xf[1][pt] = LDW(bf16x8, xo + pt * 2048 + 64 + 16 * fq);
#pragma unroll
            for (int mt = 0; mt < 4; ++mt) xd[mt][pt] = LDW(u32x2, xbo + mt * (16 * XBCW * 2) + 32 * pt); }
        SCHED_FENCE();
#pragma unroll
        for (int ks = 2; ks < 4; ++ks) { const bf16x8 b0 = pack_tiles(H[2 * ks][0], H[2 * ks + 1][0]), b1 = pack_tiles(H[2 * ks][1], H[2 * ks + 1][1]);
#pragma unroll
            for (int mt = 0; mt < 4; ++mt) { const bf16x8 a = mk8(ca[mt][ks], cb2[mt][ks]); y[mt][0] = MFMA32(b0, a, y[mt][0]); y[mt][1] = MFMA32(b1, a, y[mt][1]); } }
#pragma unroll
        for (int mt = 0; mt < 4; ++mt) { y[mt][0] = y[mt][0] * ea[mt]; y[mt][1] = y[mt][1] * ea[mt]; }
        SCHED_FENCE();
        bf16x8 bt0[8], bt1[8], xe[2][2]; const float dec = LDW(float, deo);
#pragma unroll
        for (int nt = 0; nt < 8; ++nt) bt0[nt] = LDW(bf16x8, bo + nt * 2048);
        xe[0][0] = LDW(bf16x8, xeo); xe[0][1] = LDW(bf16x8, xeo + 2048);
        SCHED_FENCE();
#pragma unroll
        for (int mt = 0; mt < 4; ++mt) { y[mt][0] = MFMA32(xf[0][0], wf[mt], y[mt][0]); y[mt][1] = MFMA32(xf[0][1], wf[mt], y[mt][1]); }
        y[2][0] = MFMA32(xf[1][0], wf[4], y[2][0]); y[2][1] = MFMA32(xf[1][1], wf[4], y[2][1]); y[3][0] = MFMA32(xf[1][0], wf[5], y[3][0]); y[3][1] = MFMA32(xf[1][1], wf[5], y[3][1]);
#pragma unroll
        for (int mt = 0; mt < 4; ++mt)
#pragma unroll
            for (int pt = 0; pt < 2; ++pt) { const f32x4 xv = (f32x4){bf_lo(xd[mt][pt].x), bf_hi(xd[mt][pt].x), bf_lo(xd[mt][pt].y), bf_hi(xd[mt][pt].y)};
                if (16 * mt + fr < nvalid) *(f32x4*)(C.ws + yo + (unsigned)((16 * mt * DM + 16 * pt) * 4)) = y[mt][pt] + Dh * xv; }
        SCHED_FENCE();
#pragma unroll
        for (int nt = 0; nt < 8; ++nt) bt1[nt] = LDW(bf16x8, bo + nt * 2048 + 64);
        xe[1][0] = LDW(bf16x8, xeo + 64); xe[1][1] = LDW(bf16x8, xeo + 2048 + 64);
        SCHED_FENCE();
#pragma unroll
        for (int nt = 0; nt < 8; ++nt) { H[nt][0] = MFMA32(bt0[nt], xe[0][0], H[nt][0] * dec); H[nt][1] = MFMA32(bt0[nt], xe[0][1], H[nt][1] * dec); }
#pragma unroll
        for (int nt = 0; nt < 8; ++nt) { H[nt][0] = MFMA32(bt1[nt], xe[1][0], H[nt][0]); H[nt][1] = MFMA32(bt1[nt], xe[1][1], H[nt][1]); }
        co += 64 * 512 * 2; eo += 32 * 64 * 4; wo += 32 * 64 * 64 * 2; xo += DM * 64 * 2; xeo += DM * 64 * 2; bo += 512 * 64 * 2; deo += 32 * 4; yo += 64 * DM * 4; xbo += 64 * XBCW * 2;
    }
    float* dst = C.out + (s.sample ? O_SSSD : O_PSSD) + st_off;
#pragma unroll
    for (int nt = 0; nt < 8; ++nt)
#pragma unroll
        for (int pt = 0; pt < 2; ++pt) *(f32x4*)(dst + (size_t)(ph * 32 + 16 * pt + fr) * 128 + 16 * nt + 4 * fq) = H[nt][pt];
}
__device__ __forceinline__ void phase_scan(const Ctx& C0, int l) {
    constexpr int NGP = NB * 4 * 32, NGS = SBT * 4 * 32, NSP = NB * 32 * 2, NSS = SBT * 32 * 2;
    static_assert(2 * GLA_RING <= 131072, "GLA rings fit the phase scratch");
    const Ctx& C = C0;
#ifdef PROBE_SERIAL
    volatile LAS unsigned* sfl = (volatile LAS unsigned*)(C.lds + LDS_CTL_OFF) + 20;
    __syncthreads(); if (C.tid < 2) sfl[C.tid] = 0u; __syncthreads();
    if (C.wave >= 2) { while (sfl[0] == 0u || sfl[1] == 0u) __builtin_amdgcn_s_sleep(32); }
#endif
    { volatile LAS unsigned* gfl = (volatile LAS unsigned*)(C.lds + LDS_CTL_OFF) + 32; __syncthreads(); if (C.tid < 2) gfl[C.tid] = 0u; __syncthreads(); }
    const unsigned pt0 = PT_NOW(); (void)pt0;
    static_assert(2 * GLA_RING + GLA_SLOT <= 131072 && SSQ == 16, "one more slot above the two rings; sample sequences are one chunk");
    if (C.wave < 2) {
        unsigned ebase = 0u;
        for (int pi = C.bid; pi < NGP / 2; pi += C.G) {
            const unsigned pt1 = PT_NOW(); (void)pt1;
            int st, vp;
            if constexpr (NGP == 512) { st = (pi & 7) * 2 + (pi >> 7); vp = (pi >> 3) & 15; }
            else { st = pi / 16; vp = pi % 16; }
            gla_scan_task<2>(C, l, st >> 2, st & 3, 2 * vp + C.wave, C.lds, ebase);
            ebase += (unsigned)(SEQ / 16 + 2);
            { const unsigned dt_ = PT_NOW() - pt1; PT_MAX(C, 6 + l, dt_); PT_SUM(C, 8 + l, dt_); } }
        PT_MAX(C, 0 + l, PT_NOW() - pt0);
#ifdef PROBE_SERIAL
        if (C.lane == 0) sfl[C.wave] = 1u;
#endif
    } else if (C.wave == 7) {
        LAS unsigned char* slot = C.lds + 2 * GLA_RING;
        for (int u = C.bid; u < NGS; u += C.G) gla_scan_task<1>(C, l, NB + u / 128, (u % 128) / 32, u % 32, slot);
    }
    if (C.wave >= 2) {
        for (int t = (C.wave - 2) * C.G + C.bid; t < NSP + NSS; t += 6 * C.G) {
            if (t < NSP) {
                if constexpr (NSP == 256) {
                    const int st = (t & 7) * 2 + (t >> 7), wi = (t >> 3) & 15;
                    ssd_scan_task(C, l, st >> 2, (st & 3) * 8 + (wi >> 1), wi & 1); }
                else ssd_scan_task(C, l, t / 64, (t % 64) / 2, t % 2); }
            else { const int r = t - NSP; ssd_scan_task(C, l, NB + r / 64, (r % 64) / 2, r % 2); } }
        PT_MAX(C, (C.wave == 2 ? 2 : 4) + l, PT_NOW() - pt0);
    }
}
__device__ __forceinline__ void phase_ynorm(const Ctx& C, int l) {
    const int gw = C.bid * 8 + C.wave, NGW = C.G * 8; const bf16* P = WSP(const bf16, WS_PROJ);
    const float* sn = C.in(16) + (size_t)l * DM; const float* gn = C.in(19) + (size_t)l * 512;
    for (int row = gw; row < T; row += NGW) {
#pragma unroll
        for (int gi = 0; gi < 4; ++gi) { const int c = gi * 512 + C.lane * 8;
            const f32x4 y0 = *(const f32x4*)(WSP(const float, WS_YSR) + (size_t)row * DM + c), y1 = *(const f32x4*)(WSP(const float, WS_YSR) + (size_t)row * DM + c + 4);
            float zv[8]; unpack8(*(const u32x4*)(P + (size_t)row * NPROJ + PZ + c), zv); float v[8]; float ss = 0.f;
#pragma unroll
            for (int j = 0; j < 8; ++j) { const float y = j < 4 ? y0[j] : y1[j - 4]; v[j] = y * siluf_(zv[j]); ss += v[j] * v[j]; }
            const float rstd = 1.0f / sqrtf(wave_sum(ss) * (1.0f / 512.0f) + EPSF);
#pragma unroll
            for (int j = 0; j < 8; ++j) v[j] = v[j] * rstd * sn[c + j];
            *(u32x4*)(WSP(bf16, WS_YS) + (size_t)row * DM + c) = pack8(v); }
#pragma unroll
        for (int hh = 0; hh < 4; ++hh) { const int c = hh * 512 + C.lane * 8;
            const f32x4 y0 = *(const f32x4*)(WSP(const float, WS_YGR) + (size_t)row * DM + c), y1 = *(const f32x4*)(WSP(const float, WS_YGR) + (size_t)row * DM + c + 4);
            float gv[8]; unpack8(*(const u32x4*)(P + (size_t)row * NPROJ + PG + c), gv); float v[8]; float ss = 0.f;
#pragma unroll
            for (int j = 0; j < 8; ++j) { v[j] = j < 4 ? y0[j] : y1[j - 4]; ss += v[j] * v[j]; }
            const float rstd = 1.0f / sqrtf(wave_sum(ss) * (1.0f / 512.0f) + EPSF);
#pragma unroll
            for (int j = 0; j < 8; ++j) v[j] = v[j] * rstd * gn[C.lane * 8 + j] * siluf_(gv[j]);
            *(u32x4*)(WSP(bf16, WS_YG) + (size_t)row * DM + c) = pack8(v); }
    }
}
__device__ __forceinline__ void phase_attn(const Ctx& C, int l) {
    constexpr int QT = SEQ / 128, NU_P = NB * 4 * QT, NU = NU_P + SBT * 4;
    constexpr int KROW = 1040, VROW = 528, BUFB = 16896;
    const int tid = C.tid, lane = C.lane, w = C.wave, fr = lane & 15, fq = lane >> 4;
    LAS unsigned char* KV = C.lds;
    constexpr int BUFP = 2 * BUFB;
    static_assert(2 * BUFP + 8 * 8448 <= LDS_CTL_OFF, "attention LDS");
    LAS bf16* Pl = (LAS bf16*)(C.lds + 2 * BUFP + w * 8448);
    const int krow = tid >> 6, kc = tid & 63, vrow = tid >> 5, vc = tid & 31;
    const unsigned char* wsb = C.ws;
#define LDG(type, off) (*(const type*)(wsb + (off)))
    for (int u = C.bid; u < NU; u += C.G) {
        int row0, h, nvw; unsigned kbo, vbo;
        if (u < NU_P) { const int b = u / (4 * QT), r = u % (4 * QT); h = r / QT; row0 = b * SEQ + (r % QT) * 128; nvw = 8;
            kbo = (unsigned)(WS_KP + (((size_t)l * NB + b) * MTOK * DM + h * 512) * 2); vbo = (unsigned)(WS_VTP + ((((size_t)l * NB + b) * DM + h * 512) * MTOK) * 2); }
        else { const int r = u - NU_P, b = r / 4; h = r % 4; row0 = TP + b * SSQ; nvw = 1;
            kbo = (unsigned)(WS_KS + (((size_t)l * SBT + b) * MTOK * DM + h * 512) * 2); vbo = (unsigned)(WS_VTS + ((((size_t)l * SBT + b) * DM + h * 512) * MTOK) * 2); }
        const bool act = w < nvw; const int qrow = row0 + 16 * w;
        const unsigned kld = kbo + (unsigned)((krow * DM + kc * 8) * 2), vld = vbo + (unsigned)((vrow * MTOK + vc * 8) * 2);
        const unsigned qo = (unsigned)(WS_YS + ((size_t)(qrow + fr) * DM + h * 512 + 8 * fq) * 2), oo = (unsigned)(WS_YG + ((size_t)(qrow + 4 * fq) * DM + h * 512 + fr) * 2);
        __syncthreads();
        u32x4 st0 = LDG(u32x4, kld), st1 = LDG(u32x4, kld + 8 * DM * 2), st2 = LDG(u32x4, kld + 16 * DM * 2), st3 = LDG(u32x4, kld + 24 * DM * 2);
        bf16x8 qf[16];
        if (act) {
#pragma unroll
            for (int ks = 0; ks < 16; ++ks) qf[ks] = LDG(bf16x8, qo + 64 * ks); }
        else {
#pragma unroll
            for (int ks = 0; ks < 16; ++ks) qf[ks] = zero8h(); }
        *(LAS u32x4*)(KV + krow * KROW + kc * 16) = st0; *(LAS u32x4*)(KV + (krow + 8) * KROW + kc * 16) = st1;
        *(LAS u32x4*)(KV + BUFB + krow * KROW + kc * 16) = st2; *(LAS u32x4*)(KV + BUFB + (krow + 8) * KROW + kc * 16) = st3;
        __syncthreads();
        f32x4 sacc[16];
#pragma unroll
        for (int kp = 0; kp < 8; ++kp) {
            if (kp < 7) { const unsigned o_ = kld + (kp + 1) * (32 * DM * 2); st0 = LDG(u32x4, o_); st1 = LDG(u32x4, o_ + 8 * DM * 2); st2 = LDG(u32x4, o_ + 16 * DM * 2); st3 = LDG(u32x4, o_ + 24 * DM * 2); }
            else { st0 = LDG(u32x4, vld); st1 = LDG(u32x4, vld + 16 * MTOK * 2); st2 = LDG(u32x4, vld + 32 * MTOK * 2); st3 = LDG(u32x4, vld + 48 * MTOK * 2); }
#pragma unroll
            for (int t = 0; t < 2; ++t) { f32x4 a = (f32x4){0.f, 0.f, 0.f, 0.f};
                if (act) {
#pragma unroll
                    for (int ks = 0; ks < 16; ++ks) { const bf16x8 kf = *(const LAS bf16x8*)(KV + (kp & 1) * BUFP + t * BUFB + fr * KROW + (32 * ks + 8 * fq) * 2); a = MFMA32(qf[ks], kf, a); } }
                sacc[2 * kp + t] = a; }
            if (kp < 7) { LAS unsigned char* nb = KV + ((kp + 1) & 1) * BUFP;
                *(LAS u32x4*)(nb + krow * KROW + kc * 16) = st0; *(LAS u32x4*)(nb + (krow + 8) * KROW + kc * 16) = st1;
                *(LAS u32x4*)(nb + BUFB + krow * KROW + kc * 16) = st2; *(LAS u32x4*)(nb + BUFB + (krow + 8) * KROW + kc * 16) = st3; }
            else { *(LAS u32x4*)(KV + vrow * VROW + vc * 16) = st0; *(LAS u32x4*)(KV + (vrow + 16) * VROW + vc * 16) = st1;
                *(LAS u32x4*)(KV + BUFB + vrow * VROW + vc * 16) = st2; *(LAS u32x4*)(KV + BUFB + (vrow + 16) * VROW + vc * 16) = st3; }
            __syncthreads();
            __builtin_amdgcn_sched_barrier(0);
        }
        bf16x8 pf[8];
        if (act) {
            const float sc = 0.04419417382415922f;
#pragma unroll
            for (int r = 0; r < 4; ++r) { float mx = -3.0e38f;
#pragma unroll
                for (int nt = 0; nt < 16; ++nt) mx = fmaxf(mx, sacc[nt][r]);
                mx = fmaxf(mx, __shfl_xor(mx, 1)); mx = fmaxf(mx, __shfl_xor(mx, 2)); mx = fmaxf(mx, __shfl_xor(mx, 4)); mx = fmaxf(mx, __shfl_xor(mx, 8));
                float sum = 0.f;
#pragma unroll
                for (int nt = 0; nt < 16; ++nt) { const float e = __expf((sacc[nt][r] - mx) * sc); sacc[nt][r] = e; sum += e; }
                sum += __shfl_xor(sum, 1); sum += __shfl_xor(sum, 2); sum += __shfl_xor(sum, 4); sum += __shfl_xor(sum, 8);
                const float inv = 1.0f / sum;
#pragma unroll
                for (int nt = 0; nt < 16; ++nt) Pl[(4 * fq + r) * 264 + 16 * nt + fr] = (bf16)f2bf(sacc[nt][r] * inv); }
            WAVE_LDS_SYNC();
#pragma unroll
            for (int ks = 0; ks < 8; ++ks) pf[ks] = *(const LAS bf16x8*)(Pl + fr * 264 + 32 * ks + 8 * fq);
            WAVE_LDS_SYNC();
        } else {
#pragma unroll
            for (int ks = 0; ks < 8; ++ks) pf[ks] = zero8h(); }
#pragma unroll
        for (int vp = 0; vp < 8; ++vp) {
            if (vp < 7) { const unsigned o_ = vld + (vp + 1) * (64 * MTOK * 2); st0 = LDG(u32x4, o_); st1 = LDG(u32x4, o_ + 16 * MTOK * 2); st2 = LDG(u32x4, o_ + 32 * MTOK * 2); st3 = LDG(u32x4, o_ + 48 * MTOK * 2); }
            if (act) {
#pragma unroll
                for (int t = 0; t < 2; ++t)
#pragma unroll
                    for (int d2 = 0; d2 < 2; ++d2) { f32x4 a = (f32x4){0.f, 0.f, 0.f, 0.f};
#pragma unroll
                        for (int ks = 0; ks < 8; ++ks) { const bf16x8 vf = *(const LAS bf16x8*)(KV + (vp & 1) * BUFP + t * BUFB + (16 * d2 + fr) * VROW + (32 * ks + 8 * fq) * 2); a = MFMA32(pf[ks], vf, a); }
#pragma unroll
                        for (int r = 0; r < 4; ++r) *(bf16*)(C.ws + oo + (unsigned)((r * DM + 32 * (2 * vp + t) + 16 * d2) * 2)) = (bf16)f2bf(a[r]); } }
            if (vp < 7) { LAS unsigned char* nb = KV + ((vp + 1) & 1) * BUFP;
                *(LAS u32x4*)(nb + vrow * VROW + vc * 16) = st0; *(LAS u32x4*)(nb + (vrow + 16) * VROW + vc * 16) = st1;
                *(LAS u32x4*)(nb + BUFB + vrow * VROW + vc * 16) = st2; *(LAS u32x4*)(nb + BUFB + (vrow + 16) * VROW + vc * 16) = st3;
                __syncthreads(); }
            __builtin_amdgcn_sched_barrier(0);
        }
    }
#undef LDG
}
__device__ __forceinline__ void phase_ffnact(const Ctx& C, int l) {
    const size_t gt = (size_t)C.bid * 512 + C.tid, NT = (size_t)C.G * 512;
    const bf16* U = WSP(const bf16, WS_PROJ);
    const float* cw = C.in(29) + (size_t)l * 3 * DFF2; const float* cb = C.in(30) + (size_t)l * DFF2; const float* st = C.in(6) + (size_t)l * SBT * 2 * DFF2;
    for (size_t it = gt; it < (size_t)(T / 8) * (DFF / 8); it += NT) {
        const int seg = (int)(it / (DFF / 8)), c = (int)(it % (DFF / 8)) * 8, row0 = seg * 8; const SeqInfo s = seq_of_row(row0);
        u32x4 ru[10], rg[10];
#pragma unroll
        for (int i = 0; i < 8; ++i) { ru[2 + i] = *(const u32x4*)(U + (size_t)(row0 + i) * DFF2 + c); rg[2 + i] = *(const u32x4*)(U + (size_t)(row0 + i) * DFF2 + DFF + c); }
        float wu[3][8], wg[3][8], bu[8], bg[8];
#pragma unroll
        for (int i = 0; i < 3; ++i)
#pragma unroll
            for (int hlf = 0; hlf < 2; ++hlf) { const f32x4 a = *(const f32x4*)(cw + i * DFF2 + c + 4 * hlf), b = *(const f32x4*)(cw + i * DFF2 + DFF + c + 4 * hlf);
#pragma unroll
                for (int j = 0; j < 4; ++j) { wu[i][4 * hlf + j] = a[j]; wg[i][4 * hlf + j] = b[j]; } }
#pragma unroll
        for (int hlf = 0; hlf < 2; ++hlf) { const f32x4 a = *(const f32x4*)(cb + c + 4 * hlf), b = *(const f32x4*)(cb + DFF + c + 4 * hlf);
#pragma unroll
            for (int j = 0; j < 4; ++j) { bu[4 * hlf + j] = a[j]; bg[4 * hlf + j] = b[j]; } }
        float hu[2][8], hg[2][8];
        if (s.t >= 2) {
#pragma unroll
            for (int i = 0; i < 2; ++i) { ru[i] = *(const u32x4*)(U + (size_t)(row0 - 2 + i) * DFF2 + c); rg[i] = *(const u32x4*)(U + (size_t)(row0 - 2 + i) * DFF2 + DFF + c); unpack8(ru[i], hu[i]); unpack8(rg[i], hg[i]); } }
        else if (s.sample) {
#pragma unroll
            for (int i = 0; i < 2; ++i) { const float* sp = st + ((size_t)s.b * 2 + i) * DFF2 + c;
#pragma unroll
                for (int j = 0; j < 8; ++j) { hu[i][j] = sp[j]; hg[i][j] = sp[DFF + j]; } } }
        else {
#pragma unroll
            for (int i = 0; i < 2; ++i)
#pragma unroll
                for (int j = 0; j < 8; ++j) { hu[i][j] = 0.f; hg[i][j] = 0.f; } }
#pragma unroll
        for (int i = 0; i < 8; ++i) { float cu[8], cg[8], o[8]; unpack8(ru[2 + i], cu); unpack8(rg[2 + i], cg);
#pragma unroll
            for (int j = 0; j < 8; ++j) { const float au = bu[j] + hu[0][j] * wu[0][j] + hu[1][j] * wu[1][j] + cu[j] * wu[2][j], ag = bg[j] + hg[0][j] * wg[0][j] + hg[1][j] * wg[1][j] + cg[j] * wg[2][j];
                o[j] = siluf_(ag) * au; hu[0][j] = hu[1][j]; hu[1][j] = cu[j]; hg[0][j] = hg[1][j]; hg[1][j] = cg[j]; }
            *(u32x4*)(WSP(bf16, WS_YSR) + (size_t)(row0 + i) * DFF + c) = pack8(o); }
    }
    for (size_t it = gt; it < (size_t)NSEQ * 2 * DFF2; it += NT) {
        const int c = (int)(it % DFF2), j = (int)(it / DFF2) % 2, sq = (int)(it / (2 * DFF2)); const SeqInfo s = seq_of_idx(sq);
        float* dst = C.out + (s.sample ? O_SFFC + ((size_t)l * SBT + s.b) * 2 * DFF2 : O_PFFC + ((size_t)l * NB + s.b) * 2 * DFF2);
        dst[j * DFF2 + c] = bf2f(U[(size_t)(s.row0 + s.L - 2 + j) * DFF2 + c]);
    }
}

struct SEpiGate0 { const bf16* P; float* M0; static constexpr bool ROWSUM = false; __device__ __forceinline__ float operator()(int row, int col, float v) const { M0[(size_t)row * DM + col] = v * sigmoidf_(bf2f(P[(size_t)row * NPROJ + PGATE + col])); return 0.f; } };
struct SEpiGate1 { const bf16* P; const float* M0; bf16* O; static constexpr bool ROWSUM = false; __device__ __forceinline__ float operator()(int row, int col, float v) const { O[(size_t)row * DM + col] = (bf16)f2bf(M0[(size_t)row * DM + col] + v * sigmoidf_(bf2f(P[(size_t)row * NPROJ + PGATE + DM + col]))); return 0.f; } };
struct SEpiResid { float* X; bf16* H; float* SS; static constexpr bool ROWSUM = true; __device__ __forceinline__ float operator()(int row, int col, float v) const { const float x = X[(size_t)row * DM + col] + v; X[(size_t)row * DM + col] = x; H[(size_t)row * DM + col] = (bf16)f2bf(x); return x * x; } };
struct SEpiBf16 { bf16* O; const float* SS; static constexpr bool ROWSUM = false; __device__ __forceinline__ float operator()(int row, int col, float v) const { O[(size_t)row * DM + col] = (bf16)f2bf(v * row_rstd(SS, row)); return 0.f; } };
template <class SE>
__device__ __forceinline__ void sample_gemm(const Ctx& C, size_t a_off, size_t b_off, int K, const SE& E) {
    const int lane = C.lane, fr = lane & 15, fq = lane >> 4; const unsigned char* wsb = C.ws;
    const int KW = K / 8, NK = KW / 32;
    for (int u = C.bid; u < 256; u += C.G) {
        const int jx = u >> 3, mi = jx >> 3, ni = (jx & 7) * 8 + (u & 7);
        const unsigned ao = (unsigned)(a_off + ((size_t)(TP + 64 * mi + fr) * K + C.wave * KW + 8 * fq) * 2);
        const unsigned bo = (unsigned)(b_off + ((size_t)(32 * ni + fr) * K + C.wave * KW + 8 * fq) * 2);
        f32x4 acc[4][2];
#pragma unroll
        for (int i = 0; i < 4; ++i) { acc[i][0] = __builtin_bit_cast(f32x4, zero16()); acc[i][1] = __builtin_bit_cast(f32x4, zero16()); }
        constexpr int WP = 3;
        bf16x8 af[2 * WP][4], bfv[2 * WP][2];
#define SG_LD(slot, ks_) do { const unsigned ko_ = 64u * (unsigned)(ks_); \
        _Pragma("unroll") for (int i = 0; i < 4; ++i) af[slot][i] = *(const bf16x8*)(wsb + ao + (unsigned)(i * 32 * K) + ko_); \
        _Pragma("unroll") for (int n = 0; n < 2; ++n) bfv[slot][n] = *(const bf16x8*)(wsb + bo + (unsigned)(n * 32 * K) + ko_); } while (0)
#pragma unroll
        for (int j = 0; j < 2 * WP; ++j) SG_LD(j, j);
        __syncthreads();
        for (int ks = 0; ks < NK; ks += 2 * WP) {
#pragma unroll
            for (int jp = 0; jp < WP; ++jp) {
                if (ks + 2 * jp < NK) {
#pragma unroll
                    for (int j = 2 * jp; j < 2 * jp + 2; ++j)
#pragma unroll
                        for (int i = 0; i < 4; ++i) { acc[i][0] = MFMA32(af[j][i], bfv[j][0], acc[i][0]); acc[i][1] = MFMA32(af[j][i], bfv[j][1], acc[i][1]); } }
                const int kn = ks + 2 * WP + 2 * jp < NK ? ks + 2 * WP + 2 * jp : NK - 2;
                SG_LD(2 * jp, kn); SG_LD(2 * jp + 1, kn + 1);
                __builtin_amdgcn_sched_barrier(0); } }
#undef SG_LD
        LAS f32x4* red = (LAS f32x4*)C.lds;
#pragma unroll
        for (int i = 0; i < 4; ++i) { red[(C.wave * 8 + 2 * i) * 64 + lane] = acc[i][0]; red[(C.wave * 8 + 2 * i + 1) * 64 + lane] = acc[i][1]; }
        __syncthreads();
        f32x4 sum = red[C.wave * 64 + lane];
#pragma unroll
        for (int w = 1; w < 8; ++w) sum += red[(w * 8 + C.wave) * 64 + lane];
        const int row0 = TP + 64 * mi + 16 * (C.wave >> 1) + 4 * fq, col = 32 * ni + 16 * (C.wave & 1) + fr;
#pragma unroll
        for (int r = 0; r < 4; ++r) { const int row = row0 + r; float q = E(row, col, sum[r]);
            if constexpr (SE::ROWSUM) { q += __shfl_xor(q, 1); q += __shfl_xor(q, 2); q += __shfl_xor(q, 4); q += __shfl_xor(q, 8); if (fr == 0) atomicAdd(E.SS + row, q); } }
    }
}

#ifndef HOST_EMU
#define XB_TMO      128
#define XB_XCNT(j)  (256  + 64 * (j))
#define XB_XSUB(j)  (1280 + 64 * (j))
#define XB_XGEN(j)  (2304 + 64 * (j))
#define XB_TOP      3328
#define XB_TOPGEN   3392
#define XCD_BAR_WORDS 3456
#define XB_SPIN_CAP (1u << 18)
__device__ __forceinline__ unsigned xb_ld(unsigned* p)              { return __hip_atomic_load(p, __ATOMIC_RELAXED, __HIP_MEMORY_SCOPE_AGENT); }
__device__ __forceinline__ unsigned xb_add(unsigned* p, unsigned v) { return __hip_atomic_fetch_add(p, v, __ATOMIC_RELAXED, __HIP_MEMORY_SCOPE_AGENT); }
__device__ __forceinline__ unsigned xb_xcc_id() { return (unsigned)__builtin_amdgcn_s_getreg((3 << 11) | 20) & 0xFu; }
#define XB_SPIN(cond, bar) do { unsigned _sp = 0; while (cond) { __builtin_amdgcn_s_sleep(1); \
    if ((++_sp & 255u) == 0u) { if (xb_ld(&(bar)[XB_TMO])) break; if (_sp > XB_SPIN_CAP) { atomicAdd(&(bar)[XB_TMO], 1u); break; } } } } while (0)
struct XcdBarrier { unsigned* bar; unsigned x; volatile LAS unsigned* st; };
__device__ __forceinline__ XcdBarrier xcd_barrier_post(unsigned* bar, volatile LAS unsigned* st) {
    XcdBarrier b; b.bar = bar; b.x = xb_xcc_id(); b.st = st;
    if (threadIdx.x == 0) (void)xb_add(&bar[XB_XCNT(b.x)], 1u);
    return b;
}
__device__ __forceinline__ void xcd_barrier_complete(unsigned* bar, unsigned x, unsigned& nloc, unsigned& nx) {
    const unsigned G = gridDim.x * gridDim.y * gridDim.z;
    unsigned sum, cnt, mine, sp = 0u;
    for (;;) {
        sum = 0u; cnt = 0u; mine = 0u;
#pragma unroll
        for (unsigned j = 0; j < 16; ++j) { const unsigned c = xb_ld(&bar[XB_XCNT(j)]); sum += c; cnt += (c > 0u) ? 1u : 0u; mine = (j == x) ? c : mine; }
        if (sum == G) break;
        __builtin_amdgcn_s_sleep(1);
        if ((++sp & 255u) == 0u) { if (xb_ld(&bar[XB_TMO])) break; if (sp > XB_SPIN_CAP) { atomicAdd(&bar[XB_TMO], 1u); break; } }
    }
    nloc = mine > 0u ? mine : 1u; nx = cnt > 0u ? cnt : 1u;
}
__device__ __forceinline__ void xcd_barrier(const XcdBarrier& b) {
    asm volatile("s_waitcnt vmcnt(0)" ::: "memory");
    __syncthreads();
    if (threadIdx.x == 0) {
        unsigned* bar = b.bar;
        __builtin_amdgcn_s_waitcnt(0);
        unsigned nloc = b.st[0], nx = b.st[1];
        if (nloc == 0u) { xcd_barrier_complete(bar, b.x, nloc, nx); b.st[0] = nloc; b.st[1] = nx; }
        const unsigned old = xb_add(&bar[XB_XSUB(b.x)], 1u);
        const unsigned gen = old / nloc;
        if (old + 1u == (gen + 1u) * nloc) {
            __builtin_amdgcn_fence(__ATOMIC_RELEASE, "agent");
            asm volatile("s_waitcnt vmcnt(0)" ::: "memory");
            const unsigned og = xb_add(&bar[XB_TOP], 1u);
            const unsigned tg = og / nx;
            if (og + 1u == (tg + 1u) * nx) xb_add(&bar[XB_TOPGEN], 1u);
            else XB_SPIN(xb_ld(&bar[XB_TOPGEN]) == tg, bar);
            __builtin_amdgcn_fence(__ATOMIC_ACQUIRE, "agent");
            xb_add(&bar[XB_XGEN(b.x)], 1u);
            asm volatile("s_waitcnt vmcnt(0)" ::: "memory");
        } else {
            XB_SPIN(xb_ld(&bar[XB_XGEN(b.x)]) == gen, bar);
            __builtin_amdgcn_fence(__ATOMIC_ACQUIRE, "agent");
            asm volatile("s_waitcnt vmcnt(0)" ::: "memory");
        }
    }
    __syncthreads();
}
#endif

constexpr int PH_PRO = 0, PH_KV = 1, PH_L0 = 2, PH_PER_LAYER = 18, PH_FINAL = PH_L0 + 2 * PH_PER_LAYER, NPH = PH_FINAL + 1;
#ifdef HOST_EMU
__device__ __forceinline__ Ctx make_ctx(const Args& args, unsigned char* lds, int) {
    Ctx C; C.lds = lds; C.tid = threadIdx.x; C.lane = C.tid & 63; C.wave = C.tid >> 6; C.G = gridDim.x; C.bid = blockIdx.x; C.ap = &args; C.out = args.out; C.ws = args.ws; return C;
}
#else
__device__ __forceinline__ Ctx make_ctx(const Args& args, unsigned char* lds, int wave_s) {
    Ctx C; int wave = wave_s; asm volatile("" : "+s"(wave));
    int lane = __builtin_amdgcn_mbcnt_hi(~0u, __builtin_amdgcn_mbcnt_lo(~0u, 0u)); asm volatile("" : "+v"(lane));
    int bid = blockIdx.x, G = gridDim.x; asm volatile("" : "+s"(bid), "+s"(G));
    const CAS unsigned char* kp = (const CAS unsigned char*)__builtin_amdgcn_kernarg_segment_ptr(); asm volatile("" : "+s"(kp));
    int tid = wave * 64 + lane; asm volatile("" : "+v"(tid));
    C.lds = (LAS unsigned char*)lds; C.tid = tid; C.lane = tid & 63; C.wave = __builtin_amdgcn_readfirstlane(tid >> 6); C.G = G; C.bid = bid; C.kp = kp;
    C.out = *(float* const CAS*)(kp + 264); C.ws = *(unsigned char* const CAS*)(kp + 272);
    return C;
}
static_assert(sizeof(Args) == 288, "Args layout (kernarg offsets in make_ctx)");
#endif
__global__ void __launch_bounds__(512, 2) mk_fwd(Args args) {
    DYN_LDS(lds);
    const int lo = args.ph_lo, hi = args.ph_hi;
    const int wave_s = __builtin_amdgcn_readfirstlane((int)threadIdx.x >> 6);
#ifndef HOST_EMU
    volatile LAS unsigned* lctl = (volatile LAS unsigned*)((LAS unsigned char*)lds + LDS_CTL_OFF);
    if (threadIdx.x < 64) lctl[threadIdx.x] = 0u;
    __syncthreads();
    if (hi - lo > 1) (void)xcd_barrier_post((unsigned*)(args.ws + WS_CTL) + 4096, lctl + 8);
#define GRID_BAR() do { XcdBarrier bar_; { const CAS unsigned char* kp_ = (const CAS unsigned char*)__builtin_amdgcn_kernarg_segment_ptr(); asm volatile("" : "+s"(kp_)); \
        bar_.bar = (unsigned*)(*(unsigned char* const CAS*)(kp_ + 272) + WS_CTL) + 4096; } bar_.x = xb_xcc_id(); bar_.st = (volatile LAS unsigned*)((LAS unsigned char*)lds + LDS_CTL_OFF) + 8; xcd_barrier(bar_); } while (0)
#else
#define GRID_BAR() ((void)0)
#endif
#define IN(k) (lo <= (k) && (k) < hi)
#ifdef PROBE_AMP
#define SEAM(k) do { if (IN(k) && IN((k) + 1)) { const unsigned b0_ = PT_NOW(); GRID_BAR(); if (threadIdx.x == 0) atomicAdd((unsigned*)(args.ws + WS_CTL + 32768) + 256 + 6 * 256 + blockIdx.x, PT_NOW() - b0_); } } while (0)
#else
#define SEAM(k) do { if (IN(k) && IN((k) + 1)) GRID_BAR(); } while (0)
#endif
#define CTX const Ctx C = make_ctx(args, lds, wave_s)
#define GEMM_PHASE(EPI, Aoff, Boff, M_, N_, K_, ...) do { CTX; pg8::Gemm g{WSP(const bf16, Aoff), WSP(const bf16, Boff), M_, N_, K_}; pg8::StaticOrder S; S.init(M_, N_, C.G, C.bid); \
        EPI E{__VA_ARGS__}; pg8::gemm_phase<EPI, true>(C.lds, C.tid, g, S, E); } while (0)
    if (IN(PH_PRO)) { { CTX; phase_prologue(C); } { CTX; phase_xprep(C); } } SEAM(PH_PRO);
    if (IN(PH_KV)) { GEMM_PHASE(EpiMemKV, WS_MEMP, WS_WKV, NB * MTOK, 8192, DM, C.out, WSP(bf16, WS_KP), WSP(bf16, WS_VTP)); __syncthreads(); { CTX; phase_wconv(C, 0, (NB * MTOK / 256) * (8192 / 256)); } } SEAM(PH_KV);
#ifndef PROBE_MASK
#define PROBE_MASK 0
#endif
#ifdef PROBE_AMP
#define PT_G0 unsigned ptg_ = PT_NOW()
#define PT_G1(k) do { __syncthreads(); CTX; const unsigned n_ = PT_NOW(); PT_BLK_ADD(C, k, n_ - ptg_); ptg_ = n_; } while (0)
#else
#define PT_G0 ((void)0)
#define PT_G1(k) ((void)0)
#endif
#define LPH_NS(off, ...) do { if (IN(pb + (off))) { __VA_ARGS__; __syncthreads(); } } while (0)
#define LPH(off, ...) do { if (IN(pb + (off))) { __VA_ARGS__; if ((PROBE_MASK >> (off)) & 1) { GRID_BAR(); __VA_ARGS__; } } SEAM(pb + (off)); } while (0)
    for (int l = 0; l < 2; ++l) {
        const int pb = PH_L0 + PH_PER_LAYER * l;
        if (IN(pb + 0)) { if (l > 0) { CTX; phase_wconv(C, l); } if (PROBE_MASK & 1) { GRID_BAR(); CTX; phase_wconv(C, l); } } if (l > 0) SEAM(pb + 0);
        LPH(2, GEMM_PHASE(EpiProj, WS_H, WS_WIN, T, NPROJ_PAD, DM, WSP(bf16, WS_PROJ), WSP(float, WS_SMALL), WSP(const float, WS_SS) + (size_t)(3 * l) * T));
        LPH(3, { CTX; phase_prep(C, l); });
        LPH(4, { CTX; phase_chunkprep(C, l); });
        LPH(5, { CTX; phase_scan(C, l); });
        LPH(6, { CTX; phase_ynorm(C, l); });
        LPH_NS(7, { PT_G0; GEMM_PHASE(EpiGate0, WS_YS, WS_WB0, TP, DM, DM, WSP(const bf16, WS_PROJ), WSP(float, WS_YSR)); PT_G1(5); CTX; sample_gemm(C, WS_YS, WS_WB0, DM, SEpiGate0{WSP(const bf16, WS_PROJ), WSP(float, WS_YSR)}); PT_G1(4); });
        LPH(8, { PT_G0; GEMM_PHASE(EpiGate1, WS_YG, WS_WB1, TP, DM, DM, WSP(const bf16, WS_PROJ), WSP(const float, WS_YSR), WSP(bf16, WS_MRG)); PT_G1(5); CTX; sample_gemm(C, WS_YG, WS_WB1, DM, SEpiGate1{WSP(const bf16, WS_PROJ), WSP(const float, WS_YSR), WSP(bf16, WS_MRG)}); PT_G1(4); });
        LPH(9, { PT_G0; GEMM_PHASE(EpiResid, WS_MRG, WS_WOUT, TP, DM, DM, WSP(float, WS_X), WSP(bf16, WS_H), WSP(float, WS_SS) + (size_t)(3 * l + 1) * T); PT_G1(5); CTX; sample_gemm(C, WS_MRG, WS_WOUT, DM, SEpiResid{WSP(float, WS_X), WSP(bf16, WS_H), WSP(float, WS_SS) + (size_t)(3 * l + 1) * T}); PT_G1(4); });
        LPH(11, { PT_G0; GEMM_PHASE(EpiBf16, WS_H, WS_WMQ, TP, DM, DM, WSP(bf16, WS_YS), DM, WSP(const float, WS_SS) + (size_t)(3 * l + 1) * T); PT_G1(5); CTX; sample_gemm(C, WS_H, WS_WMQ, DM, SEpiBf16{WSP(bf16, WS_YS), WSP(const float, WS_SS) + (size_t)(3 * l + 1) * T}); PT_G1(4); });
        LPH(12, { CTX; phase_attn(C, l); });
        LPH(13, { PT_G0; GEMM_PHASE(EpiResid, WS_YG, WS_WMO, TP, DM, DM, WSP(float, WS_X), WSP(bf16, WS_H), WSP(float, WS_SS) + (size_t)(3 * l + 2) * T); PT_G1(5); CTX; sample_gemm(C, WS_YG, WS_WMO, DM, SEpiResid{WSP(float, WS_X), WSP(bf16, WS_H), WSP(float, WS_SS) + (size_t)(3 * l + 2) * T}); PT_G1(4); });
        LPH(15, GEMM_PHASE(EpiBf16, WS_H, WS_WFI, T, DFF2, DM, WSP(bf16, WS_PROJ), DFF2, WSP(const float, WS_SS) + (size_t)(3 * l + 2) * T));
        LPH(16, { CTX; phase_ffnact(C, l); });
        LPH(17, { PT_G0; GEMM_PHASE(EpiResid, WS_YSR, WS_WFO, TP, DM, DFF, WSP(float, WS_X), WSP(bf16, WS_H), WSP(float, WS_SS) + (size_t)(3 * l + 3) * T); PT_G1(5); CTX; sample_gemm(C, WS_YSR, WS_WFO, DFF, SEpiResid{WSP(float, WS_X), WSP(bf16, WS_H), WSP(float, WS_SS) + (size_t)(3 * l + 3) * T}); PT_G1(4); });
    }
    if (IN(PH_FINAL)) { CTX; phase_final(C); }
#ifdef PROBE_AMP
    if (IN(PH_FINAL)) { GRID_BAR();
        if (blockIdx.x == 0 && threadIdx.x == 0) { unsigned* pt = (unsigned*)(args.ws + WS_CTL + 32768); unsigned v = 0;
            if (PROBE_SEL < 4) v = __hip_atomic_load(pt + 2 * PROBE_SEL, __ATOMIC_RELAXED, __HIP_MEMORY_SCOPE_AGENT) + __hip_atomic_load(pt + 2 * PROBE_SEL + 1, __ATOMIC_RELAXED, __HIP_MEMORY_SCOPE_AGENT);
            else if (PROBE_SEL == 10) v = __hip_atomic_load(pt + 12, __ATOMIC_RELAXED, __HIP_MEMORY_SCOPE_AGENT);
            else if (PROBE_SEL == 9) v = (__hip_atomic_load(pt + 10, __ATOMIC_RELAXED, __HIP_MEMORY_SCOPE_AGENT) + __hip_atomic_load(pt + 11, __ATOMIC_RELAXED, __HIP_MEMORY_SCOPE_AGENT)) / 512u;
            else if (PROBE_SEL == 8) v = (__hip_atomic_load(pt + 8, __ATOMIC_RELAXED, __HIP_MEMORY_SCOPE_AGENT) + __hip_atomic_load(pt + 9, __ATOMIC_RELAXED, __HIP_MEMORY_SCOPE_AGENT)) / 512u;
            else if (PROBE_SEL == 6) { unsigned long long t = 0; for (int i = 0; i < 256; ++i) t += __hip_atomic_load(pt + 256 + 6 * 256 + i, __ATOMIC_RELAXED, __HIP_MEMORY_SCOPE_AGENT); v = (unsigned)(t / 256); }
            else if (PROBE_SEL == 7) { v = ~0u; for (int i = 0; i < 256; ++i) { const unsigned w = __hip_atomic_load(pt + 256 + 6 * 256 + i, __ATOMIC_RELAXED, __HIP_MEMORY_SCOPE_AGENT); v = w < v ? w : v; } }
            else for (int i = 0; i < 256; ++i) { const unsigned w = __hip_atomic_load(pt + 256 + PROBE_SEL * 256 + i, __ATOMIC_RELAXED, __HIP_MEMORY_SCOPE_AGENT); v = w > v ? w : v; }
            const unsigned long long t0 = __builtin_amdgcn_s_memrealtime(), span = (unsigned long long)v * PROBE_AMP;
            while (__builtin_amdgcn_s_memrealtime() - t0 < span) __builtin_amdgcn_s_sleep(20); } }
#endif
#undef IN
#undef SEAM
#undef GRID_BAR
}

extern "C" void kernel_launch(void* const* d_in, const int* in_sizes, int n_in, void* d_out, int out_size, void* d_ws, size_t ws_size, hipStream_t stream) {
    static int grid = 0;
    if (grid == 0) {
        if (n_in != 33 || (size_t)out_size != O_END || ws_size < WS_END) { fprintf(stderr, "kernel_launch: unexpected shapes (n_in %d out %d ws %zu; need out %zu ws %zu)\n", n_in, out_size, ws_size, (size_t)O_END, (size_t)WS_END); grid = -1; return; }
        int dev = 0, cus = 0;
        if (hipGetDevice(&dev) != hipSuccess || hipDeviceGetAttribute(&cus, hipDeviceAttributeMultiprocessorCount, dev) != hipSuccess) { grid = -1; return; }
        if (hipFuncSetAttribute((const void*)mk_fwd, hipFuncAttributeMaxDynamicSharedMemorySize, LDS_BYTES) != hipSuccess) { fprintf(stderr, "kernel_launch: hipFuncSetAttribute failed\n"); grid = -1; return; }
        (void)hipGetLastError();
        grid = cus;
    }
    if (grid < 0) return;
    (void)hipMemsetAsync((char*)d_ws + WS_CTL, 0, CTL_BYTES, stream);
    Args a{};
    for (int i = 0; i < 33; ++i) a.in[i] = (const float*)d_in[i];
    a.out = (float*)d_out; a.ws = (unsigned char*)d_ws;
#ifdef HOST_EMU
    const char* e0 = getenv("EMU_PH_LO"); const char* e1 = getenv("EMU_PH_HI");
    const int plo = e0 ? atoi(e0) : 0, phi = e1 ? atoi(e1) : NPH;
    for (int p = plo; p < phi; ++p) { a.ph_lo = p; a.ph_hi = p + 1; fprintf(stderr, "emu: phase %d\n", p); emu_launch(mk_fwd, (unsigned)grid, 512u, (size_t)LDS_BYTES, a); }
#else
#if MK_ONE_LAUNCH
    a.ph_lo = 0; a.ph_hi = NPH;
    hipLaunchKernelGGL(mk_fwd, dim3(grid), dim3(512), LDS_BYTES, stream, a);
#else
    for (int p = 0; p < NPH; ++p) { a.ph_lo = p; a.ph_hi = p + 1; hipLaunchKernelGGL(mk_fwd, dim3(grid), dim3(512), LDS_BYTES, stream, a); }
#endif
#endif
}
```

```cpp
#ifndef HOST_EMU
#include <hip/hip_runtime.h>
#endif
#include <cstdio>
#include <cstdint>

#ifndef CFG_BATCH
#define CFG_BATCH 4
#endif
#ifndef CFG_SEQ
#define CFG_SEQ 2048
#endif
#ifndef MK_ONE_LAUNCH
#define MK_ONE_LAUNCH 1
#endif

#ifdef HOST_EMU
#define LAS
#define VMCNT(n) ((void)emu_wave_op([](unsigned char*) {}, [](unsigned char (*)[64]) {}))
#define LGKMCNT(n) ((void)0)
#define MEMCLOB() ((void)0)
#define WAVE_LDS_SYNC() ((void)emu_wave_op([](unsigned char*) {}, [](unsigned char (*)[64]) {}))
#define DYN_LDS(name) unsigned char* name = emu_lds()
#define LAUNDER_V(x) ((void)0)
#else
#define LAS __attribute__((address_space(3)))
#define VMCNT(n) asm volatile("s_waitcnt vmcnt(" #n ")" ::: "memory")
#define LGKMCNT(n) asm volatile("s_waitcnt lgkmcnt(" #n ")" ::: "memory")
#define MEMCLOB() asm volatile("" ::: "memory")
#define WAVE_LDS_SYNC() asm volatile("s_waitcnt lgkmcnt(0)" ::: "memory")
#define DYN_LDS(name) extern __shared__ __attribute__((aligned(16))) unsigned char name[]
#define LAUNDER_V(x) asm volatile("" : "+v"(x))
#endif

typedef unsigned short bf16;
typedef short bf16x8 __attribute__((ext_vector_type(8)));
typedef float f32x4 __attribute__((ext_vector_type(4)));
typedef float f32x2 __attribute__((ext_vector_type(2)));
typedef unsigned u32x4 __attribute__((ext_vector_type(4)));
typedef unsigned u32x2 __attribute__((ext_vector_type(2)));

__device__ __forceinline__ unsigned f2bf(float f) { unsigned u = __builtin_bit_cast(unsigned, f); return (u + 0x7fffu + ((u >> 16) & 1u)) >> 16; }
__device__ __forceinline__ float bf2f(unsigned b) { return __builtin_bit_cast(float, b << 16); }
__device__ __forceinline__ float bf_lo(unsigned w) { return __builtin_bit_cast(float, w << 16); }
__device__ __forceinline__ float bf_hi(unsigned w) { return __builtin_bit_cast(float, w & 0xffff0000u); }
#ifdef HOST_EMU
__device__ __forceinline__ unsigned cvt_pk_bf16(float lo, float hi) { return f2bf(lo) | (f2bf(hi) << 16); }
#else
typedef __bf16 bf16x2_native __attribute__((ext_vector_type(2)));
__device__ __forceinline__ unsigned cvt_pk_bf16(float lo, float hi) { const f32x2 v = {lo, hi}; return __builtin_bit_cast(unsigned, __builtin_convertvector(v, bf16x2_native)); }
#endif
__device__ __forceinline__ void unpack8(const u32x4 w, float (&v)[8]) { v[0] = bf_lo(w.x); v[1] = bf_hi(w.x); v[2] = bf_lo(w.y); v[3] = bf_hi(w.y); v[4] = bf_lo(w.z); v[5] = bf_hi(w.z); v[6] = bf_lo(w.w); v[7] = bf_hi(w.w); }
__device__ __forceinline__ u32x4 pack8(const float (&v)[8]) { u32x4 w; w.x = cvt_pk_bf16(v[0], v[1]); w.y = cvt_pk_bf16(v[2], v[3]); w.z = cvt_pk_bf16(v[4], v[5]); w.w = cvt_pk_bf16(v[6], v[7]); return w; }
__device__ __forceinline__ u32x4 zero16() { unsigned z = 0u; LAUNDER_V(z); return (u32x4){z, z, z, z}; }
__device__ __forceinline__ bf16x8 zero8h() { return __builtin_bit_cast(bf16x8, zero16()); }
__device__ __forceinline__ float sigmoidf_(float x) { return 1.0f / (1.0f + __expf(-x)); }
__device__ __forceinline__ float siluf_(float x) { return x / (1.0f + __expf(-x)); }
__device__ __forceinline__ float softplusf_(float x) { return x > 20.f ? x : __logf(1.0f + __expf(x)); }
__device__ __forceinline__ float logsigmoidf_(float x) { return fminf(x, 0.f) - __logf(1.0f + __expf(-fabsf(x))); }
__device__ __forceinline__ float wave_sum(float v) {
#pragma unroll
    for (int o = 1; o < 64; o <<= 1) v += __shfl_xor(v, o);
    return v;
}

constexpr int DM = 2048, NB = CFG_BATCH, SEQ = CFG_SEQ, TP = NB * SEQ, SBT = 16, SSQ = 16, TS = SBT * SSQ, T = TP + TS, NSEQ = NB + SBT;
constexpr int MTOK = 256, DFF = 5632, DFF2 = 11264, IN_DIM = 15408, NPROJ = 15360, NPROJ_PAD = 15616, XBCW = 3072;
constexpr int PZ = 0, PXBC = 2048, PQ = 5120, PK = 6144, PV = 7168, PG = 9216, PGATE = 11264;
constexpr float EPSF = 1e-6f;
static_assert(TP % 256 == 0 && SEQ % 16 == 0, "token tiling");
constexpr size_t O_Y = 0, O_PSSD = (size_t)T * DM, O_PSSDC = O_PSSD + (size_t)2 * NB * 32 * 64 * 128, O_PGLA = O_PSSDC + (size_t)2 * NB * 3 * XBCW, O_PFFC = O_PGLA + (size_t)2 * NB * 4 * 256 * 512,
                 O_PMK = O_PFFC + (size_t)2 * NB * 2 * DFF2, O_PMV = O_PMK + (size_t)2 * NB * MTOK * DM, O_SSSD = O_PMV + (size_t)2 * NB * MTOK * DM, O_SSSDC = O_SSSD + (size_t)2 * SBT * 32 * 64 * 128,
                 O_SGLA = O_SSSDC + (size_t)2 * SBT * 3 * XBCW, O_SFFC = O_SGLA + (size_t)2 * SBT * 4 * 256 * 512, O_END = O_SFFC + (size_t)2 * SBT * 2 * DFF2;
constexpr size_t A256(size_t x) { return (x + 255) & ~(size_t)255; }
constexpr size_t WS_CTL = 0, CTL_BYTES = 1u << 20;
constexpr size_t WS_WIN = WS_CTL + CTL_BYTES;
constexpr size_t WS_WB0 = WS_WIN + (size_t)NPROJ_PAD * DM * 2;
constexpr size_t WS_WB1 = WS_WB0 + (size_t)DM * DM * 2, WS_WOUT = WS_WB1 + (size_t)DM * DM * 2, WS_WMQ = WS_WOUT + (size_t)DM * DM * 2, WS_WMO = WS_WMQ + (size_t)DM * DM * 2;
constexpr size_t WS_WFI = WS_WMO + (size_t)DM * DM * 2;
constexpr size_t WS_WFO = WS_WFI + (size_t)DFF2 * DM * 2;
constexpr size_t WS_WKV = WS_WFO + (size_t)DM * DFF * 2;
constexpr size_t WS_X = WS_WKV + (size_t)8192 * DM * 2;
constexpr size_t WS_H = WS_X + (size_t)T * DM * 4;
constexpr size_t WS_PROJ = WS_H + (size_t)T * DM * 2;
constexpr size_t WS_SMALL = WS_PROJ + (size_t)T * NPROJ * 2;
constexpr size_t WS_XBC = WS_SMALL + (size_t)T * 256 * 4;
constexpr size_t WS_DT = WS_XBC + (size_t)T * XBCW * 2;
constexpr size_t WS_LOGA = WS_DT + (size_t)T * 32 * 4;
constexpr size_t WS_YSR = WS_LOGA + (size_t)T * 1024 * 4;
constexpr size_t WS_YGR = WS_YSR + (size_t)T * DM * 4;
constexpr size_t WS_YS = WS_YGR + (size_t)T * DM * 4;
constexpr size_t WS_YG = WS_YS + (size_t)T * DM * 2;
constexpr size_t WS_MRG = WS_YG + (size_t)T * DM * 2;
constexpr size_t WS_KP = WS_MRG + (size_t)T * DM * 2;
constexpr size_t WS_VTP = WS_KP + (size_t)2 * NB * MTOK * DM * 2;
constexpr size_t WS_KS = WS_VTP + (size_t)2 * NB * MTOK * DM * 2;
constexpr size_t WS_VTS = WS_KS + (size_t)2 * SBT * MTOK * DM * 2;
constexpr size_t WS_MEMP = WS_VTS + (size_t)2 * SBT * MTOK * DM * 2;
constexpr int NCK = T / 16, NCP = TP / 64, NCS = NCP + SBT;
static_assert(SEQ % 64 == 0, "SSD chunks must not straddle sequences");
constexpr size_t WS_WCH = WS_MEMP + (size_t)NB * MTOK * DM * 2;
constexpr size_t WS_XT = WS_WCH + (size_t)NCS * 32 * 64 * 64 * 2;
constexpr size_t WS_END0 = WS_XT + (size_t)NCS * DM * 64 * 2;
constexpr size_t WS_VT16 = WS_H;
constexpr size_t WS_QD = WS_MRG, WS_KET = WS_MRG + (size_t)T * 1024 * 2;
constexpr size_t WS_DEC = WS_WKV, WS_ATT = WS_DEC + (size_t)NCK * 1024 * 4, WS_EA = WS_ATT + (size_t)NCK * 4 * 256 * 2, WS_DECS = WS_EA + (size_t)NCS * 32 * 64 * 4;
constexpr size_t SZ_XTE = (size_t)NCS * DM * 64 * 2, SZ_BT = (size_t)NCS * 512 * 64 * 2, SZ_CC = (size_t)NCS * 64 * 512 * 2;
constexpr bool OVL_Y = SZ_XTE + SZ_BT + SZ_CC <= (size_t)2 * T * DM * 2;
constexpr size_t WS_XTE = OVL_Y ? WS_YS : WS_END0, WS_BT = WS_XTE + SZ_XTE, WS_CC = WS_BT + SZ_BT;
constexpr size_t WS_END = OVL_Y ? WS_END0 : WS_CC + SZ_CC;
static_assert(WS_DECS + (size_t)NCS * 32 * 4 <= WS_WKV + (size_t)8192 * DM * 2, "scan operand overlays");
static_assert((size_t)T * DFF * 2 <= (size_t)2 * T * DM * 4, "ACT overlay");
static_assert(WS_END <= (size_t)1081389824, "workspace budget");
constexpr size_t WS_SS = WS_CTL + 65536;
static_assert(65536 + (size_t)7 * T * 4 <= CTL_BYTES, "SS slots inside the zeroed control region");
constexpr int LDS_BYTES = 147456;
constexpr int GLP_SLOT = 19456;
constexpr int LDS_CTL_OFF = 139264;

namespace pg8 {
constexpr int BM = 256, BK = 64, HALF = 128, HTB = HALF * BK * 2, STAGE_BYTES = 8 * HTB, NXCD = 8, WGM = 8;
__host__ __device__ __forceinline__ int lds_byte(int r, int c) { const int st = (r >> 4) * 2 + (c >> 5), rr = r & 15, cc = c & 31, ob = rr * 64 + cc * 2; return st * 1024 + (ob ^ (((ob >> 9) & 1) << 5)); }
__host__ __device__ __forceinline__ void stage_rc(int b, int& R, int& C) { const int st = b / 1024, sb = b % 1024, swz = sb ^ (((sb >> 9) & 1) << 5); R = (st >> 1) * 16 + swz / 64; C = (st & 1) * 32 + (swz % 64) / 2; }
__host__ __device__ __forceinline__ int perm32(int rho) { const int n = rho >> 4, i = rho & 15; return 8 * (i >> 2) + 4 * n + (i & 3); }
struct Unit { int pm, pn; };
struct Gemm { const bf16* A; const bf16* Bt; int M, N, K; };
struct StaticOrder {
    int nM, nN, nwg, G, c;
    __host__ __device__ void init(int M, int N, int G_, int c_) { nM = M / BM; nN = N / BM; nwg = nM * nN; G = G_; c = c_; }
    __host__ __device__ bool next(int i, Unit& u) const {
        const long L = (long)i * G + c; if (L >= nwg) return false;
        int wgid = (int)L; { const int q = nwg / NXCD, r = nwg % NXCD, xcd = wgid % NXCD, off = wgid / NXCD; wgid = (xcd < r ? xcd * (q + 1) : r * (q + 1) + (xcd - r) * q) + off; }
        const int nig = WGM * nN, gid = wgid / nig, fm = gid * WGM, gsz = (nM - fm) < WGM ? (nM - fm) : WGM;
        u.pm = fm + ((wgid % nig) % gsz); u.pn = (wgid % nig) / gsz; return true;
    }
};
template <class Epi, bool ALIGN_EPI>
__device__ __forceinline__ void gemm_phase(LAS unsigned char* lds, const int tid, const Gemm g, const StaticOrder& S, const Epi& E) {
    const int wid = __builtin_amdgcn_readfirstlane(tid >> 6), lane = tid & 63, wr = wid >> 2, wc = wid & 3, fr = lane & 15, fq = lane >> 4;
    const int K = g.K, nt = K / BK;
    unsigned voffA[2], voffB[2];
#pragma unroll
    for (int i = 0; i < 2; ++i) { int R, C; stage_rc(tid * 16 + i * 8192, R, C); const int Rb = Epi::PERM ? ((R & ~31) + perm32(R & 31)) : R;
        voffA[i] = (unsigned)(R * K + C) * 2u; voffB[i] = (unsigned)(Rb * K + C) * 2u; }
    const size_t kstep = (size_t)(BK * 2), hstep = (size_t)HALF * K * 2, tstep = 2 * hstep;
    const unsigned ldsw = (unsigned)wid * 1024u;
    const int aoff = lds_byte(wr * 64 + fr, fq * 8), boff = lds_byte(wc * 32 + fr, fq * 8);
#define PG8_SA(b, h) (((b) * 2 + (h)) * HTB)
#define PG8_SB(b, h) ((4 + (b) * 2 + (h)) * HTB)
#define PG8_STAGE(bufoff, gbase, voff) do { _Pragma("unroll") for (int _i = 0; _i < 2; ++_i) \
        __builtin_amdgcn_global_load_lds((const unsigned*)((const char*)(gbase) + (voff)[_i]), (LAS unsigned*)(lds + (bufoff) + ldsw + _i * 8192), 16, 0, 0); } while (0)
#define PG8_LDA(dst, b, h) do { _Pragma("unroll") for (int m = 0; m < 4; ++m) _Pragma("unroll") for (int k = 0; k < 2; ++k) dst[m][k] = *(const LAS bf16x8*)(lds + PG8_SA(b, h) + aoff + m * 2048 + k * 1024); } while (0)
#define PG8_LDB(dst, b, h) do { _Pragma("unroll") for (int n = 0; n < 2; ++n) _Pragma("unroll") for (int k = 0; k < 2; ++k) dst[n][k] = *(const LAS bf16x8*)(lds + PG8_SB(b, h) + boff + n * 2048 + k * 1024); } while (0)
#define PG8_MMA(ai, bj, At, Bt) do { __builtin_amdgcn_s_setprio(1); _Pragma("unroll") for (int m = 0; m < 4; ++m) _Pragma("unroll") for (int n = 0; n < 2; ++n) _Pragma("unroll") for (int k = 0; k < 2; ++k) \
        acc[ai][bj][m][n] = __builtin_amdgcn_mfma_f32_16x16x32_bf16(Bt[n][k], At[m][k], acc[ai][bj][m][n], 0, 0, 0); __builtin_amdgcn_s_setprio(0); } while (0)
#define PG8_BAR __builtin_amdgcn_s_barrier()
#define PG8_SCHED __builtin_amdgcn_sched_barrier(0)
    Unit cur, nxt; int ui = 0;
    if (!S.next(0, cur)) return;
    float zf = 0.f; LAUNDER_V(zf);
    f32x4 acc[2][2][4][2];
#pragma unroll
    for (int a = 0; a < 2; ++a)
#pragma unroll
        for (int b = 0; b < 2; ++b)
#pragma unroll
            for (int m = 0; m < 4; ++m)
#pragma unroll
                for (int n = 0; n < 2; ++n) acc[a][b][m][n] = (f32x4){zf, zf, zf, zf};
    bf16x8 At[4][2], B0[2][2], B1[2][2];
    const char* cA = (const char*)g.A + (size_t)cur.pm * tstep; const char* cB = (const char*)g.Bt + (size_t)cur.pn * tstep;
    PG8_STAGE(PG8_SB(0, 0), cB, voffB); PG8_STAGE(PG8_SB(0, 1), cB + hstep, voffB); PG8_STAGE(PG8_SA(0, 0), cA, voffA); PG8_STAGE(PG8_SA(0, 1), cA + hstep, voffA);
    if (wr == 1) PG8_BAR;
    VMCNT(2); PG8_BAR;
    PG8_STAGE(PG8_SB(1, 0), cB + kstep, voffB); PG8_STAGE(PG8_SA(1, 0), cA + kstep, voffA); PG8_STAGE(PG8_SB(1, 1), cB + hstep + kstep, voffB);
    VMCNT(6); PG8_BAR;
    for (;;) {
        const bool has_next = S.next(ui + 1, nxt);
        const char* nA = has_next ? (const char*)g.A + (size_t)nxt.pm * tstep : cA; const char* nB = has_next ? (const char*)g.Bt + (size_t)nxt.pn * tstep : cB;
        for (int t = 0; t < nt; t += 2) {
            const bool last = (t == nt - 2);
            const char* a1 = cA + (size_t)(t + 1) * kstep;
            const char* a2 = last ? nA : cA + (size_t)(t + 2) * kstep; const char* b2 = last ? nB : cB + (size_t)(t + 2) * kstep;
            const char* a3 = a2 + kstep; const char* b3 = b2 + kstep;
            PG8_LDB(B0, 0, 0); PG8_LDB(B1, 0, 1); PG8_SCHED; PG8_LDA(At, 0, 0); PG8_STAGE(PG8_SA(1, 1), a1 + hstep, voffA);
            VMCNT(8); LGKMCNT(0); PG8_BAR; PG8_MMA(0, 0, At, B0); PG8_MMA(0, 1, At, B1); PG8_BAR; PG8_SCHED;
            PG8_LDA(At, 0, 1); PG8_STAGE(PG8_SB(0, 0), b2, voffB); PG8_STAGE(PG8_SB(0, 1), b2 + hstep, voffB); PG8_STAGE(PG8_SA(0, 0), a2, voffA);
            VMCNT(8); LGKMCNT(0); PG8_BAR; PG8_MMA(1, 0, At, B0); PG8_MMA(1, 1, At, B1); PG8_BAR; PG8_SCHED;
            PG8_LDB(B0, 1, 0); PG8_LDB(B1, 1, 1); PG8_SCHED; PG8_LDA(At, 1, 0); PG8_STAGE(PG8_SA(0, 1), a2 + hstep, voffA);
            VMCNT(8); LGKMCNT(0); PG8_BAR; PG8_MMA(0, 0, At, B0); PG8_MMA(0, 1, At, B1); PG8_BAR; PG8_SCHED;
            PG8_LDA(At, 1, 1); PG8_STAGE(PG8_SB(1, 0), b3, voffB); PG8_STAGE(PG8_SB(1, 1), b3 + hstep, voffB); PG8_STAGE(PG8_SA(1, 0), a3, voffA);
            VMCNT(8); LGKMCNT(0); PG8_BAR; PG8_MMA(1, 0, At, B0); PG8_MMA(1, 1, At, B1); PG8_BAR; PG8_SCHED;
        }
        if constexpr (ALIGN_EPI) { if (wr == 0) PG8_BAR; }
        E(acc, cur, wr, wc, fr, fq);
        if (!has_next) break;
#pragma unroll
        for (int a = 0; a < 2; ++a)
#pragma unroll
            for (int b = 0; b < 2; ++b)
#pragma unroll
                for (int m = 0; m < 4; ++m)
#pragma unroll
                    for (int n = 0; n < 2; ++n) acc[a][b][m][n] = (f32x4){zf, zf, zf, zf};
        cur = nxt; cA = nA; cB = nB; ++ui;
        if constexpr (ALIGN_EPI) { if (wr == 1) PG8_BAR; }
    }
    VMCNT(0);
    if constexpr (!ALIGN_EPI) { if (wr == 0) PG8_BAR; }
    PG8_BAR;
#undef PG8_SA
#undef PG8_SB
#undef PG8_STAGE
#undef PG8_LDA
#undef PG8_LDB
#undef PG8_MMA
#undef PG8_BAR
#undef PG8_SCHED
}
}
using pg8::Unit;

#define EPI_LOOP_ROWS for (int ai = 0; ai < 2; ++ai) _Pragma("unroll") for (int m = 0; m < 4; ++m)
__device__ __forceinline__ float row_rstd(const float* SS, int row) { return 1.0f / sqrtf(SS[row] * (1.0f / DM) + EPSF); }
struct EpiBf16 {
    static constexpr bool PERM = true;
    bf16* O; int ldc; const float* SS;
    __device__ __forceinline__ void operator()(const f32x4 (&acc)[2][2][4][2], const Unit& u, int wr, int wc, int fr, int fq) const {
        const int row0 = u.pm * 256 + wr * 64 + fr, col0 = u.pn * 256 + wc * 32 + 8 * fq;
#pragma unroll
        EPI_LOOP_ROWS { const int row = row0 + ai * 128 + m * 16; const float rs = row_rstd(SS, row); bf16* rowp = O + (size_t)row * ldc + col0;
#pragma unroll
            for (int bj = 0; bj < 2; ++bj) { const f32x4 v0 = acc[ai][bj][m][0] * rs, v1 = acc[ai][bj][m][1] * rs;
                u32x4 w; w.x = cvt_pk_bf16(v0[0], v0[1]); w.y = cvt_pk_bf16(v0[2], v0[3]); w.z = cvt_pk_bf16(v1[0], v1[1]); w.w = cvt_pk_bf16(v1[2], v1[3]);
                *(u32x4*)(rowp + bj * 128) = w; } }
    }
};
struct EpiProj {
    static constexpr bool PERM = true;
    bf16* P; float* Sm; const float* SS;
    __device__ __forceinline__ void operator()(const f32x4 (&acc)[2][2][4][2], const Unit& u, int wr, int wc, int fr, int fq) const {
        const int row0 = u.pm * 256 + wr * 64 + fr;
        if (u.pn < NPROJ / 256) {
            const int col0 = u.pn * 256 + wc * 32 + 8 * fq;
#pragma unroll
            EPI_LOOP_ROWS { const int row = row0 + ai * 128 + m * 16; const float rs = row_rstd(SS, row); bf16* rowp = P + (size_t)row * NPROJ + col0;
#pragma unroll
                for (int bj = 0; bj < 2; ++bj) { const f32x4 v0 = acc[ai][bj][m][0] * rs, v1 = acc[ai][bj][m][1] * rs;
                    u32x4 w; w.x = cvt_pk_bf16(v0[0], v0[1]); w.y = cvt_pk_bf16(v0[2], v0[3]); w.z = cvt_pk_bf16(v1[0], v1[1]); w.w = cvt_pk_bf16(v1[2], v1[3]);
                    *(u32x4*)(rowp + bj * 128) = w; } }
        } else {
            const int col0 = wc * 32 + 8 * fq;
#pragma unroll
            EPI_LOOP_ROWS { const int row = row0 + ai * 128 + m * 16; const float rs = row_rstd(SS, row); float* rowp = Sm + (size_t)row * 256 + col0;
#pragma unroll
                for (int bj = 0; bj < 2; ++bj) { *(f32x4*)(rowp + bj * 128) = acc[ai][bj][m][0] * rs; *(f32x4*)(rowp + bj * 128 + 4) = acc[ai][bj][m][1] * rs; } }
        }
    }
};
struct EpiGate0 {
    static constexpr bool PERM = false;
    const bf16* P; float* M0;
    __device__ __forceinline__ void operator()(const f32x4 (&acc)[2][2][4][2], const Unit& u, int wr, int wc, int fr, int fq) const {
        const int row0 = u.pm * 256 + wr * 64 + fr, col0 = u.pn * 256 + wc * 32 + 4 * fq;
#pragma unroll
        EPI_LOOP_ROWS { const size_t r = (size_t)(row0 + ai * 128 + m * 16);
#pragma unroll
            for (int bj = 0; bj < 2; ++bj)
#pragma unroll
                for (int n = 0; n < 2; ++n) { const int c = col0 + bj * 128 + n * 16; const u32x2 gw = *(const u32x2*)(P + r * NPROJ + PGATE + c); const f32x4 a = acc[ai][bj][m][n];
                    f32x4 o; o[0] = a[0] * sigmoidf_(bf_lo(gw.x)); o[1] = a[1] * sigmoidf_(bf_hi(gw.x)); o[2] = a[2] * sigmoidf_(bf_lo(gw.y)); o[3] = a[3] * sigmoidf_(bf_hi(gw.y));
                    *(f32x4*)(M0 + r * DM + c) = o; } }
    }
};
struct EpiGate1 {
    static constexpr bool PERM = true;
    const bf16* P; const float* M0; bf16* O;
    __device__ __forceinline__ void operator()(const f32x4 (&acc)[2][2][4][2], const Unit& u, int wr, int wc, int fr, int fq) const {
        const int row0 = u.pm * 256 + wr * 64 + fr, col0 = u.pn * 256 + wc * 32 + 8 * fq;
#pragma unroll
        EPI_LOOP_ROWS { const size_t r = (size_t)(row0 + ai * 128 + m * 16);
#pragma unroll
            for (int bj = 0; bj < 2; ++bj) { const int c = col0 + bj * 128; const u32x4 gw = *(const u32x4*)(P + r * NPROJ + PGATE + DM + c); float gv[8]; unpack8(gw, gv);
                const f32x4 m0 = *(const f32x4*)(M0 + r * DM + c), m1 = *(const f32x4*)(M0 + r * DM + c + 4); const f32x4 a0 = acc[ai][bj][m][0], a1 = acc[ai][bj][m][1];
                float o[8];
#pragma unroll
                for (int j = 0; j < 4; ++j) { o[j] = m0[j] + a0[j] * sigmoidf_(gv[j]); o[4 + j] = m1[j] + a1[j] * sigmoidf_(gv[4 + j]); }
                *(u32x4*)(O + r * DM + c) = pack8(o); } }
    }
};
struct EpiResid {
    static constexpr bool PERM = false;
    float* X; bf16* H; float* SS;
    __device__ __forceinline__ void operator()(const f32x4 (&acc)[2][2][4][2], const Unit& u, int wr, int wc, int fr, int fq) const {
        const int row0 = u.pm * 256 + wr * 64 + fr, col0 = u.pn * 256 + wc * 32 + 4 * fq;
#pragma unroll
        EPI_LOOP_ROWS { const int row = row0 + ai * 128 + m * 16; float* rowp = X + (size_t)row * DM + col0; bf16* hp = H + (size_t)row * DM + col0; float ss = 0.f;
#pragma unroll
            for (int bj = 0; bj < 2; ++bj)
#pragma unroll
                for (int n = 0; n < 2; ++n) { f32x4* p = (f32x4*)(rowp + bj * 128 + n * 16); const f32x4 x = *p + acc[ai][bj][m][n]; *p = x;
                    ss += (x[0] * x[0] + x[1] * x[1]) + (x[2] * x[2] + x[3] * x[3]);
                    u32x2 w; w.x = cvt_pk_bf16(x[0], x[1]); w.y = cvt_pk_bf16(x[2], x[3]); *(u32x2*)(hp + bj * 128 + n * 16) = w; }
            ss += __shfl_xor(ss, 16); ss += __shfl_xor(ss, 32);
            if (fq == 0) atomicAdd(SS + row, ss); }
    }
};
struct EpiMemKV {
    static constexpr bool PERM = false;
    float* out; bf16* KP; bf16* VTP;
    __device__ __forceinline__ void operator()(const f32x4 (&acc)[2][2][4][2], const Unit& u, int wr, int wc, int fr, int fq) const {
        const int row0 = u.pm * 256 + wr * 64 + fr, colt = u.pn * 256, l = colt / 4096, kv = (colt / 2048) & 1, cbase = (colt & 2047) + wc * 32 + 4 * fq;
        float* dst = out + (kv ? O_PMV : O_PMK) + (size_t)l * NB * MTOK * DM;
#pragma unroll
        EPI_LOOP_ROWS { const int r = row0 + ai * 128 + m * 16, b = r >> 8, mt = r & 255;
#pragma unroll
            for (int bj = 0; bj < 2; ++bj)
#pragma unroll
                for (int n = 0; n < 2; ++n) { const int c = cbase + bj * 128 + n * 16; const f32x4 a = acc[ai][bj][m][n];
                    *(f32x4*)(dst + (size_t)r * DM + c) = a;
                    if (!kv) { u32x2 w; w.x = cvt_pk_bf16(a[0], a[1]); w.y = cvt_pk_bf16(a[2], a[3]); *(u32x2*)(KP + ((size_t)l * NB * MTOK + r) * DM + c) = w; }
                    else { bf16* vt = VTP + (((size_t)l * NB + b) * DM + c) * MTOK + mt;
#pragma unroll
                        for (int j = 0; j < 4; ++j) vt[(size_t)j * MTOK] = (bf16)f2bf(a[j]); } } }
    }
};

struct Args { const float* in[33]; float* out; unsigned char* ws; int ph_lo, ph_hi; };
#ifdef HOST_EMU
struct Ctx {
    LAS unsigned char* lds; int tid, lane, wave, G, bid;
    const Args* ap; float* out; unsigned char* ws;
    __device__ __forceinline__ const float* in(int i) const { return ap->in[i]; }
};
#else
#define CAS __attribute__((address_space(4)))
struct Ctx {
    LAS unsigned char* lds; int tid, lane, wave, G, bid;
    const CAS unsigned char* kp; float* out; unsigned char* ws;
    __device__ __forceinline__ const float* in(int i) const { return ((const float* const CAS*)kp)[i]; }
};
#endif
#ifdef HOST_EMU
#define SPIN_PAUSE() emu_yield()
#else
#define SPIN_PAUSE() __builtin_amdgcn_s_sleep(1)
#endif
#define WSP(type, off) ((type*)(C.ws + (off)))

template <class RowMap>
__device__ __forceinline__ void transpose_item(const float* W, int K, int N, bf16* WT, const float* gain, LAS float* scr, int item, int lane, RowMap rowmap) {
    const int nblk = (N + 31) / 32, kb = item / nblk, nb = item % nblk, k0 = 64 * kb, n0 = 32 * nb;
    float vv[32]; const int nn = n0 + (lane & 31); const bool nok = nn < N; const float* wp = W + (size_t)(k0 + (lane >> 5)) * N + (nok ? nn : 0);
#pragma unroll
    for (int i = 0; i < 32; ++i) vv[i] = nok ? wp[(size_t)(2 * i) * N] : 0.f;
    if (gain) {
#pragma unroll
        for (int i = 0; i < 32; ++i) vv[i] *= gain[k0 + 2 * i + (lane >> 5)]; }
#pragma unroll
    for (int i = 0; i < 32; ++i) scr[(2 * i + (lane >> 5)) * 33 + (lane & 31)] = vv[i];
    WAVE_LDS_SYNC();
    const int c = lane & 7;
#pragma unroll
    for (int j = 0; j < 4; ++j) { const int n = (lane >> 3) + 8 * j; const LAS float* s = scr + (8 * c) * 33 + n;
        if (n0 + n < N) { u32x4 o; o.x = cvt_pk_bf16(s[0 * 33], s[1 * 33]); o.y = cvt_pk_bf16(s[2 * 33], s[3 * 33]); o.z = cvt_pk_bf16(s[4 * 33], s[5 * 33]); o.w = cvt_pk_bf16(s[6 * 33], s[7 * 33]);
            *(u32x4*)(WT + (size_t)rowmap(n0 + n) * K + k0 + 8 * c) = o; } }
    WAVE_LDS_SYNC();
}
struct RowId { int off; __device__ __forceinline__ int operator()(int n) const { return off + n; } };
struct RowWin { __device__ __forceinline__ int operator()(int n) const {
    return n < 5120 ? n : n < 5152 ? NPROJ + (n - 5120) : n < 11296 ? n - 32 : n < 11312 ? NPROJ + 32 + (n - 11296) : n - 48; } };

__device__ __forceinline__ void phase_wconv(const Ctx& C, int l, int kvb = 0) {
    LAS float* scr = (LAS float*)(C.lds + C.wave * 16384);
    const int gw = C.bid * 8 + C.wave, NGW = C.G * 8;
    const int I_IN = (DM / 64) * ((IN_DIM + 31) / 32), I_SQ = (DM / 64) * (DM / 32), I_FI = (DM / 64) * (DFF2 / 32), I_FO = (DFF / 64) * (DM / 32);
    const int NIT = I_IN + 5 * I_SQ + I_FI + I_FO;
    const int NA = (kvb > 0 && kvb < C.G) ? (int)(((long)NIT * 8) / 25) : 0;
    const int itA = C.bid >= kvb ? (C.bid - kvb) * 8 + C.wave : NA, stA = (C.G - kvb) * 8;
    for (int pass = (NA > 0 ? 0 : 1); pass < 2; ++pass)
    for (int it = pass ? NA + gw : itA; it < (pass ? NIT : NA); it += (pass ? NGW : stA)) {
        int r = it;
        if (r < I_IN) { transpose_item(C.in(10) + (size_t)l * DM * IN_DIM, DM, IN_DIM, WSP(bf16, WS_WIN), C.in(9) + l * DM, scr, r, C.lane, RowWin{}); continue; } r -= I_IN;
        if (r < I_SQ) { transpose_item(C.in(20) + (size_t)(l * 2 + 0) * DM * DM, DM, DM, WSP(bf16, WS_WB0), (const float*)nullptr, scr, r, C.lane, RowId{0}); continue; } r -= I_SQ;
        if (r < I_SQ) { transpose_item(C.in(20) + (size_t)(l * 2 + 1) * DM * DM, DM, DM, WSP(bf16, WS_WB1), (const float*)nullptr, scr, r, C.lane, RowId{0}); continue; } r -= I_SQ;
        if (r < I_SQ) { transpose_item(C.in(21) + (size_t)l * DM * DM, DM, DM, WSP(bf16, WS_WOUT), (const float*)nullptr, scr, r, C.lane, RowId{0}); continue; } r -= I_SQ;
        if (r < I_SQ) { transpose_item(C.in(23) + (size_t)l * DM * DM, DM, DM, WSP(bf16, WS_WMQ), C.in(22) + l * DM, scr, r, C.lane, RowId{0}); continue; } r -= I_SQ;
        if (r < I_SQ) { transpose_item(C.in(26) + (size_t)l * DM * DM, DM, DM, WSP(bf16, WS_WMO), (const float*)nullptr, scr, r, C.lane, RowId{0}); continue; } r -= I_SQ;
        if (r < I_FI) { transpose_item(C.in(28) + (size_t)l * DM * DFF2, DM, DFF2, WSP(bf16, WS_WFI), C.in(27) + l * DM, scr, r, C.lane, RowId{0}); continue; } r -= I_FI;
        transpose_item(C.in(31) + (size_t)l * DFF * DM, DFF, DM, WSP(bf16, WS_WFO), (const float*)nullptr, scr, r, C.lane, RowId{0});
    }
    { u32x4* z = (u32x4*)(WSP(bf16, WS_WIN) + (size_t)(NPROJ + 48) * DM); const size_t n16 = (size_t)(NPROJ_PAD - NPROJ - 48) * DM * 2 / 16;
      for (size_t i = (size_t)C.bid * 512 + C.tid; i < n16; i += (size_t)C.G * 512) z[i] = zero16(); }
}
__device__ __forceinline__ void phase_prologue(const Ctx& C) {
    const size_t gt = (size_t)C.bid * 512 + C.tid, NT = (size_t)C.G * 512;
    { const f32x4* s = (const f32x4*)C.in(2); u32x2* d = WSP(u32x2, WS_MEMP); const size_t n = (size_t)NB * MTOK * DM / 4;
      for (size_t i = gt; i < n; i += NT) { const f32x4 v = s[i]; u32x2 w; w.x = cvt_pk_bf16(v[0], v[1]); w.y = cvt_pk_bf16(v[2], v[3]); d[i] = w; } }
    { const f32x4* s = (const f32x4*)C.in(7); u32x2* d = WSP(u32x2, WS_KS); const size_t n = (size_t)2 * SBT * MTOK * DM / 4;
      for (size_t i = gt; i < n; i += NT) { const f32x4 v = s[i]; u32x2 w; w.x = cvt_pk_bf16(v[0], v[1]); w.y = cvt_pk_bf16(v[2], v[3]); d[i] = w; } }
    LAS float* scr = (LAS float*)(C.lds + C.wave * 16384);
    const int gw = C.bid * 8 + C.wave, NGW = C.G * 8;
    const int I_V = (MTOK / 64) * (DM / 32), I_SQ = (DM / 64) * (DM / 32);
    const int NIT = 2 * SBT * I_V + 4 * I_SQ;
    for (int it = gw; it < NIT; it += NGW) {
        if (it < 2 * SBT * I_V) { const int lb = it / I_V, r = it % I_V;
            transpose_item(C.in(8) + (size_t)lb * MTOK * DM, MTOK, DM, WSP(bf16, WS_VTS) + (size_t)lb * DM * MTOK, (const float*)nullptr, scr, r, C.lane, RowId{0}); }
        else { const int q = (it - 2 * SBT * I_V) / I_SQ, r = (it - 2 * SBT * I_V) % I_SQ, l = q >> 1, kv = q & 1;
            transpose_item(C.in(kv ? 25 : 24) + (size_t)l * DM * DM, DM, DM, WSP(bf16, WS_WKV), (const float*)nullptr, scr, r, C.lane, RowId{q * DM}); }
    }
}
__device__ __forceinline__ void phase_xprep(const Ctx& C) {
    const int gw = C.bid * 8 + C.wave, NGW = C.G * 8;
    for (int row = gw; row < T; row += NGW) {
        const f32x4* xr = (row < TP ? (const f32x4*)C.in(0) + (size_t)row * (DM / 4) : (const f32x4*)C.in(1) + (size_t)(row - TP) * (DM / 4)) + C.lane; f32x4 v[8]; float s = 0.f;
#pragma unroll
        for (int j = 0; j < 8; ++j) { v[j] = xr[64 * j]; s += (v[j][0] * v[j][0] + v[j][1] * v[j][1]) + (v[j][2] * v[j][2] + v[j][3] * v[j][3]); }
        s = wave_sum(s); if (C.lane == 0) WSP(float, WS_SS)[row] = s;
        u32x2* o = WSP(u32x2, WS_H) + (size_t)row * (DM / 4) + C.lane; f32x4* xo = WSP(f32x4, WS_X) + (size_t)row * (DM / 4) + C.lane;
#pragma unroll
        for (int j = 0; j < 8; ++j) { u32x2 w; w.x = cvt_pk_bf16(v[j][0], v[j][1]); w.y = cvt_pk_bf16(v[j][2], v[j][3]); o[64 * j] = w; xo[64 * j] = v[j]; }
    }
}
__device__ __forceinline__ void phase_final(const Ctx& C) {
    const int gw = C.bid * 8 + C.wave, NGW = C.G * 8; const f32x4* gn = (const f32x4*)C.in(32) + C.lane;
    for (int row = gw; row < T; row += NGW) {
        const f32x4* xr = WSP(const f32x4, WS_X) + (size_t)row * (DM / 4) + C.lane; f32x4 v[8];
#pragma unroll
        for (int j = 0; j < 8; ++j) v[j] = xr[64 * j];
        const float rstd = row_rstd(WSP(const float, WS_SS) + (size_t)6 * T, row);
        f32x4* o = (f32x4*)(C.out + O_Y) + (size_t)row * (DM / 4) + C.lane;
#pragma unroll
        for (int j = 0; j < 8; ++j) o[64 * j] = v[j] * rstd * gn[64 * j];
    }
}
struct SeqInfo { int sample, b, t, L, row0; };
__device__ __forceinline__ SeqInfo seq_of_row(int row) { SeqInfo s; if (row < TP) { s.sample = 0; s.b = row / SEQ; s.t = row % SEQ; s.L = SEQ; s.row0 = s.b * SEQ; } else { const int r = row - TP; s.sample = 1; s.b = r / SSQ; s.t = r % SSQ; s.L = SSQ; s.row0 = TP + s.b * SSQ; } return s; }
__device__ __forceinline__ SeqInfo seq_of_idx(int sq) { SeqInfo s; if (sq < NB) { s.sample = 0; s.b = sq; s.L = SEQ; s.row0 = sq * SEQ; } else { s.sample = 1; s.b = sq - NB; s.L = SSQ; s.row0 = TP + s.b * SSQ; } s.t = 0; return s; }

__device__ __forceinline__ void phase_prep_conv(const Ctx& C, int l) {
    const size_t gt = (size_t)C.bid * 512 + C.tid, NT = (size_t)C.G * 512;
    const bf16* P = WSP(const bf16, WS_PROJ); const float* Sm = WSP(const float, WS_SMALL);
    const float* cw = C.in(11) + (size_t)l * 4 * XBCW; const float* cb = C.in(12) + (size_t)l * XBCW; const float* st = C.in(4) + (size_t)l * SBT * 3 * XBCW;
    for (size_t it = gt; it < (size_t)(T / 16) * (XBCW / 8); it += NT) {
        const int seg = (int)(it / (XBCW / 8)), c = (int)(it % (XBCW / 8)) * 8, row0 = seg * 16; const SeqInfo s = seq_of_row(row0);
        u32x4 raw[19];
#pragma unroll
        for (int i = 0; i < 16; ++i) raw[3 + i] = *(const u32x4*)(P + (size_t)(row0 + i) * NPROJ + PXBC + c);
        float w[4][8], bias[8];
#pragma unroll
        for (int i = 0; i < 4; ++i) { const f32x4 a = *(const f32x4*)(cw + i * XBCW + c), b = *(const f32x4*)(cw + i * XBCW + c + 4);
#pragma unroll
            for (int j = 0; j < 4; ++j) { w[i][j] = a[j]; w[i][4 + j] = b[j]; } }
        { const f32x4 a = *(const f32x4*)(cb + c), b = *(const f32x4*)(cb + c + 4);
#pragma unroll
          for (int j = 0; j < 4; ++j) { bias[j] = a[j]; bias[4 + j] = b[j]; } }
        float hist[3][8];
        if (s.t >= 3) {
#pragma unroll
            for (int i = 0; i < 3; ++i) { raw[i] = *(const u32x4*)(P + (size_t)(row0 - 3 + i) * NPROJ + PXBC + c); unpack8(raw[i], hist[i]); } }
        else if (s.sample) {
#pragma unroll
            for (int i = 0; i < 3; ++i) { const float* sp = st + ((size_t)s.b * 3 + i) * XBCW + c;
#pragma unroll
                for (int j = 0; j < 8; ++j) hist[i][j] = sp[j]; } }
        else {
#pragma unroll
            for (int i = 0; i < 3; ++i)
#pragma unroll
                for (int j = 0; j < 8; ++j) hist[i][j] = 0.f; }
#pragma unroll
        for (int i = 0; i < 16; ++i) { float cur[8], o[8]; unpack8(raw[3 + i], cur);
#pragma unroll
            for (int j = 0; j < 8; ++j) { o[j] = siluf_(bias[j] + hist[0][j] * w[0][j] + hist[1][j] * w[1][j] + hist[2][j] * w[2][j] + cur[j] * w[3][j]); hist[0][j] = hist[1][j]; hist[1][j] = hist[2][j]; hist[2][j] = cur[j]; }
            *(u32x4*)(WSP(bf16, WS_XBC) + (size_t)(row0 + i) * XBCW + c) = pack8(o); }
    }
    for (size_t it = gt; it < (size_t)NSEQ * 3 * XBCW; it += NT) {
        const int c = (int)(it % XBCW), j = (int)(it / XBCW) % 3, sq = (int)(it / (3 * XBCW)); const SeqInfo s = seq_of_idx(sq);
        const float v = bf2f(P[(size_t)(s.row0 + s.L - 3 + j) * NPROJ + PXBC + c]);
        float* dst = C.out + (s.sample ? O_SSSDC + ((size_t)l * SBT + s.b) * 3 * XBCW : O_PSSDC + ((size_t)l * NB + s.b) * 3 * XBCW);
        dst[j * XBCW + c] = v;
    }
    for (size_t it = gt; it < (size_t)T * 32; it += NT) { const int row = (int)(it >> 5), h = (int)(it & 31);
        WSP(float, WS_DT)[it] = softplusf_(Sm[(size_t)row * 256 + h] + C.in(13)[l * 32 + h]); }
}

typedef short bf16x4 __attribute__((ext_vector_type(4)));
#define MFMA32(a, b, c) __builtin_amdgcn_mfma_f32_16x16x32_bf16(a, b, c, 0, 0, 0)
#define MFMA16(a, b, c) __builtin_amdgcn_mfma_f32_16x16x16bf16_1k(a, b, c, 0, 0, 0)
__device__ __forceinline__ bf16x8 mk8(u32x2 lo, u32x2 hi) { u32x4 w; w.x = lo.x; w.y = lo.y; w.z = hi.x; w.w = hi.y; return __builtin_bit_cast(bf16x8, w); }
__device__ __forceinline__ bf16x8 pack_tiles(const f32x4 t0, const f32x4 t1) { u32x4 w; w.x = cvt_pk_bf16(t0[0], t0[1]); w.y = cvt_pk_bf16(t0[2], t0[3]); w.z = cvt_pk_bf16(t1[0], t1[1]); w.w = cvt_pk_bf16(t1[2], t1[3]); return __builtin_bit_cast(bf16x8, w); }
struct ChunkInfo { int row0, nvalid; };
__device__ __forceinline__ ChunkInfo ssd_chunk(int cs) { ChunkInfo c; if (cs < NCP) { c.row0 = 64 * cs; c.nvalid = 64; } else { c.row0 = TP + SSQ * (cs - NCP); c.nvalid = SSQ; } return c; }

__device__ __forceinline__ void gla_prep_task(const Ctx& C, int l, int ck, int h) {
    const int lane = C.lane, fr = lane & 15, fq = lane >> 4, k4 = 4 * lane;
    LAS bf16* Lq = (LAS bf16*)(C.lds + C.wave * 16384); LAS bf16* Lk = Lq + 16 * 256;
    const bf16* P = WSP(const bf16, WS_PROJ); const float* Sm = WSP(const float, WS_SMALL);
    f32x4 bc[16]; f32x4 run = (f32x4){0.f, 0.f, 0.f, 0.f};
    { const float* wa2 = C.in(17) + (size_t)l * 16 * 1024 + h * 256 + k4; f32x4 wv[16];
#pragma unroll
      for (int r = 0; r < 16; ++r) wv[r] = *(const f32x4*)(wa2 + r * 1024);
      const f32x4 bav = *(const f32x4*)(C.in(18) + (size_t)l * 1024 + h * 256 + k4);
#pragma unroll
      for (int i = 0; i < 16; ++i) { const float* ar = Sm + (size_t)(16 * ck + i) * 256 + 32; f32x4 a = bav;
#pragma unroll
          for (int r4 = 0; r4 < 4; ++r4) { const f32x4 av = *(const f32x4*)(ar + 4 * r4);
#pragma unroll
              for (int q = 0; q < 4; ++q) a = a + wv[4 * r4 + q] * av[q]; }
#pragma unroll
          for (int j = 0; j < 4; ++j) run[j] += logsigmoidf_(a[j]) * (1.0f / 16.0f);
          bc[i] = run; } }
    const f32x4 b15 = bc[15];
    unsigned ke[4][8];
#pragma unroll
    for (int i = 0; i < 16; ++i) { const size_t row = (size_t)(16 * ck + i);
        const u32x2 qw = *(const u32x2*)(P + row * NPROJ + PQ + h * 256 + k4), kw = *(const u32x2*)(P + row * NPROJ + PK + h * 256 + k4);
        const float qv[4] = {bf_lo(qw.x), bf_hi(qw.x), bf_lo(qw.y), bf_hi(qw.y)}, kv[4] = {bf_lo(kw.x), bf_hi(kw.x), bf_lo(kw.y), bf_hi(kw.y)};
        float qd[4], ki[4], kend[4];
#pragma unroll
        for (int j = 0; j < 4; ++j) { qd[j] = qv[j] * 0.0625f * __expf(bc[i][j]); ki[j] = kv[j] * __expf(-bc[i][j]); kend[j] = kv[j] * __expf(b15[j] - bc[i][j]); }
        u32x2 w; w.x = cvt_pk_bf16(qd[0], qd[1]); w.y = cvt_pk_bf16(qd[2], qd[3]);
        *(u32x2*)(WSP(bf16, WS_QD) + row * 1024 + h * 256 + k4) = w; *(LAS u32x2*)(Lq + i * 256 + k4) = w;
        u32x2 w2; w2.x = cvt_pk_bf16(ki[0], ki[1]); w2.y = cvt_pk_bf16(ki[2], ki[3]); *(LAS u32x2*)(Lk + i * 256 + k4) = w2;
#pragma unroll
        for (int j = 0; j < 4; ++j) { if (i & 1) ke[j][i >> 1] |= f2bf(kend[j]) << 16; else ke[j][i >> 1] = f2bf(kend[j]); } }
#pragma unroll
    for (int j = 0; j < 4; ++j) { u32x4* d = (u32x4*)(WSP(bf16, WS_KET) + ((size_t)ck * 1024 + h * 256 + k4 + j) * 16);
        d[0] = (u32x4){ke[j][0], ke[j][1], ke[j][2], ke[j][3]}; d[1] = (u32x4){ke[j][4], ke[j][5], ke[j][6], ke[j][7]}; }
    { f32x4 dv; dv[0] = __expf(b15[0]); dv[1] = __expf(b15[1]); dv[2] = __expf(b15[2]); dv[3] = __expf(b15[3]); *(f32x4*)(WSP(float, WS_DEC) + (size_t)ck * 1024 + h * 256 + k4) = dv; }
    WAVE_LDS_SYNC();
    f32x4 att = (f32x4){0.f, 0.f, 0.f, 0.f};
#pragma unroll
    for (int ks = 0; ks < 8; ++ks) { const bf16x8 a = *(const LAS bf16x8*)(Lq + fr * 256 + 32 * ks + 8 * fq), b = *(const LAS bf16x8*)(Lk + fr * 256 + 32 * ks + 8 * fq); att = MFMA32(a, b, att); }
#pragma unroll
    for (int r = 0; r < 4; ++r) { const int i = 4 * fq + r; WSP(bf16, WS_ATT)[(((size_t)ck * 4 + h) * 16 + i) * 16 + fr] = (bf16)(fr <= i ? f2bf(att[r]) : 0u); }
    WAVE_LDS_SYNC();
    unsigned vt[8][8];
#pragma unroll
    for (int i = 0; i < 16; ++i) { float vv[8]; unpack8(*(const u32x4*)(P + (size_t)(16 * ck + i) * NPROJ + PV + h * 512 + 8 * lane), vv);
#pragma unroll
        for (int j = 0; j < 8; ++j) { if (i & 1) vt[j][i >> 1] |= f2bf(vv[j]) << 16; else vt[j][i >> 1] = f2bf(vv[j]); } }
#pragma unroll
    for (int j = 0; j < 8; ++j) { u32x4* d = (u32x4*)(WSP(bf16, WS_VT16) + ((size_t)ck * DM + h * 512 + 8 * lane + j) * 16);
        d[0] = (u32x4){vt[j][0], vt[j][1], vt[j][2], vt[j][3]}; d[1] = (u32x4){vt[j][4], vt[j][5], vt[j][6], vt[j][7]}; }
}
__device__ __forceinline__ void ssd_prep_head(const Ctx& C, int l, int cs, int h) {
    const int lane = C.lane, fr = lane & 15, fq = lane >> 4, g = h >> 3; const ChunkInfo ci = ssd_chunk(cs);
    LAS float* La = (LAS float*)(C.lds + C.wave * 16384); LAS float* Ld = La + 64;
    const bf16* XB = WSP(const bf16, WS_XBC); const float* DT = WSP(const float, WS_DT);
    const bf16x8 z8 = zero8h();
    f32x4 cb[4][4];
#pragma unroll
    for (int mt = 0; mt < 4; ++mt)
#pragma unroll
        for (int nt = 0; nt < 4; ++nt) cb[mt][nt] = (f32x4){0.f, 0.f, 0.f, 0.f};
#pragma unroll
    for (int ks = 0; ks < 4; ++ks) { bf16x8 af[4], bfr[4];
#pragma unroll
        for (int t = 0; t < 4; ++t) { const int i = 16 * t + fr; const bool ok = i < ci.nvalid; const bf16* rp = XB + (size_t)(ci.row0 + (ok ? i : 0)) * XBCW + g * 128 + 32 * ks + 8 * fq;
            af[t] = ok ? *(const bf16x8*)(rp + 2560) : z8; bfr[t] = ok ? *(const bf16x8*)(rp + 2048) : z8; }
#pragma unroll
        for (int mt = 0; mt < 4; ++mt)
#pragma unroll
            for (int nt = 0; nt <= mt; ++nt) cb[mt][nt] = MFMA32(af[mt], bfr[nt], cb[mt][nt]); }
    const bool jok = lane < ci.nvalid; const size_t jrow = (size_t)(ci.row0 + (jok ? lane : 0));
    const float a = -__expf(C.in(14)[l * 32 + h]); const float dtj = jok ? DT[jrow * 32 + h] : 0.f;
    float ac = dtj * a;
#pragma unroll
    for (int d = 1; d < 64; d <<= 1) { const float t = __shfl(ac, (lane - d) & 63); if (lane >= d) ac += t; }
    const float a63 = __shfl(ac, 63), te = __expf(a63 - ac) * dtj;
    La[lane] = ac; Ld[lane] = dtj;
    WSP(float, WS_EA)[((size_t)cs * 32 + h) * 64 + lane] = __expf(ac);
    if (lane == 0) WSP(float, WS_DECS)[(size_t)cs * 32 + h] = __expf(a63);
    u32x4 xr[8];
#pragma unroll
    for (int p8 = 0; p8 < 8; ++p8) xr[p8] = jok ? *(const u32x4*)(XB + jrow * XBCW + h * 64 + 8 * p8) : zero16();
#pragma unroll
    for (int p8 = 0; p8 < 8; ++p8) { float xv[8]; unpack8(xr[p8], xv);
#pragma unroll
        for (int q = 0; q < 8; ++q) { const size_t o = ((size_t)cs * DM + h * 64 + 8 * p8 + q) * 64 + lane; WSP(bf16, WS_XT)[o] = (bf16)f2bf(xv[q]); WSP(bf16, WS_XTE)[o] = (bf16)f2bf(xv[q] * te); } }
    WAVE_LDS_SYNC();
#pragma unroll
    for (int mt = 0; mt < 4; ++mt)
#pragma unroll
        for (int nt = 0; nt < 4; ++nt) { const int j = 16 * nt + fr; const float aj = La[j], dj = Ld[j];
#pragma unroll
            for (int r = 0; r < 4; ++r) { const int i = 16 * mt + 4 * fq + r; const float w = (nt <= mt && j <= i) ? cb[mt][nt][r] * __expf(La[i] - aj) * dj : 0.f;
                WSP(bf16, WS_WCH)[(((size_t)cs * 32 + h) * 64 + i) * 64 + j] = (bf16)f2bf(w); } }
    WAVE_LDS_SYNC();
}
__device__ __forceinline__ void ssd_prep_group(const Ctx& C, int cs, int g) {
    const int lane = C.lane; const ChunkInfo ci = ssd_chunk(cs); const bf16* XB = WSP(const bf16, WS_XBC);
    const bool jok = lane < ci.nvalid; const size_t jrow = (size_t)(ci.row0 + (jok ? lane : 0));
#pragma unroll 4
    for (int n8 = 0; n8 < 16; ++n8) { float bv[8];
        if (jok) unpack8(*(const u32x4*)(XB + jrow * XBCW + 2048 + g * 128 + 8 * n8), bv); else {
#pragma unroll
            for (int q = 0; q < 8; ++q) bv[q] = 0.f; }
#pragma unroll
        for (int q = 0; q < 8; ++q) WSP(bf16, WS_BT)[((size_t)cs * 512 + g * 128 + 8 * n8 + q) * 64 + lane] = (bf16)f2bf(bv[q]); }
#pragma unroll 4
    for (int it = 0; it < 16; ++it) { const int idx = it * 64 + lane, i = idx >> 4, n8 = idx & 15; const bool ok = i < ci.nvalid;
        const u32x4 v = ok ? *(const u32x4*)(XB + (size_t)(ci.row0 + i) * XBCW + 2560 + g * 128 + 8 * n8) : zero16();
        *(u32x4*)(WSP(bf16, WS_CC) + ((size_t)cs * 64 + i) * 512 + g * 128 + 8 * n8) = v; }
}
__device__ __forceinline__ void phase_prep(const Ctx& C, int l) {
    const int gw = C.wave * C.G + C.bid, NGW = C.G * 8;
    for (int t = gw; t < NCK * 4; t += NGW) gla_prep_task(C, l, t >> 2, t & 3);
    phase_prep_conv(C, l);
}
__device__ __forceinline__ void phase_chunkprep(const Ctx& C, int l) {
    const int gw = C.wave * C.G + C.bid, NGW = C.G * 8;
    constexpr int NHT = NCS * 32, NGT = NCS * 4;
    for (int t = gw; t < NHT + NGT; t += NGW) { if (t < NHT) ssd_prep_head(C, l, t >> 5, t & 31); else ssd_prep_group(C, (t - NHT) >> 2, (t - NHT) & 3); }
}
constexpr int GLA_SLOT = 18432, GLA_RING = 3 * GLA_SLOT;
#ifdef PROBE_AMP
#define PT_NOW() ((unsigned)__builtin_amdgcn_s_memrealtime())
#define PT_WORDS(C) ((unsigned*)((C).ws + WS_CTL + 32768))
#define PT_MAX(C, slot, dt) do { if ((C).lane == 0) atomicMax(PT_WORDS(C) + (slot), (unsigned)(dt)); } while (0)
#define PT_SUM(C, slot, dt) do { if ((C).lane == 0) atomicAdd(PT_WORDS(C) + (slot), (unsigned)(dt)); } while (0)
#define PT_BLK_ADD(C, k, dt) do { if ((C).tid == 0) atomicAdd(PT_WORDS(C) + 256 + (k) * 256 + (C).bid, (unsigned)(dt)); } while (0)
#else
#define PT_NOW() 0u
#define PT_MAX(C, slot, dt) ((void)0)
#define PT_BLK_ADD(C, k, dt) ((void)0)
#define PT_SUM(C, slot, dt) ((void)0)
#endif
template <int MODE>
__device__ __forceinline__ void gla_scan_task(const Ctx& C, int l, int sq, int h, int vs, LAS unsigned char* ring, unsigned ebase = 0u) {
    constexpr bool ONE = MODE == 1, PAIR = MODE == 2; constexpr int SLOTB = PAIR ? GLP_SLOT : GLA_SLOT;
    const int pw = C.wave & 1; volatile LAS unsigned* gfl = (volatile LAS unsigned*)(C.lds + LDS_CTL_OFF) + 32; (void)pw; (void)gfl;
    int lane = C.lane; LAUNDER_V(lane);
    const SeqInfo s = seq_of_idx(sq); const int fr = lane & 15, fq = lane >> 4, vc0 = h * 512 + vs * 16;
    f32x4 S[16];
    const size_t st_off = ((((size_t)l * (s.sample ? SBT : NB) + s.b) * 4 + h) * 256) * 512 + vs * 16;
    if (s.sample) { const float* st = C.in(5) + st_off;
#pragma unroll
        for (int kt = 0; kt < 16; ++kt)
#pragma unroll
            for (int r = 0; r < 4; ++r) S[kt][r] = st[(size_t)(16 * kt + 4 * fq + r) * 512 + fr]; }
    else {
#pragma unroll
        for (int kt = 0; kt < 16; ++kt) S[kt] = (f32x4){0.f, 0.f, 0.f, 0.f}; }
    VMCNT(0);
    const int nch = s.L / 16, ck0 = s.row0 / 16;
    const unsigned char* wsb = C.ws;
#define LDW(type, off) (*(const type*)(wsb + (off)))
    unsigned gq = (unsigned)(WS_QD + ((size_t)(16 * ck0 + (lane & 15)) * 1024 + h * 256) * 2 + (lane >> 4) * 16);
    unsigned gk = (unsigned)(WS_KET + ((size_t)ck0 * 1024 + h * 256) * 32 + lane * 16);
    unsigned gd = (unsigned)(WS_DEC + ((size_t)ck0 * 1024 + h * 256) * 4 + lane * 16);
    unsigned ga = lane < 32 ? (unsigned)(WS_ATT + (((size_t)ck0 * 4 + h) * 256) * 2 + lane * 16) : (unsigned)(WS_VT16 + (((size_t)ck0 * DM + vc0) * 16) * 2 + (lane - 32) * 16);
    const unsigned sa = lane < 32 ? 2048u : (unsigned)(DM * 16 * 2);
    unsigned gm = pw ? gk : gq; const unsigned mstr = pw ? 1024u : 64u, moff = pw ? 8192u : 0u, madv = pw ? (unsigned)(1024 * 32) : (unsigned)(16 * 2048), poff = PAIR ? 1024u * pw : 0u;
    (void)gm; (void)mstr; (void)moff; (void)madv;
#define GLA_PSYNC(val) do { const unsigned v_ = (val); if (lane == 0) gfl[pw] = v_; while ((int)(gfl[pw ^ 1] - v_) < 0) SPIN_PAUSE(); asm volatile("" ::: "memory"); } while (0)
#define GLA_DMA(slot) do { LAS unsigned char* sb_ = ring + (slot) * SLOTB; LAUNDER_V(gd); LAUNDER_V(ga);     \
        if constexpr (PAIR) { LAUNDER_V(gm); \
            _Pragma("unroll") for (int i = 0; i < 8; ++i) __builtin_amdgcn_global_load_lds((const unsigned*)(wsb + gm + i * mstr), (LAS unsigned*)(sb_ + moff + i * 1024), 16, 0, 0); } \
        else { LAUNDER_V(gq); LAUNDER_V(gk); \
            _Pragma("unroll") for (int i = 0; i < 8; ++i) { \
                __builtin_amdgcn_global_load_lds((const unsigned*)(wsb + gq + i * 64), (LAS unsigned*)(sb_ + i * 1024), 16, 0, 0); \
                __builtin_amdgcn_global_load_lds((const unsigned*)(wsb + gk + i * 1024), (LAS unsigned*)(sb_ + 8192 + i * 1024), 16, 0, 0); } } \
        __builtin_amdgcn_global_load_lds((const unsigned*)(wsb + gd), (LAS unsigned*)(sb_ + 16384), 16, 0, 0); \
        __builtin_amdgcn_global_load_lds((const unsigned*)(wsb + ga), (LAS unsigned*)(sb_ + 17408 + poff), 16, 0, 0); } while (0)
#define GLA_ADV(on) do { const unsigned a_ = (on) ? 1u : 0u; if constexpr (PAIR) gm += a_ * madv; else { gq += a_ * (16 * 2048); gk += a_ * (1024 * 32); } gd += a_ * 4096; ga += a_ * sa; } while (0)
    GLA_DMA(0); if constexpr (!ONE) { GLA_ADV(1 < nch); GLA_DMA(1); GLA_ADV(2 < nch); }
    const int fh = fq & 1; const bool alo = fq < 2;
    const unsigned rq = (unsigned)(fr * 16 + 8 * fh + 256 * (fq >> 1));
    const unsigned rk = (unsigned)(8192 + fr * 32 + 16 * fh);
    const unsigned rat = (unsigned)(17408 + fr * 32 + 16 * fh) + poff, rv = rat + 512, rd = (unsigned)(16384 + 16 * fq);
    unsigned yo = (unsigned)(WS_YGR + ((size_t)(16 * ck0 + 4 * fq) * DM + vc0 + fr) * 4);
#define GLA_RD(G, D, K) _Pragma("unroll") for (int kt = 0; kt < 4; ++kt) { D[kt] = *(const LAS f32x4*)(sb + rd + 64 * (4 * (G) + kt)); K[kt] = *(const LAS bf16x8*)(sb + rk + 512 * (4 * (G) + kt)); }
#define GLA_UP(G, D, K) _Pragma("unroll") for (int kt = 0; kt < 4; ++kt) S[4 * (G) + kt] = MFMA32(K[kt], v0, S[4 * (G) + kt] * D[kt]);
#define GLA_DMA_QK(slot, P) do { LAS unsigned char* sb_ = ring + (slot) * SLOTB; \
        if constexpr (PAIR) { LAUNDER_V(gm); \
            _Pragma("unroll") for (int i = 2 * (P); i < 2 * (P) + 2; ++i) __builtin_amdgcn_global_load_lds((const unsigned*)(wsb + gm + i * mstr), (LAS unsigned*)(sb_ + moff + i * 1024), 16, 0, 0); } \
        else { LAUNDER_V(gq); LAUNDER_V(gk); \
            _Pragma("unroll") for (int i = 2 * (P); i < 2 * (P) + 2; ++i) { \
                __builtin_amdgcn_global_load_lds((const unsigned*)(wsb + gq + i * 64), (LAS unsigned*)(sb_ + i * 1024), 16, 0, 0); \
                __builtin_amdgcn_global_load_lds((const unsigned*)(wsb + gk + i * 1024), (LAS unsigned*)(sb_ + 8192 + i * 1024), 16, 0, 0); } } } while (0)
#define GLA_DMA_DA(slot) do { LAS unsigned char* sb_ = ring + (slot) * SLOTB; LAUNDER_V(gd); LAUNDER_V(ga); \
        __builtin_amdgcn_global_load_lds((const unsigned*)(wsb + gd), (LAS unsigned*)(sb_ + 16384), 16, 0, 0); \
        __builtin_amdgcn_global_load_lds((const unsigned*)(wsb + ga), (LAS unsigned*)(sb_ + 17408 + poff), 16, 0, 0); } while (0)
#ifdef PROBE_AMP
    unsigned ptw = 0;
#define PTW0 const unsigned w0_ = PT_NOW()
#define PTW1 ptw += PT_NOW() - w0_
#else
#define PTW0 ((void)0)
#define PTW1 ((void)0)
#endif
#define GLA_ITER(SL) do { \
        PTW0; if constexpr (ONE) VMCNT(0); else if constexpr (PAIR) { if (c == 0) VMCNT(10); else VMCNT(14); GLA_PSYNC(ebase + (unsigned)c + 1u); } else { if (c == 0) VMCNT(18); else VMCNT(22); } PTW1;               \
        __builtin_amdgcn_sched_barrier(0); \
        if constexpr (!ONE) GLA_DMA_QK(((SL) + 2) % 3, 0); \
        __builtin_amdgcn_sched_barrier(0); \
        const LAS unsigned char* sb = ring + (SL) * SLOTB; \
        u32x2 qa[8], qb[8]; f32x4 dA[4], dB[4]; bf16x8 kA[4], kB[4]; \
        _Pragma("unroll") for (int ks = 0; ks < 8; ++ks) { qa[ks] = *(const LAS u32x2*)(sb + rq + 1024 * ks); qb[ks] = *(const LAS u32x2*)(sb + rq + 1024 * ks + 512); } \
        const bf16x8 at = *(const LAS bf16x8*)(sb + rat); bf16x8 v0 = *(const LAS bf16x8*)(sb + rv); \
        GLA_RD(0, dA, kA) \
        __builtin_amdgcn_sched_barrier(0); \
        if (!alo) v0 = zero8h(); \
        f32x4 o0 = (f32x4){0.f, 0.f, 0.f, 0.f}; \
        _Pragma("unroll") for (int ks = 0; ks < 8; ++ks) o0 = MFMA32(mk8(qa[ks], qb[ks]), pack_tiles(S[2 * ks], S[2 * ks + 1]), o0); \
        o0 = MFMA32(at, v0, o0); \
        __builtin_amdgcn_sched_barrier(0); \
        GLA_RD(1, dB, kB) \
        if constexpr (!ONE) GLA_DMA_QK(((SL) + 2) % 3, 1); \
        _Pragma("unroll") for (int r = 0; r < 4; ++r) *(float*)(C.ws + yo + (unsigned)(r * DM * 4)) = o0[r]; \
        yo += 16 * DM * 4; \
        __builtin_amdgcn_sched_barrier(0); \
        GLA_UP(0, dA, kA) \
        __builtin_amdgcn_sched_barrier(0); \
        GLA_RD(2, dA, kA) \
        if constexpr (!ONE) GLA_DMA_QK(((SL) + 2) % 3, 2); \
        __builtin_amdgcn_sched_barrier(0); \
        GLA_UP(1, dB, kB) \
        __builtin_amdgcn_sched_barrier(0); \
        GLA_RD(3, dB, kB) \
        if constexpr (!ONE) GLA_DMA_QK(((SL) + 2) % 3, 3); \
        __builtin_amdgcn_sched_barrier(0); \
        GLA_UP(2, dA, kA) \
        __builtin_amdgcn_sched_barrier(0); \
        if constexpr (!ONE) { GLA_DMA_DA(((SL) + 2) % 3); GLA_ADV(c + 3 < nch); } \
        __builtin_amdgcn_sched_barrier(0); \
        GLA_UP(3, dB, kB) \
        ++c; } while (0)
    if constexpr (ONE) { int c = 0; GLA_ITER(0); (void)c; }
    else for (int c = 0; c < nch;) { GLA_ITER(0); if (c >= nch) break; GLA_ITER(1); if (c >= nch) break; GLA_ITER(2); }
#undef GLA_ITER
#ifdef PROBE_AMP
    if (nch > 64) PT_SUM(C, 10 + l, ptw);
#endif
#undef GLA_DMA_QK
#undef GLA_DMA_DA
    VMCNT(0);
    if constexpr (PAIR) GLA_PSYNC(ebase + (unsigned)nch + 1u);
#undef GLA_PSYNC
#undef GLA_DMA
#undef GLA_ADV
    int lane2 = C.lane; LAUNDER_V(lane2);
    float* dst = C.out + (s.sample ? O_SGLA : O_PGLA) + st_off + (size_t)(4 * (lane2 >> 4)) * 512 + (lane2 & 15);
#pragma unroll
    for (int kt = 0; kt < 16; ++kt)
#pragma unroll
        for (int r = 0; r < 4; ++r) dst[(size_t)(16 * kt + r) * 512] = S[kt][r];
}
__device__ __forceinline__ void ssd_scan_task(const Ctx& C, int l, int sq, int h, int ph) {
    const SeqInfo s = seq_of_idx(sq); const int lane = C.lane, fr = lane & 15, fq = lane >> 4, g = h >> 3, ch0 = h * 64 + ph * 32;
    f32x4 H[8][2];
    const size_t st_off = (((size_t)l * (s.sample ? SBT : NB) + s.b) * 32 + h) * 64 * 128;
    if (s.sample) { const float* st = C.in(3) + st_off;
#pragma unroll
        for (int nt = 0; nt < 8; ++nt)
#pragma unroll
            for (int pt = 0; pt < 2; ++pt) H[nt][pt] = *(const f32x4*)(st + (size_t)(ph * 32 + 16 * pt + fr) * 128 + 16 * nt + 4 * fq); }
    else {
#pragma unroll
        for (int nt = 0; nt < 8; ++nt) { H[nt][0] = (f32x4){0.f, 0.f, 0.f, 0.f}; H[nt][1] = (f32x4){0.f, 0.f, 0.f, 0.f}; } }
    const float Dh = C.in(15)[l * 32 + h];
    const int nch = s.sample ? 1 : SEQ / 64, cs0 = s.sample ? NCP + s.b : s.row0 / 64, nvalid = s.sample ? SSQ : 64;
    const unsigned char* wsb = C.ws;
    unsigned co = (unsigned)(WS_CC + (((size_t)cs0 * 64 + fr) * 512 + g * 128 + 4 * fq) * 2);
    unsigned eo = (unsigned)(WS_EA + (((size_t)cs0 * 32 + h) * 64 + fr) * 4);
    unsigned wo = (unsigned)(WS_WCH + ((((size_t)cs0 * 32 + h) * 64 + fr) * 64 + 8 * fq) * 2);
    unsigned xo = (unsigned)(WS_XT + (((size_t)cs0 * DM + ch0 + fr) * 64) * 2);
    unsigned xeo = (unsigned)(WS_XTE + (((size_t)cs0 * DM + ch0 + fr) * 64 + 8 * fq) * 2);
    unsigned bo = (unsigned)(WS_BT + (((size_t)cs0 * 512 + g * 128 + fr) * 64 + 8 * fq) * 2);
    unsigned deo = (unsigned)(WS_DECS + ((size_t)cs0 * 32 + h) * 4);
    unsigned yo = (unsigned)(WS_YSR + ((size_t)(s.row0 + fr) * DM + ch0 + 4 * fq) * 4);
    unsigned xbo = (unsigned)(WS_XBC + ((size_t)(s.row0 + fr) * XBCW + ch0 + 4 * fq) * 2);
#define SCHED_FENCE() __builtin_amdgcn_sched_barrier(0)
    for (int c = 0; c < nch; ++c) {
        u32x2 ca[4][4], cb2[4][4]; float ea[4];
#pragma unroll
        for (int mt = 0; mt < 4; ++mt) { ea[mt] = LDW(float, eo + 64 * mt);
#pragma unroll
            for (int ks = 0; ks < 4; ++ks) { ca[mt][ks] = LDW(u32x2, co + mt * 16384 + 64 * ks); cb2[mt][ks] = LDW(u32x2, co + mt * 16384 + 64 * ks + 32); } }
        f32x4 y[4][2];
#pragma unroll
        for (int mt = 0; mt < 4; ++mt) { y[mt][0] = (f32x4){0.f, 0.f, 0.f, 0.f}; y[mt][1] = (f32x4){0.f, 0.f, 0.f, 0.f}; }
        SCHED_FENCE();
#pragma unroll
        for (int ks = 0; ks < 2; ++ks) { const bf16x8 b0 = pack_tiles(H[2 * ks][0], H[2 * ks + 1][0]), b1 = pack_tiles(H[2 * ks][1], H[2 * ks + 1][1]);
#pragma unroll
            for (int mt = 0; mt < 4; ++mt) { const bf16x8 a = mk8(ca[mt][ks], cb2[mt][ks]); y[mt][0] = MFMA32(b0, a, y[mt][0]); y[mt][1] = MFMA32(b1, a, y[mt][1]); } }
        SCHED_FENCE();
        bf16x8 wf[6], xf[2][2]; u32x2 xd[4][2];
#pragma unroll
        for (int mt = 0; mt < 4; ++mt) wf[mt] = LDW(bf16x8, wo + mt * 2048);
        wf[4] = LDW(bf16x8, wo + 2 * 2048 + 64); wf[5] = LDW(bf16x8, wo + 3 * 2048 + 64);
#pragma unroll
        for (int pt = 0; pt < 2; ++pt) { xf[0][pt] = LDW(bf16x8, xo + pt * 2048 + 16 * fq); xf[1][pt] = LDW(bf16x8, xo + pt * 2048 + 64 + 16 * fq);
#pragma unroll
            for (int mt = 0; mt < 4; ++mt) xd[mt][pt] = LDW(u32x2, xbo + mt * (16 * XBCW * 2) + 32 * pt); }
        SCHED_FENCE();
#pragma unroll
        for (int ks = 2; ks < 4; ++ks) { const bf16x8 b0 = pack_tiles(H[2 * ks][0], H[2 * ks + 1][0]), b1 = pack_tiles(H[2 * ks][1], H[2 * ks + 1][1]);
#pragma unroll
            for (int mt = 0; mt < 4; ++mt) { const bf16x8 a = mk8(ca[mt][ks], cb2[mt][ks]); y[mt][0] = MFMA32(b0, a, y[mt][0]); y[mt][1] = MFMA32(b1, a, y[mt][1]); } }
#pragma unroll
        for (int mt = 0; mt < 4; ++mt) { y[mt][0] = y[mt][0] * ea[mt]; y[mt][1] = y[mt][1] * ea[mt]; }
        SCHED_FENCE();
        bf16x8 bt0[8], bt1[8], xe[2][2]; const float dec = LDW(float, deo);
#pragma unroll
        for (int nt = 0; nt < 8; ++nt) bt0[nt] = LDW(bf16x8, bo + nt * 2048);
        xe[0][0] = LDW(bf16x8, xeo); xe[0][1] = LDW(bf16x8, xeo + 2048);
        SCHED_FENCE();
#pragma unroll
        for (int mt = 0; mt < 4; ++mt) { y[mt][0] = MFMA32(xf[0][0], wf[mt], y[mt][0]); y[mt][1] = MFMA32(xf[0][1], wf[mt], y[mt][1]); }
        y[2][0] = MFMA32(xf[1][0], wf[4], y[2][0]); y[2][1] = MFMA32(xf[1][1], wf[4], y[2][1]); y[3][0] = MFMA32(xf[1][0], wf[5], y[3][0]); y[3][1] = MFMA32(xf[1][1], wf[5], y[3][1]);
#pragma unroll
        for (int mt = 0; mt < 4; ++mt)
#pragma unroll
            for (int pt = 0; pt < 2; ++pt) { const f32x4 xv = (f32x4){bf_lo(xd[mt][pt].x), bf_hi(xd[mt][pt].x), bf_lo(xd[mt][pt].y), bf_hi(xd[mt][pt].y)};
                if (16 * mt + fr < nvalid) *(f32x4*)(C.ws + yo + (unsigned)((16 * mt * DM + 16 * pt) * 4)) = y[mt][pt] + Dh * xv; }
        SCHED_FENCE();
#pragma unroll
        for (int nt = 0; nt < 8; ++nt) bt1[nt] = LDW(bf16x8, bo + nt * 2048 + 64);
        xe[1][0] = LDW(bf16x8, xeo + 64); xe[1][1] = LDW(bf16x8, xeo + 2048 + 64);
        SCHED_FENCE();
#pragma unroll
        for (int nt = 0; nt < 8; ++nt) { H[nt][0] = MFMA32(bt0[nt], xe[0][0], H[nt][0] * dec); H[nt][1] = MFMA32(bt0[nt], xe[0][1], H[nt][1] * dec); }
#pragma unroll
        for (int nt = 0; nt < 8; ++nt) { H[nt][0] = MFMA32(bt1[nt], xe[1][0], H[nt][0]); H[nt][1] = MFMA32(bt1[nt], xe[1][1], H[nt][1]); }
        co += 64 * 512 * 2; eo += 32 * 64 * 4; wo += 32 * 64 * 64 * 2; xo += DM * 64 * 2; xeo += DM * 64 * 2; bo += 512 * 64 * 2; deo += 32 * 4; yo += 64 * DM * 4; xbo += 64 * XBCW * 2;
    }
    float* dst = C.out + (s.sample ? O_SSSD : O_PSSD) + st_off;
#pragma unroll
    for (int nt = 0; nt < 8; ++nt)
#pragma unroll
        for (int pt = 0; pt < 2; ++pt) *(f32x4*)(dst + (size_t)(ph * 32 + 16 * pt + fr) * 128 + 16 * nt + 4 * fq) = H[nt][pt];
}
__device__ __forceinline__ void phase_scan(const Ctx& C0, int l) {
    constexpr int NGP = NB * 4 * 32, NGS = SBT * 4 * 32, NSP = NB * 32 * 2, NSS = SBT * 32 * 2;
    static_assert(2 * GLA_RING <= 131072, "GLA rings fit the phase scratch");
    const Ctx& C = C0;
#ifdef PROBE_SERIAL
    volatile LAS unsigned* sfl = (volatile LAS unsigned*)(C.lds + LDS_CTL_OFF) + 20;
    __syncthreads(); if (C.tid < 2) sfl[C.tid] = 0u; __syncthreads();
    if (C.wave >= 2) { while (sfl[0] == 0u || sfl[1] == 0u) __builtin_amdgcn_s_sleep(32); }
#endif
    { volatile LAS unsigned* gfl = (volatile LAS unsigned*)(C.lds + LDS_CTL_OFF) + 32; __syncthreads(); if (C.tid < 2) gfl[C.tid] = 0u; __syncthreads(); }
    const unsigned pt0 = PT_NOW(); (void)pt0;
    static_assert(2 * GLA_RING + GLA_SLOT <= 131072 && SSQ == 16, "one more slot above the two rings; sample sequences are one chunk");
    if (C.wave < 2) {
        unsigned ebase = 0u;
        for (int pi = C.bid; pi < NGP / 2; pi += C.G) {
            const unsigned pt1 = PT_NOW(); (void)pt1;
            int st, vp;
            if constexpr (NGP == 512) { st = (pi & 7) * 2 + (pi >> 7); vp = (pi >> 3) & 15; }
            else { st = pi / 16; vp = pi % 16; }
            gla_scan_task<2>(C, l, st >> 2, st & 3, 2 * vp + C.wave, C.lds, ebase);
            ebase += (unsigned)(SEQ / 16 + 2);
            { const unsigned dt_ = PT_NOW() - pt1; PT_MAX(C, 6 + l, dt_); PT_SUM(C, 8 + l, dt_); } }
        PT_MAX(C, 0 + l, PT_NOW() - pt0);
#ifdef PROBE_SERIAL
        if (C.lane == 0) sfl[C.wave] = 1u;
#endif
    } else if (C.wave == 7) {
        LAS unsigned char* slot = C.lds + 2 * GLA_RING;
        for (int u = C.bid; u < NGS; u += C.G) gla_scan_task<1>(C, l, NB + u / 128, (u % 128) / 32, u % 32, slot);
    }
    if (C.wave >= 2) {
        for (int t = (C.wave - 2) * C.G + C.bid; t < NSP + NSS; t += 6 * C.G) {
            if (t < NSP) {
                if constexpr (NSP == 256) {
                    const int st = (t & 7) * 2 + (t >> 7), wi = (t >> 3) & 15;
                    ssd_scan_task(C, l, st >> 2, (st & 3) * 8 + (wi >> 1), wi & 1); }
                else ssd_scan_task(C, l, t / 64, (t % 64) / 2, t % 2); }
            else { const int r = t - NSP; ssd_scan_task(C, l, NB + r / 64, (r % 64) / 2, r % 2); } }
        PT_MAX(C, (C.wave == 2 ? 2 : 4) + l, PT_NOW() - pt0);
    }
}
__device__ __forceinline__ void phase_ynorm(const Ctx& C, int l) {
    const int gw = C.bid * 8 + C.wave, NGW = C.G * 8; const bf16* P = WSP(const bf16, WS_PROJ);
    const float* sn = C.in(16) + (size_t)l * DM; const float* gn = C.in(19) + (size_t)l * 512;
    for (int row = gw; row < T; row += NGW) {
#pragma unroll
        for (int gi = 0; gi < 4; ++gi) { const int c = gi * 512 + C.lane * 8;
            const f32x4 y0 = *(const f32x4*)(WSP(const float, WS_YSR) + (size_t)row * DM + c), y1 = *(const f32x4*)(WSP(const float, WS_YSR) + (size_t)row * DM + c + 4);
            float zv[8]; unpack8(*(const u32x4*)(P + (size_t)row * NPROJ + PZ + c), zv); float v[8]; float ss = 0.f;
#pragma unroll
            for (int j = 0; j < 8; ++j) { const float y = j < 4 ? y0[j] : y1[j - 4]; v[j] = y * siluf_(zv[j]); ss += v[j] * v[j]; }
            const float rstd = 1.0f / sqrtf(wave_sum(ss) * (1.0f / 512.0f) + EPSF);
#pragma unroll
            for (int j = 0; j < 8; ++j) v[j] = v[j] * rstd * sn[c + j];
            *(u32x4*)(WSP(bf16, WS_YS) + (size_t)row * DM + c) = pack8(v); }
#pragma unroll
        for (int hh = 0; hh < 4; ++hh) { const int c = hh * 512 + C.lane * 8;
            const f32x4 y0 = *(const f32x4*)(WSP(const float, WS_YGR) + (size_t)row * DM + c), y1 = *(const f32x4*)(WSP(const float, WS_YGR) + (size_t)row * DM + c + 4);
            float gv[8]; unpack8(*(const u32x4*)(P + (size_t)row * NPROJ + PG + c), gv); float v[8]; float ss = 0.f;
#pragma unroll
            for (int j = 0; j < 8; ++j) { v[j] = j < 4 ? y0[j] : y1[j - 4]; ss += v[j] * v[j]; }
            const float rstd = 1.0f / sqrtf(wave_sum(ss) * (1.0f / 512.0f) + EPSF);
#pragma unroll
            for (int j = 0; j < 8; ++j) v[j] = v[j] * rstd * gn[C.lane * 8 + j] * siluf_(gv[j]);
            *(u32x4*)(WSP(bf16, WS_YG) + (size_t)row * DM + c) = pack8(v); }
    }
}
__device__ __forceinline__ void phase_attn(const Ctx& C, int l) {
    constexpr int QT = SEQ / 128, NU_P = NB * 4 * QT, NU = NU_P + SBT * 4;
    constexpr int KROW = 1040, VROW = 528, BUFB = 16896;
    const int tid = C.tid, lane = C.lane, w = C.wave, fr = lane & 15, fq = lane >> 4;
    LAS unsigned char* KV = C.lds;
    constexpr int BUFP = 2 * BUFB;
    static_assert(2 * BUFP + 8 * 8448 <= LDS_CTL_OFF, "attention LDS");
    LAS bf16* Pl = (LAS bf16*)(C.lds + 2 * BUFP + w * 8448);
    const int krow = tid >> 6, kc = tid & 63, vrow = tid >> 5, vc = tid & 31;
    const unsigned char* wsb = C.ws;
#define LDG(type, off) (*(const type*)(wsb + (off)))
    for (int u = C.bid; u < NU; u += C.G) {
        int row0, h, nvw; unsigned kbo, vbo;
        if (u < NU_P) { const int b = u / (4 * QT), r = u % (4 * QT); h = r / QT; row0 = b * SEQ + (r % QT) * 128; nvw = 8;
            kbo = (unsigned)(WS_KP + (((size_t)l * NB + b) * MTOK * DM + h * 512) * 2); vbo = (unsigned)(WS_VTP + ((((size_t)l * NB + b) * DM + h * 512) * MTOK) * 2); }
        else { const int r = u - NU_P, b = r / 4; h = r % 4; row0 = TP + b * SSQ; nvw = 1;
            kbo = (unsigned)(WS_KS + (((size_t)l * SBT + b) * MTOK * DM + h * 512) * 2); vbo = (unsigned)(WS_VTS + ((((size_t)l * SBT + b) * DM + h * 512) * MTOK) * 2); }
        const bool act = w < nvw; const int qrow = row0 + 16 * w;
        const unsigned kld = kbo + (unsigned)((krow * DM + kc * 8) * 2), vld = vbo + (unsigned)((vrow * MTOK + vc * 8) * 2);
        const unsigned qo = (unsigned)(WS_YS + ((size_t)(qrow + fr) * DM + h * 512 + 8 * fq) * 2), oo = (unsigned)(WS_YG + ((size_t)(qrow + 4 * fq) * DM + h * 512 + fr) * 2);
        __syncthreads();
        u32x4 st0 = LDG(u32x4, kld), st1 = LDG(u32x4, kld + 8 * DM * 2), st2 = LDG(u32x4, kld + 16 * DM * 2), st3 = LDG(u32x4, kld + 24 * DM * 2);
        bf16x8 qf[16];
        if (act) {
#pragma unroll
            for (int ks = 0; ks < 16; ++ks) qf[ks] = LDG(bf16x8, qo + 64 * ks); }
        else {
#pragma unroll
            for (int ks = 0; ks < 16; ++ks) qf[ks] = zero8h(); }
        *(LAS u32x4*)(KV + krow * KROW + kc * 16) = st0; *(LAS u32x4*)(KV + (krow + 8) * KROW + kc * 16) = st1;
        *(LAS u32x4*)(KV + BUFB + krow * KROW + kc * 16) = st2; *(LAS u32x4*)(KV + BUFB + (krow + 8) * KROW + kc * 16) = st3;
        __syncthreads();
        f32x4 sacc[16];
#pragma unroll
        for (int kp = 0; kp < 8; ++kp) {
            if (kp < 7) { const unsigned o_ = kld + (kp + 1) * (32 * DM * 2); st0 = LDG(u32x4, o_); st1 = LDG(u32x4, o_ + 8 * DM * 2); st2 = LDG(u32x4, o_ + 16 * DM * 2); st3 = LDG(u32x4, o_ + 24 * DM * 2); }
            else { st0 = LDG(u32x4, vld); st1 = LDG(u32x4, vld + 16 * MTOK * 2); st2 = LDG(u32x4, vld + 32 * MTOK * 2); st3 = LDG(u32x4, vld + 48 * MTOK * 2); }
#pragma unroll
            for (int t = 0; t < 2; ++t) { f32x4 a = (f32x4){0.f, 0.f, 0.f, 0.f};
                if (act) {
#pragma unroll
                    for (int ks = 0; ks < 16; ++ks) { const bf16x8 kf = *(const LAS bf16x8*)(KV + (kp & 1) * BUFP + t * BUFB + fr * KROW + (32 * ks + 8 * fq) * 2); a = MFMA32(qf[ks], kf, a); } }
                sacc[2 * kp + t] = a; }
            if (kp < 7) { LAS unsigned char* nb = KV + ((kp + 1) & 1) * BUFP;
                *(LAS u32x4*)(nb + krow * KROW + kc * 16) = st0; *(LAS u32x4*)(nb + (krow + 8) * KROW + kc * 16) = st1;
                *(LAS u32x4*)(nb + BUFB + krow * KROW + kc * 16) = st2; *(LAS u32x4*)(nb + BUFB + (krow + 8) * KROW + kc * 16) = st3; }
            else { *(LAS u32x4*)(KV + vrow * VROW + vc * 16) = st0; *(LAS u32x4*)(KV + (vrow + 16) * VROW + vc * 16) = st1;
                *(LAS u32x4*)(KV + BUFB + vrow * VROW + vc * 16) = st2; *(LAS u32x4*)(KV + BUFB + (vrow + 16) * VROW + vc * 16) = st3; }
            __syncthreads();
            __builtin_amdgcn_sched_barrier(0);
        }
        bf16x8 pf[8];
        if (act) {
            const float sc = 0.04419417382415922f;
#pragma unroll
            for (int r = 0; r < 4; ++r) { float mx = -3.0e38f;
#pragma unroll
                for (int nt = 0; nt < 16; ++nt) mx = fmaxf(mx, sacc[nt][r]);
                mx = fmaxf(mx, __shfl_xor(mx, 1)); mx = fmaxf(mx, __shfl_xor(mx, 2)); mx = fmaxf(mx, __shfl_xor(mx, 4)); mx = fmaxf(mx, __shfl_xor(mx, 8));
                float sum = 0.f;
#pragma unroll
                for (int nt = 0; nt < 16; ++nt) { const float e = __expf((sacc[nt][r] - mx) * sc); sacc[nt][r] = e; sum += e; }
                sum += __shfl_xor(sum, 1); sum += __shfl_xor(sum, 2); sum += __shfl_xor(sum, 4); sum += __shfl_xor(sum, 8);
                const float inv = 1.0f / sum;
#pragma unroll
                for (int nt = 0; nt < 16; ++nt) Pl[(4 * fq + r) * 264 + 16 * nt + fr] = (bf16)f2bf(sacc[nt][r] * inv); }
            WAVE_LDS_SYNC();
#pragma unroll
            for (int ks = 0; ks < 8; ++ks) pf[ks] = *(const LAS bf16x8*)(Pl + fr * 264 + 32 * ks + 8 * fq);
            WAVE_LDS_SYNC();
        } else {
#pragma unroll
            for (int ks = 0; ks < 8; ++ks) pf[ks] = zero8h(); }
#pragma unroll
        for (int vp = 0; vp < 8; ++vp) {
            if (vp < 7) { const unsigned o_ = vld + (vp + 1) * (64 * MTOK * 2); st0 = LDG(u32x4, o_); st1 = LDG(u32x4, o_ + 16 * MTOK * 2); st2 = LDG(u32x4, o_ + 32 * MTOK * 2); st3 = LDG(u32x4, o_ + 48 * MTOK * 2); }
            if (act) {
#pragma unroll
                for (int t = 0; t < 2; ++t)
#pragma unroll
                    for (int d2 = 0; d2 < 2; ++d2) { f32x4 a = (f32x4){0.f, 0.f, 0.f, 0.f};
#pragma unroll
                        for (int ks = 0; ks < 8; ++ks) { const bf16x8 vf = *(const LAS bf16x8*)(KV + (vp & 1) * BUFP + t * BUFB + (16 * d2 + fr) * VROW + (32 * ks + 8 * fq) * 2); a = MFMA32(pf[ks], vf, a); }
#pragma unroll
                        for (int r = 0; r < 4; ++r) *(bf16*)(C.ws + oo + (unsigned)((r * DM + 32 * (2 * vp + t) + 16 * d2) * 2)) = (bf16)f2bf(a[r]); } }
            if (vp < 7) { LAS unsigned char* nb = KV + ((vp + 1) & 1) * BUFP;
                *(LAS u32x4*)(nb + vrow * VROW + vc * 16) = st0; *(LAS u32x4*)(nb + (vrow + 16) * VROW + vc * 16) = st1;
                *(LAS u32x4*)(nb + BUFB + vrow * VROW + vc * 16) = st2; *(LAS u32x4*)(nb + BUFB + (vrow + 16) * VROW + vc * 16) = st3;
                __syncthreads(); }
            __builtin_amdgcn_sched_barrier(0);
        }
    }
#undef LDG
}
__device__ __forceinline__ void phase_ffnact(const Ctx& C, int l) {
    const size_t gt = (size_t)C.bid * 512 + C.tid, NT = (size_t)C.G * 512;
    const bf16* U = WSP(const bf16, WS_PROJ);
    const float* cw = C.in(29) + (size_t)l * 3 * DFF2; const float* cb = C.in(30) + (size_t)l * DFF2; const float* st = C.in(6) + (size_t)l * SBT * 2 * DFF2;
    for (size_t it = gt; it < (size_t)(T / 8) * (DFF / 8); it += NT) {
        const int seg = (int)(it / (DFF / 8)), c = (int)(it % (DFF / 8)) * 8, row0 = seg * 8; const SeqInfo s = seq_of_row(row0);
        u32x4 ru[10], rg[10];
#pragma unroll
        for (int i = 0; i < 8; ++i) { ru[2 + i] = *(const u32x4*)(U + (size_t)(row0 + i) * DFF2 + c); rg[2 + i] = *(const u32x4*)(U + (size_t)(row0 + i) * DFF2 + DFF + c); }
        float wu[3][8], wg[3][8], bu[8], bg[8];
#pragma unroll
        for (int i = 0; i < 3; ++i)
#pragma unroll
            for (int hlf = 0; hlf < 2; ++hlf) { const f32x4 a = *(const f32x4*)(cw + i * DFF2 + c + 4 * hlf), b = *(const f32x4*)(cw + i * DFF2 + DFF + c + 4 * hlf);
#pragma unroll
                for (int j = 0; j < 4; ++j) { wu[i][4 * hlf + j] = a[j]; wg[i][4 * hlf + j] = b[j]; } }
#pragma unroll
        for (int hlf = 0; hlf < 2; ++hlf) { const f32x4 a = *(const f32x4*)(cb + c + 4 * hlf), b = *(const f32x4*)(cb + DFF + c + 4 * hlf);
#pragma unroll
            for (int j = 0; j < 4; ++j) { bu[4 * hlf + j] = a[j]; bg[4 * hlf + j] = b[j]; } }
        float hu[2][8], hg[2][8];
        if (s.t >= 2) {
#pragma unroll
            for (int i = 0; i < 2; ++i) { ru[i] = *(const u32x4*)(U + (size_t)(row0 - 2 + i) * DFF2 + c); rg[i] = *(const u32x4*)(U + (size_t)(row0 - 2 + i) * DFF2 + DFF + c); unpack8(ru[i], hu[i]); unpack8(rg[i], hg[i]); } }
        else if (s.sample) {
#pragma unroll
            for (int i = 0; i < 2; ++i) { const float* sp = st + ((size_t)s.b * 2 + i) * DFF2 + c;
#pragma unroll
                for (int j = 0; j < 8; ++j) { hu[i][j] = sp[j]; hg[i][j] = sp[DFF + j]; } } }
        else {
#pragma unroll
            for (int i = 0; i < 2; ++i)
#pragma unroll
                for (int j = 0; j < 8; ++j) { hu[i][j] = 0.f; hg[i][j] = 0.f; } }
#pragma unroll
        for (int i = 0; i < 8; ++i) { float cu[8], cg[8], o[8]; unpack8(ru[2 + i], cu); unpack8(rg[2 + i], cg);
#pragma unroll
            for (int j = 0; j < 8; ++j) { const float au = bu[j] + hu[0][j] * wu[0][j] + hu[1][j] * wu[1][j] + cu[j] * wu[2][j], ag = bg[j] + hg[0][j] * wg[0][j] + hg[1][j] * wg[1][j] + cg[j] * wg[2][j];
                o[j] = siluf_(ag) * au; hu[0][j] = hu[1][j]; hu[1][j] = cu[j]; hg[0][j] = hg[1][j]; hg[1][j] = cg[j]; }
            *(u32x4*)(WSP(bf16, WS_YSR) + (size_t)(row0 + i) * DFF + c) = pack8(o); }
    }
    for (size_t it = gt; it < (size_t)NSEQ * 2 * DFF2; it += NT) {
        const int c = (int)(it % DFF2), j = (int)(it / DFF2) % 2, sq = (int)(it / (2 * DFF2)); const SeqInfo s = seq_of_idx(sq);
        float* dst = C.out + (s.sample ? O_SFFC + ((size_t)l * SBT + s.b) * 2 * DFF2 : O_PFFC + ((size_t)l * NB + s.b) * 2 * DFF2);
        dst[j * DFF2 + c] = bf2f(U[(size_t)(s.row0 + s.L - 2 + j) * DFF2 + c]);
    }
}

struct SEpiGate0 { const bf16* P; float* M0; static constexpr bool ROWSUM = false; __device__ __forceinline__ float operator()(int row, int col, float v) const { M0[(size_t)row * DM + col] = v * sigmoidf_(bf2f(P[(size_t)row * NPROJ + PGATE + col])); return 0.f; } };
struct SEpiGate1 { const bf16* P; const float* M0; bf16* O; static constexpr bool ROWSUM = false; __device__ __forceinline__ float operator()(int row, int col, float v) const { O[(size_t)row * DM + col] = (bf16)f2bf(M0[(size_t)row * DM + col] + v * sigmoidf_(bf2f(P[(size_t)row * NPROJ + PGATE + DM + col]))); return 0.f; } };
struct SEpiResid { float* X; bf16* H; float* SS; static constexpr bool ROWSUM = true; __device__ __forceinline__ float operator()(int row, int col, float v) const { const float x = X[(size_t)row * DM + col] + v; X[(size_t)row * DM + col] = x; H[(size_t)row * DM + col] = (bf16)f2bf(x); return x * x; } };
struct SEpiBf16 { bf16* O; const float* SS; static constexpr bool ROWSUM = false; __device__ __forceinline__ float operator()(int row, int col, float v) const { O[(size_t)row * DM + col] = (bf16)f2bf(v * row_rstd(SS, row)); return 0.f; } };
template <class SE>
__device__ __forceinline__ void sample_gemm(const Ctx& C, size_t a_off, size_t b_off, int K, const SE& E) {
    const int lane = C.lane, fr = lane & 15, fq = lane >> 4; const unsigned char* wsb = C.ws;
    const int KW = K / 8, NK = KW / 32;
    for (int u = C.bid; u < 256; u += C.G) {
        const int jx = u >> 3, mi = jx >> 3, ni = (jx & 7) * 8 + (u & 7);
        const unsigned ao = (unsigned)(a_off + ((size_t)(TP + 64 * mi + fr) * K + C.wave * KW + 8 * fq) * 2);
        const unsigned bo = (unsigned)(b_off + ((size_t)(32 * ni + fr) * K + C.wave * KW + 8 * fq) * 2);
        f32x4 acc[4][2];
#pragma unroll
        for (int i = 0; i < 4; ++i) { acc[i][0] = __builtin_bit_cast(f32x4, zero16()); acc[i][1] = __builtin_bit_cast(f32x4, zero16()); }
        bf16x8 af[4][4], bfv[4][2];
#define SG_LD(slot, ks_) do { const unsigned ko_ = 64u * (unsigned)(ks_); \
        _Pragma("unroll") for (int i = 0; i < 4; ++i) af[slot][i] = *(const bf16x8*)(wsb + ao + (unsigned)(i * 32 * K) + ko_); \
        _Pragma("unroll") for (int n = 0; n < 2; ++n) bfv[slot][n] = *(const bf16x8*)(wsb + bo + (unsigned)(n * 32 * K) + ko_); } while (0)
#pragma unroll
        for (int j = 0; j < 4; ++j) SG_LD(j, j);
        __syncthreads();
        for (int ks = 0; ks < NK; ks += 4) {
#pragma unroll
            for (int jp = 0; jp < 2; ++jp) {
                if (ks + 2 * jp < NK) {
#pragma unroll
                    for (int j = 2 * jp; j < 2 * jp + 2; ++j)
#pragma unroll
                        for (int i = 0; i < 4; ++i) { acc[i][0] = MFMA32(af[j][i], bfv[j][0], acc[i][0]); acc[i][1] = MFMA32(af[j][i], bfv[j][1], acc[i][1]); } }
                const int kn = ks + 4 + 2 * jp < NK ? ks + 4 + 2 * jp : NK - 2;
                SG_LD(2 * jp, kn); SG_LD(2 * jp + 1, kn + 1);
                __builtin_amdgcn_sched_barrier(0); } }
#undef SG_LD
        LAS f32x4* red = (LAS f32x4*)C.lds;
#pragma unroll
        for (int i = 0; i < 4; ++i) { red[(C.wave * 8 + 2 * i) * 64 + lane] = acc[i][0]; red[(C.wave * 8 + 2 * i + 1) * 64 + lane] = acc[i][1]; }
        __syncthreads();
        f32x4 sum = red[C.wave * 64 + lane];
#pragma unroll
        for (int w = 1; w < 8; ++w) sum += red[(w * 8 + C.wave) * 64 + lane];
        const int row0 = TP + 64 * mi + 16 * (C.wave >> 1) + 4 * fq, col = 32 * ni + 16 * (C.wave & 1) + fr;
#pragma unroll
        for (int r = 0; r < 4; ++r) { const int row = row0 + r; float q = E(row, col, sum[r]);
            if constexpr (SE::ROWSUM) { q += __shfl_xor(q, 1); q += __shfl_xor(q, 2); q += __shfl_xor(q, 4); q += __shfl_xor(q, 8); if (fr == 0) atomicAdd(E.SS + row, q); } }
    }
}

#ifndef HOST_EMU
#define XB_TMO      128
#define XB_XCNT(j)  (256  + 64 * (j))
#define XB_XSUB(j)  (1280 + 64 * (j))
#define XB_XGEN(j)  (2304 + 64 * (j))
#define XB_TOP      3328
#define XB_TOPGEN   3392
#define XCD_BAR_WORDS 3456
#define XB_SPIN_CAP (1u << 18)
__device__ __forceinline__ unsigned xb_ld(unsigned* p)              { return __hip_atomic_load(p, __ATOMIC_RELAXED, __HIP_MEMORY_SCOPE_AGENT); }
__device__ __forceinline__ unsigned xb_add(unsigned* p, unsigned v) { return __hip_atomic_fetch_add(p, v, __ATOMIC_RELAXED, __HIP_MEMORY_SCOPE_AGENT); }
__device__ __forceinline__ unsigned xb_xcc_id() { return (unsigned)__builtin_amdgcn_s_getreg((3 << 11) | 20) & 0xFu; }
#define XB_SPIN(cond, bar) do { unsigned _sp = 0; while (cond) { __builtin_amdgcn_s_sleep(4); \
    if ((++_sp & 255u) == 0u) { if (xb_ld(&(bar)[XB_TMO])) break; if (_sp > XB_SPIN_CAP) { atomicAdd(&(bar)[XB_TMO], 1u); break; } } } } while (0)
struct XcdBarrier { unsigned* bar; unsigned x; volatile LAS unsigned* st; };
__device__ __forceinline__ XcdBarrier xcd_barrier_post(unsigned* bar, volatile LAS unsigned* st) {
    XcdBarrier b; b.bar = bar; b.x = xb_xcc_id(); b.st = st;
    if (threadIdx.x == 0) (void)xb_add(&bar[XB_XCNT(b.x)], 1u);
    return b;
}
__device__ __forceinline__ void xcd_barrier_complete(unsigned* bar, unsigned x, unsigned& nloc, unsigned& nx) {
    const unsigned G = gridDim.x * gridDim.y * gridDim.z;
    unsigned sum, cnt, mine, sp = 0u;
    for (;;) {
        sum = 0u; cnt = 0u; mine = 0u;
#pragma unroll
        for (unsigned j = 0; j < 16; ++j) { const unsigned c = xb_ld(&bar[XB_XCNT(j)]); sum += c; cnt += (c > 0u) ? 1u : 0u; mine = (j == x) ? c : mine; }
        if (sum == G) break;
        __builtin_amdgcn_s_sleep(1);
        if ((++sp & 255u) == 0u) { if (xb_ld(&bar[XB_TMO])) break; if (sp > XB_SPIN_CAP) { atomicAdd(&bar[XB_TMO], 1u); break; } }
    }
    nloc = mine > 0u ? mine : 1u; nx = cnt > 0u ? cnt : 1u;
}
__device__ __forceinline__ void xcd_barrier(const XcdBarrier& b) {
    asm volatile("s_waitcnt vmcnt(0)" ::: "memory");
    __syncthreads();
    if (threadIdx.x == 0) {
        unsigned* bar = b.bar;
        __builtin_amdgcn_s_waitcnt(0);
        unsigned nloc = b.st[0], nx = b.st[1];
        if (nloc == 0u) { xcd_barrier_complete(bar, b.x, nloc, nx); b.st[0] = nloc; b.st[1] = nx; }
        const unsigned old = xb_add(&bar[XB_XSUB(b.x)], 1u);
        const unsigned gen = old / nloc;
        if (old + 1u == (gen + 1u) * nloc) {
            __builtin_amdgcn_fence(__ATOMIC_RELEASE, "agent");
            asm volatile("s_waitcnt vmcnt(0)" ::: "memory");
            const unsigned og = xb_add(&bar[XB_TOP], 1u);
            const unsigned tg = og / nx;
            if (og + 1u == (tg + 1u) * nx) xb_add(&bar[XB_TOPGEN], 1u);
            else XB_SPIN(xb_ld(&bar[XB_TOPGEN]) == tg, bar);
            __builtin_amdgcn_fence(__ATOMIC_ACQUIRE, "agent");
            xb_add(&bar[XB_XGEN(b.x)], 1u);
            asm volatile("s_waitcnt vmcnt(0)" ::: "memory");
        } else {
            XB_SPIN(xb_ld(&bar[XB_XGEN(b.x)]) == gen, bar);
            __builtin_amdgcn_fence(__ATOMIC_ACQUIRE, "agent");
            asm volatile("s_waitcnt vmcnt(0)" ::: "memory");
        }
    }
    __syncthreads();
}
#endif

constexpr int PH_PRO = 0, PH_KV = 1, PH_L0 = 2, PH_PER_LAYER = 18, PH_FINAL = PH_L0 + 2 * PH_PER_LAYER, NPH = PH_FINAL + 1;
#ifdef HOST_EMU
__device__ __forceinline__ Ctx make_ctx(const Args& args, unsigned char* lds, int) {
    Ctx C; C.lds = lds; C.tid = threadIdx.x; C.lane = C.tid & 63; C.wave = C.tid >> 6; C.G = gridDim.x; C.bid = blockIdx.x; C.ap = &args; C.out = args.out; C.ws = args.ws; return C;
}
#else
__device__ __forceinline__ Ctx make_ctx(const Args& args, unsigned char* lds, int wave_s) {
    Ctx C; int wave = wave_s; asm volatile("" : "+s"(wave));
    int lane = __builtin_amdgcn_mbcnt_hi(~0u, __builtin_amdgcn_mbcnt_lo(~0u, 0u)); asm volatile("" : "+v"(lane));
    int bid = blockIdx.x, G = gridDim.x; asm volatile("" : "+s"(bid), "+s"(G));
    const CAS unsigned char* kp = (const CAS unsigned char*)__builtin_amdgcn_kernarg_segment_ptr(); asm volatile("" : "+s"(kp));
    int tid = wave * 64 + lane; asm volatile("" : "+v"(tid));
    C.lds = (LAS unsigned char*)lds; C.tid = tid; C.lane = tid & 63; C.wave = __builtin_amdgcn_readfirstlane(tid >> 6); C.G = G; C.bid = bid; C.kp = kp;
    C.out = *(float* const CAS*)(kp + 264); C.ws = *(unsigned char* const CAS*)(kp + 272);
    return C;
}
static_assert(sizeof(Args) == 288, "Args layout (kernarg offsets in make_ctx)");
#endif
__global__ void __launch_bounds__(512, 2) mk_fwd(Args args) {
    DYN_LDS(lds);
    const int lo = args.ph_lo, hi = args.ph_hi;
    const int wave_s = __builtin_amdgcn_readfirstlane((int)threadIdx.x >> 6);
#ifndef HOST_EMU
    volatile LAS unsigned* lctl = (volatile LAS unsigned*)((LAS unsigned char*)lds + LDS_CTL_OFF);
    if (threadIdx.x < 64) lctl[threadIdx.x] = 0u;
    __syncthreads();
    if (hi - lo > 1) (void)xcd_barrier_post((unsigned*)(args.ws + WS_CTL) + 4096, lctl + 8);
#define GRID_BAR() do { XcdBarrier bar_; { const CAS unsigned char* kp_ = (const CAS unsigned char*)__builtin_amdgcn_kernarg_segment_ptr(); asm volatile("" : "+s"(kp_)); \
        bar_.bar = (unsigned*)(*(unsigned char* const CAS*)(kp_ + 272) + WS_CTL) + 4096; } bar_.x = xb_xcc_id(); bar_.st = (volatile LAS unsigned*)((LAS unsigned char*)lds + LDS_CTL_OFF) + 8; xcd_barrier(bar_); } while (0)
#else
#define GRID_BAR() ((void)0)
#endif
#define IN(k) (lo <= (k) && (k) < hi)
#ifdef PROBE_AMP
#define SEAM(k) do { if (IN(k) && IN((k) + 1)) { const unsigned b0_ = PT_NOW(); GRID_BAR(); if (threadIdx.x == 0) atomicAdd((unsigned*)(args.ws + WS_CTL + 32768) + 256 + 6 * 256 + blockIdx.x, PT_NOW() - b0_); } } while (0)
#else
#define SEAM(k) do { if (IN(k) && IN((k) + 1)) GRID_BAR(); } while (0)
#endif
#define CTX const Ctx C = make_ctx(args, lds, wave_s)
#define GEMM_PHASE(EPI, Aoff, Boff, M_, N_, K_, ...) do { CTX; pg8::Gemm g{WSP(const bf16, Aoff), WSP(const bf16, Boff), M_, N_, K_}; pg8::StaticOrder S; S.init(M_, N_, C.G, C.bid); \
        EPI E{__VA_ARGS__}; pg8::gemm_phase<EPI, true>(C.lds, C.tid, g, S, E); } while (0)
    if (IN(PH_PRO)) { { CTX; phase_prologue(C); } { CTX; phase_xprep(C); } } SEAM(PH_PRO);
    if (IN(PH_KV)) { GEMM_PHASE(EpiMemKV, WS_MEMP, WS_WKV, NB * MTOK, 8192, DM, C.out, WSP(bf16, WS_KP), WSP(bf16, WS_VTP)); __syncthreads(); { CTX; phase_wconv(C, 0, (NB * MTOK / 256) * (8192 / 256)); } } SEAM(PH_KV);
#ifndef PROBE_MASK
#define PROBE_MASK 0
#endif
#ifdef PROBE_AMP
#define PT_G0 unsigned ptg_ = PT_NOW()
#define PT_G1(k) do { __syncthreads(); CTX; const unsigned n_ = PT_NOW(); PT_BLK_ADD(C, k, n_ - ptg_); ptg_ = n_; } while (0)
#else
#define PT_G0 ((void)0)
#define PT_G1(k) ((void)0)
#endif
#define LPH_NS(off, ...) do { if (IN(pb + (off))) { __VA_ARGS__; __syncthreads(); } } while (0)
#define LPH(off, ...) do { if (IN(pb + (off))) { __VA_ARGS__; if ((PROBE_MASK >> (off)) & 1) { GRID_BAR(); __VA_ARGS__; } } SEAM(pb + (off)); } while (0)
    for (int l = 0; l < 2; ++l) {
        const int pb = PH_L0 + PH_PER_LAYER * l;
        if (IN(pb + 0)) { if (l > 0) { CTX; phase_wconv(C, l); } if (PROBE_MASK & 1) { GRID_BAR(); CTX; phase_wconv(C, l); } } if (l > 0) SEAM(pb + 0);
        LPH(2, GEMM_PHASE(EpiProj, WS_H, WS_WIN, T, NPROJ_PAD, DM, WSP(bf16, WS_PROJ), WSP(float, WS_SMALL), WSP(const float, WS_SS) + (size_t)(3 * l) * T));
        LPH(3, { CTX; phase_prep(C, l); });
        LPH(4, { CTX; phase_chunkprep(C, l); });
        LPH(5, { CTX; phase_scan(C, l); });
        LPH(6, { CTX; phase_ynorm(C, l); });
        LPH_NS(7, { PT_G0; GEMM_PHASE(EpiGate0, WS_YS, WS_WB0, TP, DM, DM, WSP(const bf16, WS_PROJ), WSP(float, WS_YSR)); PT_G1(5); CTX; sample_gemm(C, WS_YS, WS_WB0, DM, SEpiGate0{WSP(const bf16, WS_PROJ), WSP(float, WS_YSR)}); PT_G1(4); });
        LPH(8, { PT_G0; GEMM_PHASE(EpiGate1, WS_YG, WS_WB1, TP, DM, DM, WSP(const bf16, WS_PROJ), WSP(const float, WS_YSR), WSP(bf16, WS_MRG)); PT_G1(5); CTX; sample_gemm(C, WS_YG, WS_WB1, DM, SEpiGate1{WSP(const bf16, WS_PROJ), WSP(const float, WS_YSR), WSP(bf16, WS_MRG)}); PT_G1(4); });
        LPH(9, { PT_G0; GEMM_PHASE(EpiResid, WS_MRG, WS_WOUT, TP, DM, DM, WSP(float, WS_X), WSP(bf16, WS_H), WSP(float, WS_SS) + (size_t)(3 * l + 1) * T); PT_G1(5); CTX; sample_gemm(C, WS_MRG, WS_WOUT, DM, SEpiResid{WSP(float, WS_X), WSP(bf16, WS_H), WSP(float, WS_SS) + (size_t)(3 * l + 1) * T}); PT_G1(4); });
        LPH(11, { PT_G0; GEMM_PHASE(EpiBf16, WS_H, WS_WMQ, TP, DM, DM, WSP(bf16, WS_YS), DM, WSP(const float, WS_SS) + (size_t)(3 * l + 1) * T); PT_G1(5); CTX; sample_gemm(C, WS_H, WS_WMQ, DM, SEpiBf16{WSP(bf16, WS_YS), WSP(const float, WS_SS) + (size_t)(3 * l + 1) * T}); PT_G1(4); });
        LPH(12, { CTX; phase_attn(C, l); });
        LPH(13, { PT_G0; GEMM_PHASE(EpiResid, WS_YG, WS_WMO, TP, DM, DM, WSP(float, WS_X), WSP(bf16, WS_H), WSP(float, WS_SS) + (size_t)(3 * l + 2) * T); PT_G1(5); CTX; sample_gemm(C, WS_YG, WS_WMO, DM, SEpiResid{WSP(float, WS_X), WSP(bf16, WS_H), WSP(float, WS_SS) + (size_t)(3 * l + 2) * T}); PT_G1(4); });
        LPH(15, GEMM_PHASE(EpiBf16, WS_H, WS_WFI, T, DFF2, DM, WSP(bf16, WS_PROJ), DFF2, WSP(const float, WS_SS) + (size_t)(3 * l + 2) * T));
        LPH(16, { CTX; phase_ffnact(C, l); });
        LPH(17, { PT_G0; GEMM_PHASE(EpiResid, WS_YSR, WS_WFO, TP, DM, DFF, WSP(float, WS_X), WSP(bf16, WS_H), WSP(float, WS_SS) + (size_t)(3 * l + 3) * T); PT_G1(5); CTX; sample_gemm(C, WS_YSR, WS_WFO, DFF, SEpiResid{WSP(float, WS_X), WSP(bf16, WS_H), WSP(float, WS_SS) + (size_t)(3 * l + 3) * T}); PT_G1(4); });
    }
    if (IN(PH_FINAL)) { CTX; phase_final(C); }
#ifdef PROBE_AMP
    if (IN(PH_FINAL)) { GRID_BAR();
        if (blockIdx.x == 0 && threadIdx.x == 0) { unsigned* pt = (unsigned*)(args.ws + WS_CTL + 32768); unsigned v = 0;
            if (PROBE_SEL < 4) v = __hip_atomic_load(pt + 2 * PROBE_SEL, __ATOMIC_RELAXED, __HIP_MEMORY_SCOPE_AGENT) + __hip_atomic_load(pt + 2 * PROBE_SEL + 1, __ATOMIC_RELAXED, __HIP_MEMORY_SCOPE_AGENT);
            else if (PROBE_SEL == 10) v = __hip_atomic_load(pt + 12, __ATOMIC_RELAXED, __HIP_MEMORY_SCOPE_AGENT);
            else if (PROBE_SEL == 9) v = (__hip_atomic_load(pt + 10, __ATOMIC_RELAXED, __HIP_MEMORY_SCOPE_AGENT) + __hip_atomic_load(pt + 11, __ATOMIC_RELAXED, __HIP_MEMORY_SCOPE_AGENT)) / 512u;
            else if (PROBE_SEL == 8) v = (__hip_atomic_load(pt + 8, __ATOMIC_RELAXED, __HIP_MEMORY_SCOPE_AGENT) + __hip_atomic_load(pt + 9, __ATOMIC_RELAXED, __HIP_MEMORY_SCOPE_AGENT)) / 512u;
            else if (PROBE_SEL == 6) { unsigned long long t = 0; for (int i = 0; i < 256; ++i) t += __hip_atomic_load(pt + 256 + 6 * 256 + i, __ATOMIC_RELAXED, __HIP_MEMORY_SCOPE_AGENT); v = (unsigned)(t / 256); }
            else if (PROBE_SEL == 7) { v = ~0u; for (int i = 0; i < 256; ++i) { const unsigned w = __hip_atomic_load(pt + 256 + 6 * 256 + i, __ATOMIC_RELAXED, __HIP_MEMORY_SCOPE_AGENT); v = w < v ? w : v; } }
            else for (int i = 0; i < 256; ++i) { const unsigned w = __hip_atomic_load(pt + 256 + PROBE_SEL * 256 + i, __ATOMIC_RELAXED, __HIP_MEMORY_SCOPE_AGENT); v = w > v ? w : v; }
            const unsigned long long t0 = __builtin_amdgcn_s_memrealtime(), span = (unsigned long long)v * PROBE_AMP;
            while (__builtin_amdgcn_s_memrealtime() - t0 < span) __builtin_amdgcn_s_sleep(20); } }
#endif
#undef IN
#undef SEAM
#undef GRID_BAR
}

extern "C" void kernel_launch(void* const* d_in, const int* in_sizes, int n_in, void* d_out, int out_size, void* d_ws, size_t ws_size, hipStream_t stream) {
    static int grid = 0;
    if (grid == 0) {
        if (n_in != 33 || (size_t)out_size != O_END || ws_size < WS_END) { fprintf(stderr, "kernel_launch: unexpected shapes (n_in %d out %d ws %zu; need out %zu ws %zu)\n", n_in, out_size, ws_size, (size_t)O_END, (size_t)WS_END); grid = -1; return; }
        int dev = 0, cus = 0;
        if (hipGetDevice(&dev) != hipSuccess || hipDeviceGetAttribute(&cus, hipDeviceAttributeMultiprocessorCount, dev) != hipSuccess) { grid = -1; return; }
        if (hipFuncSetAttribute((const void*)mk_fwd, hipFuncAttributeMaxDynamicSharedMemorySize, LDS_BYTES) != hipSuccess) { fprintf(stderr, "kernel_launch: hipFuncSetAttribute failed\n"); grid = -1; return; }
        (void)hipGetLastError();
        grid = cus;
    }
    if (grid < 0) return;
    (void)hipMemsetAsync((char*)d_ws + WS_CTL, 0, CTL_BYTES, stream);
    Args a{};
    for (int i = 0; i < 33; ++i) a.in[i] = (const float*)d_in[i];
    a.out = (float*)d_out; a.ws = (unsigned char*)d_ws;
#ifdef HOST_EMU
    const char* e0 = getenv("EMU_PH_LO"); const char* e1 = getenv("EMU_PH_HI");
    const int plo = e0 ? atoi(e0) : 0, phi = e1 ? atoi(e1) : NPH;
    for (int p = plo; p < phi; ++p) { a.ph_lo = p; a.ph_hi = p + 1; fprintf(stderr, "emu: phase %d\n", p); emu_launch(mk_fwd, (unsigned)grid, 512u, (size_t)LDS_BYTES, a); }
#else
#if MK_ONE_LAUNCH
    a.ph_lo = 0; a.ph_hi = NPH;
    hipLaunchKernelGGL(mk_fwd, dim3(grid), dim3(512), LDS_BYTES, stream, a);
#else
    for (int p = 0; p < NPH; ++p) { a.ph_lo = p; a.ph_hi = p + 1; hipLaunchKernelGGL(mk_fwd, dim3(grid), dim3(512), LDS_BYTES, stream, a); }
#endif
#endif
}
```
